# Optimizing an MI355X kernel written in HIP

```python
import math
import jax
import jax.numpy as jnp
from jax import lax
import numpy as np

D_MODEL = 1024
BATCH = 8
SEQ = 4096
DEPTH = 2

SSD_HEADS = 8
SSD_HEAD_DIM = 64
SSD_INNER = SSD_HEADS * SSD_HEAD_DIM
SSD_GROUPS = 2
SSD_STATE = 64
SSD_CONV = 4
SSD_CHUNK = 128
CONV_CH = SSD_INNER + 2 * SSD_GROUPS * SSD_STATE
ATT_HEADS = 8
ATT_HEAD_DIM = 64
ATT_INNER = ATT_HEADS * ATT_HEAD_DIM
MOBA_BLOCK = 256
MOBA_TOPK = 3
MOBA_Q_CHUNK = 16
REL_BUCKETS = 32
REL_MAX_DIST = 128
MIX_WIDTH = SSD_INNER + ATT_INNER
IN_COLS = SSD_INNER + CONV_CH + SSD_HEADS + 3 * ATT_INNER
MOE_GROUPS = 4
MOE_EXPERTS_PER_GROUP = 8
MOE_EXPERTS = MOE_GROUPS * MOE_EXPERTS_PER_GROUP
MOE_TOPK = 2
MOE_HIDDEN = 512
MOE_BLOCK_ROWS = 128
EPS = 1e-6

kernel_name = "hymba_ssd_moba_hiermoe"


def rmsnorm(x, g):
    xf = x.astype(jnp.float32)
    y = xf * lax.rsqrt(jnp.mean(xf * xf, axis=-1, keepdims=True) + EPS)
    return (y * g.astype(jnp.float32)).astype(x.dtype)


def t5_bucket(dist):
    dist = jnp.maximum(dist, 0)
    max_exact = REL_BUCKETS // 2
    d = jnp.maximum(dist, max_exact).astype(jnp.float32)
    large = max_exact + (jnp.log(d / max_exact) / math.log(REL_MAX_DIST / max_exact)
                         * (REL_BUCKETS - max_exact)).astype(jnp.int32)
    large = jnp.minimum(large, REL_BUCKETS - 1)
    return jnp.where(dist < max_exact, dist, large)


def causal_dwconv(u, w, b):
    out = lax.conv_general_dilated(
        u, w[:, None, :].astype(u.dtype), window_strides=(1,),
        padding=[(SSD_CONV - 1, 0)], dimension_numbers=('NWC', 'WIO', 'NWC'),
        feature_group_count=u.shape[-1])
    return out + b.astype(u.dtype)


def ssd_mixer(z, xbc, dt_raw, conv_w, conv_b, dt_bias, a_log, d_skip, norm_g):
    f32 = jnp.float32
    bsz, seq, _ = z.shape
    G, E, P, N, L = SSD_GROUPS, SSD_HEADS // SSD_GROUPS, SSD_HEAD_DIM, SSD_STATE, SSD_CHUNK
    nc = seq // L
    xbc = jax.nn.silu(causal_dwconv(xbc, conv_w, conv_b)).astype(f32)
    xs = xbc[..., :SSD_INNER].reshape(bsz, seq, SSD_HEADS, P)
    b_in = xbc[..., SSD_INNER:SSD_INNER + G * N].reshape(bsz, nc, L, G, N)
    c_out = xbc[..., SSD_INNER + G * N:].reshape(bsz, nc, L, G, N)
    dt = jax.nn.softplus(dt_raw.astype(f32) + dt_bias.astype(f32))
    a_dt = dt * (-jnp.exp(a_log.astype(f32)))
    xdt = (xs * dt[..., None]).reshape(bsz, nc, L, G, E, P)
    a_cs = jnp.cumsum(a_dt.reshape(bsz, nc, L, G, E).transpose(0, 3, 4, 1, 2), axis=-1)
    causal = jnp.tril(jnp.ones((L, L), dtype=bool))
    l_mat = jnp.exp(jnp.where(causal, a_cs[..., :, None] - a_cs[..., None, :], -jnp.inf))
    cb = jnp.einsum('bclgn,bcsgn->bcgls', c_out, b_in)
    y_diag = jnp.einsum('bcgls,bgecls,bcsgep->bclgep', cb, l_mat, xdt)
    decay_states = jnp.exp(a_cs[..., -1:] - a_cs)
    states = jnp.einsum('bclgn,bgecl,bclgep->bcgepn', b_in, decay_states, xdt)
    chunk_decay = jnp.exp(a_cs[..., -1])

    def step(h, inp):
        st, dec = inp
        return h * dec[..., None, None] + st, h

    h0 = jnp.zeros((bsz, G, E, P, N), f32)
    _, h_in = lax.scan(step, h0, (jnp.moveaxis(states, 1, 0), jnp.moveaxis(chunk_decay, -1, 0)))
    h_in = jnp.moveaxis(h_in, 0, 1)
    y_off = jnp.einsum('bclgn,bcgepn,bgecl->bclgep', c_out, h_in, jnp.exp(a_cs))
    y = (y_diag + y_off).reshape(bsz, seq, SSD_HEADS, P) + d_skip.astype(f32)[:, None] * xs
    y = y.reshape(bsz, seq, SSD_INNER) * jax.nn.silu(z.astype(f32))
    return rmsnorm(y, norm_g).astype(z.dtype)


def moba_attention(q, k, v, q_g, k_g, rel_bias):
    f32 = jnp.float32
    bsz, seq, _ = q.shape
    H, hd, BS, QC = ATT_HEADS, ATT_HEAD_DIM, MOBA_BLOCK, MOBA_Q_CHUNK
    q = rmsnorm(q.reshape(bsz, seq, H, hd), q_g).transpose(0, 2, 1, 3)
    k = rmsnorm(k.reshape(bsz, seq, H, hd), k_g).transpose(0, 2, 1, 3)
    v = v.reshape(bsz, seq, H, hd).transpose(0, 2, 1, 3)
    s_pad = -(-seq // BS) * BS
    pad = [(0, 0), (0, 0), (0, s_pad - seq), (0, 0)]
    q, k, v = jnp.pad(q, pad), jnp.pad(k, pad), jnp.pad(v, pad)
    nb = s_pad // BS
    topk = min(MOBA_TOPK, nb)
    kb = k.reshape(bsz, H, nb, BS, hd)
    vb = v.reshape(bsz, H, nb, BS, hd)
    kmean = jnp.mean(kb.astype(f32), axis=3)
    gate = jnp.einsum('bhsd,bhnd->bhsn', q.astype(f32), kmean)
    past = jnp.arange(nb)[None, :] < (jnp.arange(s_pad) // BS)[:, None]
    gate = jnp.where(past, gate, -jnp.inf)
    _, sel = lax.top_k(gate, topk)
    scale = ATT_HEAD_DIM ** -0.5
    bi = jnp.arange(bsz)[:, None, None, None]
    hi = jnp.arange(H)[None, :, None, None]

    def chunk(c):
        q0 = c * QC
        qpos = q0 + jnp.arange(QC)
        qc = lax.dynamic_slice_in_dim(q, q0, QC, axis=2)
        selc = lax.dynamic_slice_in_dim(sel, q0, QC, axis=2)
        ksel = kb[bi, hi, selc]
        vsel = vb[bi, hi, selc]
        kpos = selc[..., None] * BS + jnp.arange(BS)
        dist = qpos[:, None, None] - kpos
        valid = jnp.arange(topk)[None, :] < (qpos // BS)[:, None]
        s_sel = jnp.einsum('bhqd,bhqknd->bhqkn', qc, ksel, preferred_element_type=f32) * scale
        s_sel = s_sel + rel_bias[t5_bucket(dist), hi[..., None]].astype(f32)
        s_sel = jnp.where(valid[:, :, None], s_sel, -jnp.inf)
        ob = q0 // BS
        kown = lax.dynamic_index_in_dim(kb, ob, axis=2, keepdims=False)
        vown = lax.dynamic_index_in_dim(vb, ob, axis=2, keepdims=False)
        dist_own = qpos[:, None] - (ob * BS + jnp.arange(BS))[None, :]
        s_own = jnp.einsum('bhqd,bhkd->bhqk', qc, kown, preferred_element_type=f32) * scale
        s_own = s_own + rel_bias[t5_bucket(dist_own)].transpose(2, 0, 1).astype(f32)
        s_own = jnp.where(dist_own >= 0, s_own, -jnp.inf)
        logits = jnp.concatenate([s_sel.reshape(bsz, H, QC, topk * BS), s_own], axis=-1)
        p = jax.nn.softmax(logits, axis=-1)
        p_sel = p[..., :topk * BS].reshape(bsz, H, QC, topk, BS).astype(v.dtype)
        p_own = p[..., topk * BS:].astype(v.dtype)
        return (jnp.einsum('bhqkn,bhqknd->bhqd', p_sel, vsel)
                + jnp.einsum('bhqk,bhkd->bhqd', p_own, vown))

    out = lax.map(chunk, jnp.arange(s_pad // QC))
    out = out.transpose(1, 2, 0, 3, 4).reshape(bsz, H, s_pad, hd)[:, :, :seq]
    return out.transpose(0, 2, 1, 3).reshape(bsz, seq, ATT_INNER)


def hier_moe(xn, w_r1, b_r1, w_r2, b_r2, w_gate, w_up, w_down):
    f32 = jnp.float32
    bsz, seq, d = xn.shape
    T = bsz * seq
    xt = xn.reshape(T, d)
    p1 = jax.nn.softmax(jnp.matmul(xt, w_r1).astype(f32) + b_r1.astype(f32), axis=-1)
    gval, gidx = lax.top_k(p1, 1)
    lg2 = (jnp.matmul(xt, w_r2).astype(f32) + b_r2.astype(f32)).reshape(T, MOE_GROUPS, MOE_EXPERTS_PER_GROUP)
    lg2 = jnp.take_along_axis(lg2, gidx[:, :, None], axis=1)[:, 0]
    ev, eidx = lax.top_k(jax.nn.softmax(lg2, axis=-1), MOE_TOPK)
    gates = gval * (ev / jnp.sum(ev, axis=-1, keepdims=True))
    experts = gidx * MOE_EXPERTS_PER_GROUP + eidx
    M = MOE_BLOCK_ROWS
    A = T * MOE_TOPK
    flat_e = experts.reshape(-1)
    flat_tok = jnp.arange(A) // MOE_TOPK
    flat_gate = gates.reshape(-1)
    order = jnp.argsort(flat_e)
    se, st, sg = flat_e[order], flat_tok[order], flat_gate[order]
    counts = jnp.bincount(flat_e, length=MOE_EXPERTS)
    starts = jnp.cumsum(counts) - counts
    padded = (counts + M - 1) // M * M
    ends = jnp.cumsum(padded)
    pstarts = ends - padded
    dest = pstarts[se] + jnp.arange(A) - starts[se]
    n_blk = -(-A // M) + MOE_EXPERTS
    P = n_blk * M
    slot_tok = jnp.full((P,), T, jnp.int32).at[dest].set(st)
    slot_gate = jnp.zeros((P,), f32).at[dest].set(sg)
    blk_exp = jnp.minimum(jnp.searchsorted(ends, jnp.arange(n_blk) * M, side='right'), MOE_EXPERTS - 1)
    xpad = jnp.concatenate([xt, jnp.zeros((1, d), xt.dtype)], axis=0)
    xb = xpad[slot_tok].reshape(n_blk, M, d)

    def expert_block(args):
        xblk, e = args
        hmid = jax.nn.silu(xblk @ w_gate[e]) * (xblk @ w_up[e])
        return hmid @ w_down[e]

    yb = lax.map(expert_block, (xb, blk_exp)).reshape(P, d)
    out = jnp.zeros((T + 1, d), f32).at[slot_tok].add(yb.astype(f32) * slot_gate[:, None])[:T]
    return out.reshape(bsz, seq, d).astype(xn.dtype)


def setup_inputs(seed: int = 0) -> dict:
    key = jax.random.key(seed)
    ks = jax.random.split(key, 24)
    nrm = jax.random.normal
    D = D_MODEL
    dt = jnp.exp(jax.random.uniform(ks[6], (DEPTH, SSD_HEADS)) * (math.log(0.1) - math.log(0.001)) + math.log(0.001))
    return {
        "x": nrm(ks[0], (BATCH, SEQ, D), jnp.float32),
        "rel_bias": 0.5 * nrm(ks[1], (REL_BUCKETS, ATT_HEADS), jnp.float32),
        "norm1_g": 1.0 + 0.01 * nrm(ks[2], (DEPTH, D), jnp.float32),
        "w_in": nrm(ks[3], (DEPTH, D, IN_COLS), jnp.float32) * D ** -0.5,
        "conv_w": nrm(ks[4], (DEPTH, SSD_CONV, CONV_CH), jnp.float32) * SSD_CONV ** -0.5,
        "conv_b": 0.01 * nrm(ks[5], (DEPTH, CONV_CH), jnp.float32),
        "dt_bias": dt + jnp.log(-jnp.expm1(-dt)),
        "a_log": jnp.log(jax.random.uniform(ks[7], (DEPTH, SSD_HEADS), minval=1.0, maxval=16.0)),
        "d_skip": 1.0 + 0.01 * nrm(ks[8], (DEPTH, SSD_HEADS), jnp.float32),
        "ssd_norm_g": 1.0 + 0.01 * nrm(ks[9], (DEPTH, SSD_INNER), jnp.float32),
        "q_norm_g": 1.0 + 0.01 * nrm(ks[10], (DEPTH, ATT_HEAD_DIM), jnp.float32),
        "k_norm_g": 1.0 + 0.01 * nrm(ks[11], (DEPTH, ATT_HEAD_DIM), jnp.float32),
        "w_out": nrm(ks[12], (DEPTH, MIX_WIDTH, D), jnp.float32) * MIX_WIDTH ** -0.5,
        "norm2_g": 1.0 + 0.01 * nrm(ks[13], (DEPTH, D), jnp.float32),
        "w_r1": nrm(ks[14], (DEPTH, D, MOE_GROUPS), jnp.float32) * D ** -0.5,
        "b_r1": 0.01 * nrm(ks[15], (DEPTH, MOE_GROUPS), jnp.float32),
        "w_r2": nrm(ks[16], (DEPTH, D, MOE_EXPERTS), jnp.float32) * D ** -0.5,
        "b_r2": 0.01 * nrm(ks[17], (DEPTH, MOE_EXPERTS), jnp.float32),
        "w_gate": nrm(ks[18], (DEPTH, MOE_EXPERTS, D, MOE_HIDDEN), jnp.float32) * D ** -0.5,
        "w_up": nrm(ks[19], (DEPTH, MOE_EXPERTS, D, MOE_HIDDEN), jnp.float32) * D ** -0.5,
        "w_down": nrm(ks[20], (DEPTH, MOE_EXPERTS, MOE_HIDDEN, D), jnp.float32) * MOE_HIDDEN ** -0.5,
    }


def reference(x, rel_bias, norm1_g, w_in, conv_w, conv_b, dt_bias, a_log, d_skip, ssd_norm_g,
              q_norm_g, k_norm_g, w_out, norm2_g, w_r1, b_r1, w_r2, b_r2, w_gate, w_up, w_down):
    cuts = [SSD_INNER, SSD_INNER + CONV_CH, SSD_INNER + CONV_CH + SSD_HEADS,
            SSD_INNER + CONV_CH + SSD_HEADS + ATT_INNER,
            SSD_INNER + CONV_CH + SSD_HEADS + 2 * ATT_INNER]
    h = x
    for l in range(DEPTH):
        u = jnp.matmul(rmsnorm(h, norm1_g[l]), w_in[l])
        z, xbc, dt_raw, q, k, v = jnp.split(u, cuts, axis=-1)
        y_ssd = ssd_mixer(z, xbc, dt_raw, conv_w[l], conv_b[l], dt_bias[l], a_log[l],
                          d_skip[l], ssd_norm_g[l])
        y_att = moba_attention(q, k, v, q_norm_g[l], k_norm_g[l], rel_bias)
        h = h + jnp.matmul(jnp.concatenate([y_ssd, y_att], axis=-1), w_out[l])
        h = h + hier_moe(rmsnorm(h, norm2_g[l]), w_r1[l], b_r1[l], w_r2[l], b_r2[l],
                         w_gate[l], w_up[l], w_down[l])
    return h
```

```cpp
#include <hip/hip_runtime.h>
#include <cstdio>
#include <cstdint>
namespace pg8 {
#define PG8_LAS __attribute__((address_space(3)))
typedef unsigned short bf16_t;
typedef short bf16x8 __attribute__((ext_vector_type(8)));
typedef float f32x4 __attribute__((ext_vector_type(4)));
typedef unsigned u32x4 __attribute__((ext_vector_type(4)));
constexpr int BM = 256, BK = 64, HALF = 128, HTB = HALF * BK * 2  , STAGE_BYTES = 8 * HTB, NXCD = 8, WGM = 8;

__host__ __device__ __forceinline__ int lds_byte(int r, int c) { const int st = (r >> 4) * 2 + (c >> 5), rr = r & 15, cc = c & 31, ob = rr * 64 + cc * 2; return st * 1024 + (ob ^ (((ob >> 9) & 1) << 5)); }
__host__ __device__ __forceinline__ void stage_rc(int b, int& R, int& C) { const int st = b / 1024, sb = b % 1024, swz = sb ^ (((sb >> 9) & 1) << 5); R = (st >> 1) * 16 + swz / 64; C = (st & 1) * 32 + (swz % 64) / 2; }
__host__ __device__ __forceinline__ int perm32(int rho) { const int n = rho >> 4, i = rho & 15; return 8 * (i >> 2) + 4 * n + (i & 3); }

struct Unit { int pm, pn; };
struct Gemm { const bf16_t* A; const bf16_t* Bt; int M, N, K; };

struct StaticOrder {
    int nM, nN, nwg, G, c;
    __host__ __device__ void init(int M, int N, int G_, int c_) { nM = M / BM; nN = N / BM; nwg = nM * nN; G = G_; c = c_; }
    __host__ __device__ bool next(int i, Unit& u) const {
        const long L = (long)i * G + c; if (L >= nwg) return false;
        int wgid = (int)L; { const int q = nwg / NXCD, r = nwg % NXCD, xcd = wgid % NXCD, off = wgid / NXCD; wgid = (xcd < r ? xcd * (q + 1) : r * (q + 1) + (xcd - r) * q) + off; }
        const int nig = WGM * nN, gid = wgid / nig, fm = gid * WGM, gsz = (nM - fm) < WGM ? (nM - fm) : WGM;
        u.pm = fm + ((wgid % nig) % gsz); u.pn = (wgid % nig) / gsz; return true;
    }
    __device__ __forceinline__ void a_ready(const Unit&) const {}
    __device__ __forceinline__ void done(const Unit&) const {}
};

__device__ __forceinline__ unsigned cvt_pk_bf16(float lo, float hi) { unsigned r; asm volatile("v_cvt_pk_bf16_f32 %0, %1, %2" : "=v"(r) : "v"(lo), "v"(hi)); return r; }
typedef float f32x2 __attribute__((ext_vector_type(2)));
__device__ __forceinline__ float silu_f(float x) { return x * __builtin_amdgcn_rcpf(1.0f + __builtin_amdgcn_exp2f(-1.4426950408889634f * x)); }

struct EpiInProj {
    static constexpr bool PERM = true, AFTER_DRAIN = false;
    bf16_t* z; bf16_t* xbc; bf16_t* q; bf16_t* k; bf16_t* v; float* dt; float* ksum;
    const float* qg; const float* kg; float qscale; float eps;
    __device__ __forceinline__ void operator()(const f32x4 (&acc)[2][2][4][2], const Unit& u, int wr, int wc, int fr, int fq) const {
        const int pn = u.pn; const int row0 = u.pm * BM + wr * 64 + fr;
        if (pn <= 4 || pn == 9 || pn == 10) {
            bf16_t* base; int ldc, colt;
            if (pn <= 1) { base = z; ldc = 512; colt = pn * 256; } else if (pn <= 4) { base = xbc; ldc = 768; colt = (pn - 2) * 256; } else { base = v; ldc = 512; colt = (pn - 9) * 256; }
            const int col0 = colt + wc * 32 + 8 * fq;
#pragma unroll
            for (int ai = 0; ai < 2; ++ai)
#pragma unroll
                for (int m = 0; m < 4; ++m) { bf16_t* rowp = base + (size_t)(row0 + ai * HALF + m * 16) * ldc + col0;
#pragma unroll
                    for (int bj = 0; bj < 2; ++bj) { const f32x4 v0 = acc[ai][bj][m][0], v1 = acc[ai][bj][m][1];
                        u32x4 w; w.x = cvt_pk_bf16(v0[0], v0[1]); w.y = cvt_pk_bf16(v0[2], v0[3]); w.z = cvt_pk_bf16(v1[0], v1[1]); w.w = cvt_pk_bf16(v1[2], v1[3]);
                        *(u32x4*)(rowp + bj * HALF) = w; } }
        } else if (pn <= 8) {
            const bool isk = (pn >= 7); const int hh = 4 * ((pn - 5) & 1) + wc;
            const float* g = (isk ? kg : qg) + 8 * fq; bf16_t* base = isk ? k : q; const float sc = isk ? 1.0f : qscale;
            f32x4 cs[2][2];
#pragma unroll
            for (int bj = 0; bj < 2; ++bj)
#pragma unroll
                for (int n = 0; n < 2; ++n) cs[bj][n] = (f32x4){0.f, 0.f, 0.f, 0.f};
#pragma unroll
            for (int ai = 0; ai < 2; ++ai)
#pragma unroll
                for (int m = 0; m < 4; ++m) {
                    float ss = 0.f;
#pragma unroll
                    for (int bj = 0; bj < 2; ++bj)
#pragma unroll
                        for (int n = 0; n < 2; ++n) { const f32x4 x = acc[ai][bj][m][n]; ss += (x[0] * x[0] + x[1] * x[1]) + (x[2] * x[2] + x[3] * x[3]); }
                    ss += __shfl_xor(ss, 16); ss += __shfl_xor(ss, 32);
                    const float rs = sc / sqrtf(ss * (1.0f / 64.0f) + eps);
                    bf16_t* rowp = base + (size_t)(row0 + ai * HALF + m * 16) * 512 + hh * 64 + 8 * fq;
#pragma unroll
                    for (int bj = 0; bj < 2; ++bj) { const f32x4 g0 = *(const f32x4*)(g + 32 * bj), g1 = *(const f32x4*)(g + 32 * bj + 4);
                        const f32x4 v0 = acc[ai][bj][m][0] * rs * g0, v1 = acc[ai][bj][m][1] * rs * g1;
                        if (isk) { cs[bj][0] += v0; cs[bj][1] += v1; }
                        u32x4 w; w.x = cvt_pk_bf16(v0[0], v0[1]); w.y = cvt_pk_bf16(v0[2], v0[3]); w.z = cvt_pk_bf16(v1[0], v1[1]); w.w = cvt_pk_bf16(v1[2], v1[3]);
                        *(u32x4*)(rowp + bj * 32) = w; }
                    asm volatile("" : "+v"(cs[0][0]), "+v"(cs[0][1]), "+v"(cs[1][0]), "+v"(cs[1][1]) :: "memory");
                }
            if (isk) {
                float* kb = ksum + ((size_t)(u.pm >> 4) * 8 + hh) * 16 * 64 + (size_t)(u.pm & 15) * 64;
#pragma unroll
                for (int bj = 0; bj < 2; ++bj)
#pragma unroll
                    for (int n = 0; n < 2; ++n)
#pragma unroll
                        for (int j = 0; j < 4; ++j) { float s = cs[bj][n][j];
                            s += __shfl_xor(s, 1); s += __shfl_xor(s, 2); s += __shfl_xor(s, 4); s += __shfl_xor(s, 8);
                            if (fr == 0) atomicAdd(kb + 32 * bj + 8 * fq + 4 * n + j, s); }
            }
        } else {
            if (wc == 0 && fq == 0) {
#pragma unroll
                for (int ai = 0; ai < 2; ++ai)
#pragma unroll
                    for (int m = 0; m < 4; ++m) { float* rowp = dt + (size_t)(row0 + ai * HALF + m * 16) * 8;
                        *(f32x4*)(rowp) = acc[ai][0][m][0]; *(f32x4*)(rowp + 4) = acc[ai][0][m][1]; }
            }
        }
    }
};

struct EpiResid {
    static constexpr bool PERM = false, AFTER_DRAIN = false;
    const float* resid; float* out; int ldc;
    __device__ __forceinline__ void operator()(const f32x4 (&acc)[2][2][4][2], const Unit& u, int wr, int wc, int fr, int fq) const {
        const int row0 = u.pm * BM + wr * 64 + fr, col0 = u.pn * BM + wc * 32 + 4 * fq;
#pragma unroll
        for (int ai = 0; ai < 2; ++ai)
#pragma unroll
            for (int m = 0; m < 4; ++m) { const size_t off = (size_t)(row0 + ai * HALF + m * 16) * ldc + col0;
#pragma unroll
                for (int bj = 0; bj < 2; ++bj)
#pragma unroll
                    for (int n = 0; n < 2; ++n) { const f32x4 r = *(const f32x4*)(resid + off + bj * HALF + n * 16); *(f32x4*)(out + off + bj * HALF + n * 16) = acc[ai][bj][m][n] + r; } }
    }
};

struct EpiSwiGLU {
    static constexpr bool PERM = true, AFTER_DRAIN = false;
    bf16_t* hmid;
    __device__ __forceinline__ void operator()(const f32x4 (&acc)[2][2][4][2], const Unit& u, int wr, int wc, int fr, int fq) const {
        const int row0 = u.pm * BM + wr * 64 + fr, col0 = (u.pn & 3) * 128 + wc * 32 + 8 * fq;
#pragma unroll
        for (int ai = 0; ai < 2; ++ai)
#pragma unroll
            for (int m = 0; m < 4; ++m) { bf16_t* rowp = hmid + (size_t)(row0 + ai * HALF + m * 16) * 512 + col0;
                const f32x4 g0 = acc[ai][0][m][0], g1 = acc[ai][0][m][1], u0 = acc[ai][1][m][0], u1 = acc[ai][1][m][1];
                float r[8];
#pragma unroll
                for (int j = 0; j < 4; ++j) { r[j] = silu_f(g0[j]) * u0[j]; r[4 + j] = silu_f(g1[j]) * u1[j]; }
                u32x4 w; w.x = cvt_pk_bf16(r[0], r[1]); w.y = cvt_pk_bf16(r[2], r[3]); w.z = cvt_pk_bf16(r[4], r[5]); w.w = cvt_pk_bf16(r[6], r[7]);
                *(u32x4*)rowp = w; }
    }
};

struct EpiDown {
    static constexpr bool PERM = true, AFTER_DRAIN = false;
    bf16_t* y; const float* gate;
    __device__ __forceinline__ void operator()(const f32x4 (&acc)[2][2][4][2], const Unit& u, int wr, int wc, int fr, int fq) const {
        const int row0 = u.pm * BM + wr * 64 + fr, col0 = (u.pn & 3) * BM + wc * 32 + 8 * fq;
#pragma unroll
        for (int ai = 0; ai < 2; ++ai)
#pragma unroll
            for (int m = 0; m < 4; ++m) { const int row = row0 + ai * HALF + m * 16; const float gt = gate[row]; bf16_t* rowp = y + (size_t)row * 1024 + col0;
#pragma unroll
                for (int bj = 0; bj < 2; ++bj) { const f32x4 v0 = acc[ai][bj][m][0] * gt, v1 = acc[ai][bj][m][1] * gt;
                    u32x4 w; w.x = cvt_pk_bf16(v0[0], v0[1]); w.y = cvt_pk_bf16(v0[2], v0[3]); w.z = cvt_pk_bf16(v1[0], v1[1]); w.w = cvt_pk_bf16(v1[2], v1[3]);
                    *(u32x4*)(rowp + bj * HALF) = w; } }
    }
};

struct MoeOrder {
    const unsigned* tile_e; int nunits, c;
    __device__ __forceinline__ bool next(int i, Unit& u) const {
        const int L = (i * 8 + (c & 7)) * 32 + (c >> 3); if (L >= nunits) return false;
        const int rt = L >> 2; const int e = __builtin_amdgcn_readfirstlane((int)__hip_atomic_load(tile_e + rt, __ATOMIC_RELAXED, __HIP_MEMORY_SCOPE_AGENT));
        u.pm = rt; u.pn = e * 4 + (L & 3); return true;
    }
    __device__ __forceinline__ void a_ready(const Unit&) const {}
    __device__ __forceinline__ void done(const Unit&) const {}
};

template <class Epi, class Sched, bool ALIGN_EPI = false, bool SP2 = false>
__device__ __forceinline__ void gemm_phase(PG8_LAS unsigned char* lds, const Gemm g, const Sched& S, const Epi& E) {
    const int tid = threadIdx.x, wid = __builtin_amdgcn_readfirstlane(tid >> 6), lane = tid & 63, wr = wid >> 2, wc = wid & 3, fr = lane & 15, fq = lane >> 4;
    const int K = g.K, nt = K / BK;
    unsigned voffA[2], voffB[2];
#pragma unroll
    for (int i = 0; i < 2; ++i) { int R, C; stage_rc(tid * 16 + i * 8192, R, C); const int Rb = Epi::PERM ? ((R & ~31) + perm32(R & 31)) : R;
        voffA[i] = (unsigned)(R * K + C) * 2u; voffB[i] = (unsigned)(Rb * K + C) * 2u; }
    const size_t kstep = (size_t)(BK * 2);
    const size_t hstep = (size_t)HALF * K * 2;
    const size_t tstep = 2 * hstep;
    const unsigned ldsw = (unsigned)wid * 1024u;
    const int aoff = lds_byte(wr * 64 + fr, fq * 8), boff = lds_byte(wc * 32 + fr, fq * 8);
#define PG8_SA(b, h) (((b) * 2 + (h)) * HTB)
#define PG8_SB(b, h) ((4 + (b) * 2 + (h)) * HTB)
#define PG8_STAGE(bufoff, gbase, voff) do { _Pragma("unroll") for (int _i = 0; _i < 2; ++_i) \
        __builtin_amdgcn_global_load_lds((const unsigned*)((const char*)(gbase) + (voff)[_i]), (PG8_LAS unsigned*)(lds + (bufoff) + ldsw + _i * 8192), 16, 0, 0); } while (0)
#define PG8_LDA(dst, b, h) do { _Pragma("unroll") for (int m = 0; m < 4; ++m) _Pragma("unroll") for (int k = 0; k < 2; ++k) dst[m][k] = *(const PG8_LAS bf16x8*)(lds + PG8_SA(b, h) + aoff + m * 2048 + k * 1024); } while (0)
#define PG8_LDB(dst, b, h) do { _Pragma("unroll") for (int n = 0; n < 2; ++n) _Pragma("unroll") for (int k = 0; k < 2; ++k) dst[n][k] = *(const PG8_LAS bf16x8*)(lds + PG8_SB(b, h) + boff + n * 2048 + k * 1024); } while (0)
#define PG8_MMA(ai, bj, At, Bt) do { __builtin_amdgcn_s_setprio(1); _Pragma("unroll") for (int m = 0; m < 4; ++m) _Pragma("unroll") for (int n = 0; n < 2; ++n) _Pragma("unroll") for (int k = 0; k < 2; ++k) \
        acc[ai][bj][m][n] = __builtin_amdgcn_mfma_f32_16x16x32_bf16(Bt[n][k], At[m][k], acc[ai][bj][m][n], 0, 0, 0); __builtin_amdgcn_s_setprio(0); } while (0)
#define PG8_WAIT_V(n) asm volatile("s_waitcnt vmcnt(" #n ")" ::: "memory")
#define PG8_WAIT_L(n) asm volatile("s_waitcnt lgkmcnt(" #n ")" ::: "memory")
#define PG8_BAR __builtin_amdgcn_s_barrier()
#define PG8_SCHED __builtin_amdgcn_sched_barrier(0)
    Unit cur, nxt; int ui = 0;
    if (!S.next(0, cur)) return;
    f32x4 acc[2][2][4][2];
#pragma unroll
    for (int a = 0; a < 2; ++a)
#pragma unroll
        for (int b = 0; b < 2; ++b)
#pragma unroll
            for (int m = 0; m < 4; ++m)
#pragma unroll
                for (int n = 0; n < 2; ++n) acc[a][b][m][n] = (f32x4){0.f, 0.f, 0.f, 0.f};
    bf16x8 At[4][2], B0[2][2], B1[2][2];
    const char* cA = (const char*)g.A + (size_t)cur.pm * tstep; const char* cB = (const char*)g.Bt + (size_t)cur.pn * tstep;
    S.a_ready(cur);
    if constexpr (SP2) {
        PG8_STAGE(PG8_SB(0, 0), cB, voffB); PG8_STAGE(PG8_SB(0, 1), cB + hstep, voffB); PG8_STAGE(PG8_SA(0, 0), cA, voffA); PG8_STAGE(PG8_SA(0, 1), cA + hstep, voffA);
        if (wr == 1) PG8_BAR;
        PG8_WAIT_V(2); PG8_BAR;
        PG8_STAGE(PG8_SB(1, 0), cB + kstep, voffB); PG8_STAGE(PG8_SA(1, 0), cA + kstep, voffA); PG8_STAGE(PG8_SB(1, 1), cB + hstep + kstep, voffB);
        PG8_WAIT_V(6); PG8_BAR;
    } else {
        PG8_STAGE(PG8_SB(0, 0), cB, voffB); PG8_STAGE(PG8_SA(0, 0), cA, voffA); PG8_STAGE(PG8_SB(0, 1), cB + hstep, voffB); PG8_STAGE(PG8_SA(0, 1), cA + hstep, voffA);
        if (wr == 1) PG8_BAR;
        PG8_WAIT_V(4); PG8_BAR;
        PG8_STAGE(PG8_SB(1, 0), cB + kstep, voffB); PG8_STAGE(PG8_SA(1, 0), cA + kstep, voffA); PG8_STAGE(PG8_SB(1, 1), cB + hstep + kstep, voffB);
        PG8_WAIT_V(6); PG8_BAR;
    }
    for (;;) {
        const bool has_next = S.next(ui + 1, nxt);
        const char* nA = has_next ? (const char*)g.A + (size_t)nxt.pm * tstep : cA; const char* nB = has_next ? (const char*)g.Bt + (size_t)nxt.pn * tstep : cB;
        for (int t = 0; t < nt; t += 2) {
            const bool last = (t == nt - 2);
            const char* a1 = cA + (size_t)(t + 1) * kstep;
            const char* a2 = last ? nA : cA + (size_t)(t + 2) * kstep; const char* b2 = last ? nB : cB + (size_t)(t + 2) * kstep;
            const char* a3 = a2 + kstep; const char* b3 = b2 + kstep;
            if (last && has_next) S.a_ready(nxt);
            if constexpr (SP2) {
            PG8_LDB(B0, 0, 0); PG8_LDB(B1, 0, 1); PG8_SCHED; PG8_LDA(At, 0, 0); PG8_STAGE(PG8_SA(1, 1), a1 + hstep, voffA);
            PG8_WAIT_V(8); PG8_WAIT_L(0); PG8_BAR; PG8_MMA(0, 0, At, B0); PG8_MMA(0, 1, At, B1); PG8_BAR; PG8_SCHED;
            PG8_LDA(At, 0, 1); PG8_STAGE(PG8_SB(0, 0), b2, voffB); PG8_STAGE(PG8_SB(0, 1), b2 + hstep, voffB); PG8_STAGE(PG8_SA(0, 0), a2, voffA);
            PG8_WAIT_V(8); PG8_WAIT_L(0); PG8_BAR; PG8_MMA(1, 0, At, B0); PG8_MMA(1, 1, At, B1); PG8_BAR; PG8_SCHED;
            PG8_LDB(B0, 1, 0); PG8_LDB(B1, 1, 1); PG8_SCHED; PG8_LDA(At, 1, 0); PG8_STAGE(PG8_SA(0, 1), a2 + hstep, voffA);
            PG8_WAIT_V(8); PG8_WAIT_L(0); PG8_BAR; PG8_MMA(0, 0, At, B0); PG8_MMA(0, 1, At, B1); PG8_BAR; PG8_SCHED;
            PG8_LDA(At, 1, 1); PG8_STAGE(PG8_SB(1, 0), b3, voffB); PG8_STAGE(PG8_SB(1, 1), b3 + hstep, voffB); PG8_STAGE(PG8_SA(1, 0), a3, voffA);
            PG8_WAIT_V(8); PG8_WAIT_L(0); PG8_BAR; PG8_MMA(1, 0, At, B0); PG8_MMA(1, 1, At, B1); PG8_BAR; PG8_SCHED;
            } else {
            PG8_LDB(B0, 0, 0); PG8_SCHED; PG8_LDA(At, 0, 0); PG8_STAGE(PG8_SA(1, 1), a1 + hstep, voffA);
            PG8_WAIT_L(8); PG8_BAR; PG8_WAIT_L(0); PG8_MMA(0, 0, At, B0); PG8_BAR; PG8_SCHED;
            PG8_LDB(B1, 0, 1); PG8_STAGE(PG8_SB(0, 0), b2, voffB);
            PG8_BAR; PG8_WAIT_L(0); PG8_MMA(0, 1, At, B1); PG8_BAR;
            PG8_LDA(At, 0, 1); PG8_STAGE(PG8_SA(0, 0), a2, voffA);
            PG8_BAR; PG8_WAIT_L(0); PG8_MMA(1, 0, At, B0); PG8_BAR; PG8_SCHED;
            PG8_STAGE(PG8_SB(0, 1), b2 + hstep, voffB);
            PG8_WAIT_V(6); PG8_BAR; PG8_MMA(1, 1, At, B1); PG8_BAR;
            PG8_LDB(B0, 1, 0); PG8_SCHED; PG8_LDA(At, 1, 0); PG8_STAGE(PG8_SA(0, 1), a2 + hstep, voffA);
            PG8_WAIT_L(8); PG8_BAR; PG8_WAIT_L(0); PG8_MMA(0, 0, At, B0); PG8_BAR; PG8_SCHED;
            PG8_LDB(B1, 1, 1); PG8_STAGE(PG8_SB(1, 0), b3, voffB);
            PG8_BAR; PG8_WAIT_L(0); PG8_MMA(0, 1, At, B1); PG8_BAR;
            PG8_LDA(At, 1, 1); PG8_STAGE(PG8_SA(1, 0), a3, voffA);
            PG8_BAR; PG8_WAIT_L(0); PG8_MMA(1, 0, At, B0); PG8_BAR; PG8_SCHED;
            PG8_STAGE(PG8_SB(1, 1), b3 + hstep, voffB);
            PG8_WAIT_V(6); PG8_BAR; PG8_MMA(1, 1, At, B1); PG8_BAR;
            }
        }
        if constexpr (ALIGN_EPI) { if (wr == 0) PG8_BAR; }
        if constexpr (!Epi::AFTER_DRAIN) { E(acc, cur, wr, wc, fr, fq); S.done(cur); }
        if (!has_next) break;
#pragma unroll
        for (int a = 0; a < 2; ++a)
#pragma unroll
            for (int b = 0; b < 2; ++b)
#pragma unroll
                for (int m = 0; m < 4; ++m)
#pragma unroll
                    for (int n = 0; n < 2; ++n) acc[a][b][m][n] = (f32x4){0.f, 0.f, 0.f, 0.f};
        cur = nxt; cA = nA; cB = nB; ++ui;
        if constexpr (ALIGN_EPI) { if (wr == 1) PG8_BAR; }
    }
    PG8_WAIT_V(0);
    if constexpr (!ALIGN_EPI) { if (wr == 0) PG8_BAR; }
    PG8_BAR;
    if constexpr (Epi::AFTER_DRAIN) { E.fused(acc, cur, wr, wc, fr, fq, lds, wid, lane); S.done(cur); }
#undef PG8_SA
#undef PG8_SB
#undef PG8_STAGE
#undef PG8_LDA
#undef PG8_LDB
#undef PG8_MMA
#undef PG8_WAIT_V
#undef PG8_WAIT_L
#undef PG8_BAR
#undef PG8_SCHED
}
}
constexpr int NWAVES = 8, NTHREADS = 512;
constexpr int NB = 8, SEQ = 4096, T = NB * SEQ, D = 1024, DEPTH = 2;
constexpr int NH = 8, HD = 64, DI = 512, CCH = 768, NIN = 3072, INCOLS = 2824;
constexpr int NE = 32, HID = 512, PMAX = 2 * T + NE * 256;
constexpr int MB = 256, NMB = SEQ / MB;
constexpr float EPS = 1e-6f, LOG2E = 1.4426950408889634f, C2 = 0.125f * LOG2E;
constexpr int GRID = 256;

constexpr size_t MiB = 1u << 20;
constexpr size_t WS_CTL = 0, CTL_ZERO_BYTES = 1 * MiB;
constexpr size_t WS_WIN = 1 * MiB;
constexpr size_t WS_WOUT = 13 * MiB;
constexpr size_t WS_WGU = 17 * MiB;
constexpr size_t WS_WD = 145 * MiB;
constexpr size_t WS_WR = 209 * MiB;
constexpr size_t WS_TB = WS_WR + 512 * 1024;
constexpr size_t WS_ROUTE = 210 * MiB;
constexpr size_t WS_GSLOT = 211 * MiB;
constexpr size_t WS_BBASE = WS_GSLOT + 512 * 1024;
constexpr size_t WS_TILEE = WS_BBASE + 64 * 1024;
constexpr size_t WS_XN = 212 * MiB;
constexpr size_t WS_R1 = 276 * MiB;
constexpr size_t R1_Z = WS_R1, R1_XBC = WS_R1 + 32 * MiB, R1_Q = WS_R1 + 80 * MiB, R1_K = WS_R1 + 112 * MiB, R1_V = WS_R1 + 144 * MiB, R1_YMIX = WS_R1 + 176 * MiB, R1_DT = WS_R1 + 240 * MiB;
constexpr size_t R1_XG = WS_R1, R1_HMID = WS_R1 + 144 * MiB;
constexpr size_t WS_END = WS_R1 + 241 * MiB;
static_assert((size_t)PMAX * 2048 <= 144 * MiB && (size_t)PMAX * 1024 <= 72 * MiB && R1_HMID + 72 * MiB <= WS_END, "R1 map");
constexpr int CW_BAR = 4096;
constexpr int CW_CNT = 8192;
constexpr int CW_KSUM = 65536;
static_assert((CW_KSUM + 2 * 65536) * 4 <= (int)CTL_ZERO_BYTES && CW_CNT + 64 * 64 <= CW_KSUM, "CTL map");

constexpr int RING_BYTES = 131072, MISC_OFF = RING_BYTES + 320, LDS_BYTES = 147456;

#define GAS __attribute__((address_space(1)))
#define LAS __attribute__((address_space(3)))
typedef unsigned short bf16;
typedef unsigned v4u __attribute__((ext_vector_type(4)));
typedef unsigned v2u __attribute__((ext_vector_type(2)));
typedef float f32x4 __attribute__((ext_vector_type(4)));
typedef GAS unsigned gu32;
#define RLX_AGENT __ATOMIC_RELAXED, __HIP_MEMORY_SCOPE_AGENT
#define LDS_WAIT() asm volatile("s_waitcnt lgkmcnt(0)" ::: "memory")
__device__ __forceinline__ unsigned f2bf(float f) { unsigned u = __builtin_bit_cast(unsigned, f); return (u + 0x7fffu + ((u >> 16) & 1u)) >> 16; }
__device__ __forceinline__ unsigned pk2(float lo, float hi) { return f2bf(lo) | (f2bf(hi) << 16); }
__device__ __forceinline__ float bflo(unsigned w) { return __builtin_bit_cast(float, w << 16); }
__device__ __forceinline__ float bfhi(unsigned w) { return __builtin_bit_cast(float, w & 0xffff0000u); }
__device__ __forceinline__ float bf1(bf16 b) { return __builtin_bit_cast(float, (unsigned)b << 16); }
__device__ __forceinline__ unsigned ald(const unsigned* p) { return __hip_atomic_load(p, __ATOMIC_RELAXED, __HIP_MEMORY_SCOPE_AGENT); }

#define XB_TMO      128
#define XB_XCNT(j)  (256  + 64 * (j))
#define XB_XSUB(j)  (1280 + 64 * (j))
#define XB_XGEN(j)  (2304 + 64 * (j))
#define XB_TOP      3328
#define XB_TOPGEN   3392
#define XCD_BAR_WORDS 3456
#define XB_SPIN_CAP (1u << 18)

__device__ __forceinline__ unsigned xb_ld(unsigned* p)              { return __hip_atomic_load(p, __ATOMIC_RELAXED, __HIP_MEMORY_SCOPE_AGENT); }
__device__ __forceinline__ unsigned xb_add(unsigned* p, unsigned v) { return __hip_atomic_fetch_add(p, v, __ATOMIC_RELAXED, __HIP_MEMORY_SCOPE_AGENT); }
__device__ __forceinline__ unsigned xb_xcc_id() { return (unsigned)__builtin_amdgcn_s_getreg((3 << 11) | 20) & 0xFu; }
#define XB_SPIN(cond, bar) do { unsigned _sp = 0; while (cond) { __builtin_amdgcn_s_sleep(1); \
    if ((++_sp & 255u) == 0u) { if (xb_ld(&(bar)[XB_TMO])) break; if (_sp > XB_SPIN_CAP) { atomicAdd(&(bar)[XB_TMO], 1u); break; } } } } while (0)

struct XcdBarrier {
    unsigned* bar; unsigned x;
    volatile LAS unsigned* st;
};

__device__ __forceinline__ XcdBarrier xcd_barrier_post(unsigned* bar, volatile LAS unsigned* st) {
    XcdBarrier b; b.bar = bar; b.x = xb_xcc_id(); b.st = st;
    if (threadIdx.x == 0) (void)xb_add(&bar[XB_XCNT(b.x)], 1u);
    return b;
}
__device__ __forceinline__ void xcd_barrier_complete(unsigned* bar, unsigned x, unsigned& nloc, unsigned& nx) {
    const unsigned G = gridDim.x * gridDim.y * gridDim.z;
    unsigned sum, cnt, mine, sp = 0u;
    for (;;) {
        sum = 0u; cnt = 0u; mine = 0u;
#pragma unroll
        for (unsigned j = 0; j < 16; ++j) { const unsigned c = xb_ld(&bar[XB_XCNT(j)]); sum += c; cnt += (c > 0u) ? 1u : 0u; mine = (j == x) ? c : mine; }
        if (sum == G) break;
        __builtin_amdgcn_s_sleep(1);
        if ((++sp & 255u) == 0u) { if (xb_ld(&bar[XB_TMO])) break; if (sp > XB_SPIN_CAP) { atomicAdd(&bar[XB_TMO], 1u); break; } }
    }
    nloc = mine > 0u ? mine : 1u; nx = cnt > 0u ? cnt : 1u;
}

__device__ __forceinline__ void xcd_barrier(const XcdBarrier& b) {
    asm volatile("s_waitcnt vmcnt(0)" ::: "memory");
    __syncthreads();
    if (threadIdx.x == 0) {
        unsigned* bar = b.bar;
        __builtin_amdgcn_s_waitcnt(0);
        unsigned nloc = b.st[0], nx = b.st[1];
        if (nloc == 0u) { xcd_barrier_complete(bar, b.x, nloc, nx); b.st[0] = nloc; b.st[1] = nx; }
        const unsigned old = xb_add(&bar[XB_XSUB(b.x)], 1u);
        const unsigned gen = old / nloc;
        if (old + 1u == (gen + 1u) * nloc) {
            __builtin_amdgcn_fence(__ATOMIC_RELEASE, "agent");
            asm volatile("s_waitcnt vmcnt(0)" ::: "memory");
            const unsigned og = xb_add(&bar[XB_TOP], 1u);
            const unsigned tg = og / nx;
            if (og + 1u == (tg + 1u) * nx) xb_add(&bar[XB_TOPGEN], 1u);
            else XB_SPIN(xb_ld(&bar[XB_TOPGEN]) == tg, bar);
            __builtin_amdgcn_fence(__ATOMIC_ACQUIRE, "agent");
            xb_add(&bar[XB_XGEN(b.x)], 1u);
            asm volatile("s_waitcnt vmcnt(0)" ::: "memory");
        } else {
            XB_SPIN(xb_ld(&bar[XB_XGEN(b.x)]) == gen, bar);
            __builtin_amdgcn_fence(__ATOMIC_ACQUIRE, "agent");
            asm volatile("s_waitcnt vmcnt(0)" ::: "memory");
        }
    }
    __syncthreads();
}
struct Frame {
    LAS unsigned char* lds; volatile LAS unsigned* MISC; unsigned* ctl; unsigned char* ws;
    int tid, lane, wave, G, blk;
    const float* in[21]; float* out;
};
constexpr int CW_WQ = 2048;
__device__ __forceinline__ unsigned char* wsp(const Frame& F) { return F.ws; }

__device__ __forceinline__ float wave_sum(float v) {
#pragma unroll
    for (int o = 1; o < 64; o <<= 1) v += __shfl_xor(v, o);
    return v;
}
__device__ __forceinline__ float wave_max(float v) {
#pragma unroll
    for (int o = 1; o < 64; o <<= 1) v = fmaxf(v, __shfl_xor(v, o));
    return v;
}

__device__ __forceinline__ void tr_item(const float* W, int ldn, int k0, int c0, int nvalid, bf16* WT, int ldk, int drow0, const float* kscale, LAS float* scr, int lane) {
    const int col = lane & 31;
#pragma unroll 8
    for (int i = 0; i < 32; ++i) { const int kk = 2 * i + (lane >> 5); float v = (col < nvalid) ? W[(size_t)(k0 + kk) * ldn + c0 + col] : 0.f; if (kscale) v *= kscale[k0 + kk]; scr[kk * 33 + col] = v; }
    LDS_WAIT(); asm volatile("" ::: "memory");
    const int c = lane & 7;
#pragma unroll
    for (int j = 0; j < 4; ++j) { const int n = (lane >> 3) + 8 * j; const LAS float* s = scr + (8 * c) * 33 + n;
        v4u o; o.x = pk2(s[0 * 33], s[1 * 33]); o.y = pk2(s[2 * 33], s[3 * 33]); o.z = pk2(s[4 * 33], s[5 * 33]); o.w = pk2(s[6 * 33], s[7 * 33]);
        if (n < nvalid) *(v4u*)(WT + (size_t)(drow0 + n) * ldk + k0 + 8 * c) = o; }
    LDS_WAIT(); asm volatile("" ::: "memory");
}
constexpr int IT_IN = 16 * 89, IT_OUT = 512, IT_G = 8192, IT_LAYER = IT_IN + IT_OUT + 3 * IT_G;
__device__ __forceinline__ void prologue_item(Frame& F, int it, LAS float* scr) {
    unsigned char* const W_ = wsp(F);
    const int l = it / IT_LAYER; int r = it % IT_LAYER;
    bf16* Win_t = (bf16*)(W_ + WS_WIN) + (size_t)l * NIN * 1024; bf16* Wout_t = (bf16*)(W_ + WS_WOUT) + (size_t)l * 1024 * 1024;
    bf16* Wgu_t = (bf16*)(W_ + WS_WGU) + (size_t)l * 32 * 1024 * 1024; bf16* Wd_t = (bf16*)(W_ + WS_WD) + (size_t)l * 32 * 1024 * 512;
    if (r < IT_IN) { const int kb = r / 89, cb = r % 89; int c0, nv = 32, drow0;
        if (cb < 16) { c0 = 32 * cb; drow0 = 32 * cb; }
        else if (cb < 40) { c0 = 512 + 32 * (cb - 16); drow0 = c0; }
        else if (cb == 40) { c0 = 1280; nv = 8; drow0 = 2816; }
        else if (cb < 57) { const int j = cb - 41, hd = j >> 1; c0 = 1288 + 32 * j; drow0 = 256 * (5 + (hd >> 2)) + 128 * (j & 1) + 32 * (hd & 3); }
        else if (cb < 73) { const int j = cb - 57, hd = j >> 1; c0 = 1800 + 32 * j; drow0 = 256 * (7 + (hd >> 2)) + 128 * (j & 1) + 32 * (hd & 3); }
        else { const int j = cb - 73; c0 = 2312 + 32 * j; drow0 = 2304 + 32 * j; }
        tr_item(F.in[3] + (size_t)l * 1024 * INCOLS, INCOLS, 64 * kb, c0, nv, Win_t, 1024, drow0, nullptr, scr, F.lane); return; }
    r -= IT_IN;
    if (r < IT_OUT) { const int kb = r >> 5, nb = r & 31;
        tr_item(F.in[12] + (size_t)l * 1024 * 1024, 1024, 64 * kb, 32 * nb, 32, Wout_t, 1024, 32 * nb, (kb < 8) ? F.in[9] + l * 512 : nullptr, scr, F.lane); return; }
    r -= IT_OUT;
    if (r < 2 * IT_G) { const int up = r >= IT_G; if (up) r -= IT_G; const int e = r >> 8, q = r & 255, kb = q >> 4, nb = q & 15;
        tr_item(F.in[up ? 19 : 18] + (size_t)(l * 32 + e) * 1024 * 512, 512, 64 * kb, 32 * nb, 32, Wgu_t + (size_t)e * 1024 * 1024, 1024, 256 * (nb >> 2) + 128 * up + 32 * (nb & 3), nullptr, scr, F.lane); return; }
    r -= 2 * IT_G;
    { const int e = r >> 8, q = r & 255, kb = q >> 5, nb = q & 31;
        tr_item(F.in[20] + (size_t)(l * 32 + e) * 512 * 1024, 1024, 64 * kb, 32 * nb, 32, Wd_t + (size_t)e * 1024 * 512, 512, 32 * nb, nullptr, scr, F.lane); }
}
__device__ __forceinline__ void rms_row_store(const f32x4 (&v)[4], const float* g, bf16* orow, int lane) {
    float s = 0.f;
#pragma unroll
    for (int j = 0; j < 4; ++j) s += (v[j].x * v[j].x + v[j].y * v[j].y) + (v[j].z * v[j].z + v[j].w * v[j].w);
    const float rs = 1.0f / sqrtf(wave_sum(s) * (1.0f / D) + EPS);
#pragma unroll
    for (int j = 0; j < 4; ++j) { const f32x4 gj = *((const f32x4*)g + lane + 64 * j); const f32x4 o = v[j] * rs * gj;
        v2u w; w.x = pk2(o.x, o.y); w.y = pk2(o.z, o.w); *((v2u*)orow + lane + 64 * j) = w; }
}
__device__ __forceinline__ void phase_prologue(Frame& F) {
    unsigned char* const W_ = wsp(F);
    LAS float* scr = (LAS float*)(F.lds + F.wave * 16384);
    const int gw = F.blk * NWAVES + F.wave, NGW = F.G * NWAVES;
    for (int it = gw; it < DEPTH * IT_LAYER; it += NGW) prologue_item(F, it, scr);
    for (int r = gw; r < DEPTH * 248; r += NGW) { const int l = r / 248, rr = r % 248; v4u* p = (v4u*)((bf16*)(W_ + WS_WIN) + ((size_t)l * NIN + 2824 + rr) * 1024);
        p[F.lane] = (v4u){0u, 0u, 0u, 0u}; p[64 + F.lane] = (v4u){0u, 0u, 0u, 0u}; }
    float* wr_t = (float*)(W_ + WS_WR);
    for (int i = F.blk * NTHREADS + F.tid; i < DEPTH * 36 * 1024; i += F.G * NTHREADS) { const int l = i / (36 * 1024), c = (i / 1024) % 36, k = i % 1024;
        wr_t[i] = (c < 4) ? F.in[14][((size_t)l * 1024 + k) * 4 + c] : F.in[16][((size_t)l * 1024 + k) * 32 + (c - 4)]; }
    float* tb = (float*)(W_ + WS_TB);
    { const int i = F.blk * NTHREADS + F.tid;
      if (i < 1024) { const int h = i >> 7, d = i & 127; int bk = d; if (d >= 16) { bk = 16 + (int)(log2f((float)d * (1.0f / 16.0f)) * (16.0f / 3.0f)); bk = bk > 31 ? 31 : bk; } tb[i] = F.in[1][bk * 8 + h] * LOG2E; }
      else if (i < 1032) tb[i] = F.in[1][31 * 8 + (i - 1024)] * LOG2E; }
    bf16* xn = (bf16*)(W_ + WS_XN);
    for (int t = gw; t < T; t += NGW) { const f32x4* xr = (const f32x4*)(F.in[0] + (size_t)t * D) + F.lane; f32x4 v[4];
#pragma unroll
        for (int j = 0; j < 4; ++j) v[j] = xr[64 * j];
        rms_row_store(v, F.in[2], xn + (size_t)t * D, F.lane); }
}
__device__ __forceinline__ void phase_combine(Frame& F, int lnext) {
    unsigned char* const W_ = wsp(F);
    const int gw = F.blk * NWAVES + F.wave, NGW = F.G * NWAVES;
    const unsigned* route = (const unsigned*)(W_ + WS_ROUTE); const bf16* y = (const bf16*)(W_ + R1_XG); bf16* xn = (bf16*)(W_ + WS_XN);
    for (int t = gw; t < T; t += NGW) {
        const unsigned s0 = ald(route + (size_t)t * 8 + 6), s1 = ald(route + (size_t)t * 8 + 7);
        f32x4* hr = (f32x4*)(F.out + (size_t)t * D) + F.lane; const v2u* y0 = (const v2u*)(y + (size_t)s0 * D) + F.lane; const v2u* y1 = (const v2u*)(y + (size_t)s1 * D) + F.lane;
        f32x4 v[4];
#pragma unroll
        for (int j = 0; j < 4; ++j) { const f32x4 hv = hr[64 * j]; const v2u a = y0[64 * j], b = y1[64 * j];
            v[j].x = hv.x + (bflo(a.x) + bflo(b.x)); v[j].y = hv.y + (bfhi(a.x) + bfhi(b.x)); v[j].z = hv.z + (bflo(a.y) + bflo(b.y)); v[j].w = hv.w + (bfhi(a.y) + bfhi(b.y)); hr[64 * j] = v[j]; }
        if (lnext < DEPTH) rms_row_store(v, F.in[2] + lnext * D, xn + (size_t)t * D, F.lane);
    }
}
__device__ __forceinline__ void phase_conv(Frame& F, int l) {
    unsigned char* const W_ = wsp(F);
    const bf16* xbc = (const bf16*)(W_ + R1_XBC); bf16* xact = (bf16*)(W_ + WS_XN);
    const float* cw = F.in[4] + (size_t)l * 4 * CCH; const float* cb = F.in[5] + (size_t)l * CCH;
    for (int i = F.blk * NTHREADS + F.tid; i < T * 96; i += F.G * NTHREADS) { const int t = i / 96, c0 = (i % 96) * 8, s = t % SEQ;
        float a[8];
#pragma unroll
        for (int q = 0; q < 8; ++q) a[q] = cb[c0 + q];
#pragma unroll
        for (int j = 0; j < 4; ++j) { if (s - 3 + j >= 0) { const v4u w = *(const v4u*)(xbc + (size_t)(t - 3 + j) * CCH + c0); const float* wj = cw + j * CCH + c0;
            a[0] += wj[0] * bflo(w.x); a[1] += wj[1] * bfhi(w.x); a[2] += wj[2] * bflo(w.y); a[3] += wj[3] * bfhi(w.y); a[4] += wj[4] * bflo(w.z); a[5] += wj[5] * bfhi(w.z); a[6] += wj[6] * bflo(w.w); a[7] += wj[7] * bfhi(w.w); } }
#pragma unroll
        for (int q = 0; q < 8; ++q) a[q] = a[q] / (1.0f + __expf(-a[q]));
        v4u o; o.x = pk2(a[0], a[1]); o.y = pk2(a[2], a[3]); o.z = pk2(a[4], a[5]); o.w = pk2(a[6], a[7]);
        *(v4u*)(xact + (size_t)t * CCH + c0) = o; }
}
__device__ __forceinline__ void ssd_naive_item(Frame& F, int l, int item) {
    unsigned char* const W_ = wsp(F);
    const bf16* xact = (const bf16*)(W_ + WS_XN); const float* dtb = (const float*)(W_ + R1_DT); const bf16* zb = (const bf16*)(W_ + R1_Z); bf16* ymix = (bf16*)(W_ + R1_YMIX);
    const int lane = F.lane, pi = lane >> 4, ng = lane & 15;
    const int b = item >> 7, head = (item >> 4) & 7, pq = item & 15, p = 4 * pq + pi, g = head >> 2;
    const float A = -__expf(F.in[7][l * 8 + head]), dtbias = F.in[6][l * 8 + head], Dk = F.in[8][l * 8 + head];
    float h0 = 0.f, h1 = 0.f, h2 = 0.f, h3 = 0.f;
    const size_t r0 = (size_t)b * SEQ;
#pragma unroll 4
    for (int t = 0; t < SEQ; ++t) { const size_t row = r0 + t;
        const float dr = dtb[row * 8 + head] + dtbias; const float dtv = fmaxf(dr, 0.f) + log1pf(__expf(-fabsf(dr))); const float dA = __expf(dtv * A);
        const float x = bf1(xact[row * CCH + head * 64 + p]);
        const v2u bw = *(const v2u*)(xact + row * CCH + 512 + g * 64 + 4 * ng), cw = *(const v2u*)(xact + row * CCH + 640 + g * 64 + 4 * ng);
        const float xdt = x * dtv;
        h0 = h0 * dA + xdt * bflo(bw.x); h1 = h1 * dA + xdt * bfhi(bw.x); h2 = h2 * dA + xdt * bflo(bw.y); h3 = h3 * dA + xdt * bfhi(bw.y);
        float part = (h0 * bflo(cw.x) + h1 * bfhi(cw.x)) + (h2 * bflo(cw.y) + h3 * bfhi(cw.y));
        part += __shfl_xor(part, 1); part += __shfl_xor(part, 2); part += __shfl_xor(part, 4); part += __shfl_xor(part, 8);
        const float yv = part + Dk * x; const float zt = bf1(zb[row * DI + head * 64 + p]); const float yg = yv * zt / (1.0f + __expf(-zt));
        if (ng == 0) ymix[row * 1024 + head * 64 + p] = (bf16)f2bf(yg);
    }
}
__device__ __forceinline__ void attn_naive_query(Frame& F, int b, int h, int s, const float* ksum) {
    unsigned char* const W_ = wsp(F);
    const bf16* qbuf = (const bf16*)(W_ + R1_Q); const bf16* kbuf = (const bf16*)(W_ + R1_K); const bf16* vbuf = (const bf16*)(W_ + R1_V); bf16* ymix = (bf16*)(W_ + R1_YMIX);
    const float* tb = (const float*)(W_ + WS_TB);
    const int lane = F.lane, qb = s >> 8; const size_t rowq = (size_t)b * SEQ + s;
    float qf[64];
    { const v4u* qp = (const v4u*)(qbuf + rowq * 512 + h * 64);
#pragma unroll
      for (int i = 0; i < 8; ++i) { const v4u w = qp[i]; qf[8 * i] = bflo(w.x); qf[8 * i + 1] = bfhi(w.x); qf[8 * i + 2] = bflo(w.y); qf[8 * i + 3] = bfhi(w.y); qf[8 * i + 4] = bflo(w.z); qf[8 * i + 5] = bfhi(w.z); qf[8 * i + 6] = bflo(w.w); qf[8 * i + 7] = bfhi(w.w); } }
    float gv = -INFINITY;
    if (lane < qb) { const f32x4* kp = (const f32x4*)(ksum + (((size_t)b * 8 + h) * 16 + lane) * 64); float a = 0.f;
#pragma unroll
        for (int i = 0; i < 16; ++i) { const f32x4 kv = kp[i]; a += (qf[4 * i] * kv.x + qf[4 * i + 1] * kv.y) + (qf[4 * i + 2] * kv.z + qf[4 * i + 3] * kv.w); }
        gv = a; }
    unsigned selmask = 0u;
    for (int r = 0; r < 3; ++r) { float best = gv; int bi = lane;
#pragma unroll
        for (int o = 1; o < 64; o <<= 1) { const float ob = __shfl_xor(best, o); const int oi = __shfl_xor(bi, o); if (ob > best || (ob == best && oi < bi)) { best = ob; bi = oi; } }
        if (best > -INFINITY) selmask |= 1u << bi;
        if (lane == bi) gv = -INFINITY; }
    selmask = (unsigned)__builtin_amdgcn_readfirstlane((int)selmask) | (1u << qb);
    float m = -INFINITY, lsum = 0.f, o = 0.f;
    for (int bi2 = 0; bi2 <= qb; ++bi2) { const int n = qb - bi2;
        if (!((selmask >> n) & 1u)) continue;
        for (int tt = 0; tt < 4; ++tt) { const int key0 = n * 256 + tt * 64; if (key0 > s) break; const int key = key0 + lane;
            const v4u* kp = (const v4u*)(kbuf + ((size_t)b * SEQ + key) * 512 + h * 64); float sc = 0.f;
#pragma unroll
            for (int i = 0; i < 8; ++i) { const v4u w = kp[i]; sc += (qf[8 * i] * bflo(w.x) + qf[8 * i + 1] * bfhi(w.x)) + (qf[8 * i + 2] * bflo(w.y) + qf[8 * i + 3] * bfhi(w.y)) + (qf[8 * i + 4] * bflo(w.z) + qf[8 * i + 5] * bfhi(w.z)) + (qf[8 * i + 6] * bflo(w.w) + qf[8 * i + 7] * bfhi(w.w)); }
            const int dist = s - key; const float bias = (dist < 128) ? tb[h * 128 + (dist < 0 ? 0 : dist)] : tb[1024 + h];
            sc = (dist < 0) ? -INFINITY : sc + bias;
            const float mn = fmaxf(m, wave_max(sc)); const float f = __builtin_amdgcn_exp2f(m - mn), p = __builtin_amdgcn_exp2f(sc - mn); m = mn;
            lsum = lsum * f + wave_sum(p); o *= f;
            const bf16* vp = vbuf + ((size_t)b * SEQ + key0) * 512 + h * 64 + lane;
#pragma unroll 16
            for (int j = 0; j < 64; ++j) { const float pj = __builtin_bit_cast(float, __builtin_amdgcn_readlane(__builtin_bit_cast(int, p), j)); o += pj * bf1(vp[(size_t)j * 512]); }
        } }
    ymix[rowq * 1024 + 512 + h * 64 + lane] = (bf16)f2bf(o / lsum);
}
__device__ __forceinline__ void phase_mixer_naive(Frame& F, int l) {
    unsigned char* const W_ = wsp(F);
    const int gw = F.blk * NWAVES + F.wave;
    if ((gw & 1) == 0 && (gw >> 1) < 1024) ssd_naive_item(F, l, gw >> 1);
    const float* ksum = (const float*)(F.ctl + CW_KSUM) + (size_t)l * 65536;
    unsigned* wq = F.ctl + CW_WQ + 64 * l;
    for (;;) { unsigned c = 0u; if (F.lane == 0) c = __hip_atomic_fetch_add(wq, 1u, RLX_AGENT); c = (unsigned)__builtin_amdgcn_readfirstlane((int)c);
        if (c >= 8192u) break;
        const int bh = (int)(c >> 7), s0 = (int)(c & 127u) * 32;
        for (int i = 0; i < 32; ++i) attn_naive_query(F, bh >> 3, bh & 7, s0 + i, ksum); }
}
__device__ __forceinline__ void phase_ssdnorm(Frame& F) {
    unsigned char* const W_ = wsp(F);
    const int gw = F.blk * NWAVES + F.wave, NGW = F.G * NWAVES; bf16* ymix = (bf16*)(W_ + R1_YMIX);
    for (int t = gw; t < T; t += NGW) { v4u* p = (v4u*)(ymix + (size_t)t * 1024) + F.lane; const v4u w = *p;
        float a[8] = {bflo(w.x), bfhi(w.x), bflo(w.y), bfhi(w.y), bflo(w.z), bfhi(w.z), bflo(w.w), bfhi(w.w)}; float s = 0.f;
#pragma unroll
        for (int q = 0; q < 8; ++q) s += a[q] * a[q];
        const float rs = 1.0f / sqrtf(wave_sum(s) * (1.0f / DI) + EPS);
        v4u o; o.x = pk2(a[0] * rs, a[1] * rs); o.y = pk2(a[2] * rs, a[3] * rs); o.z = pk2(a[4] * rs, a[5] * rs); o.w = pk2(a[6] * rs, a[7] * rs); *p = o; }
}
__device__ __forceinline__ void phase_router(Frame& F, int l) {
    unsigned char* const W_ = wsp(F);
    LAS unsigned* lcnt = (LAS unsigned*)F.lds;
    if (F.tid < 32) lcnt[F.tid] = 0u;
    __syncthreads();
    const float* g2 = F.in[13] + (size_t)l * D; const float* wr = (const float*)(W_ + WS_WR) + (size_t)l * 36 * 1024;
    const float* b1 = F.in[15] + l * 4; const float* b2 = F.in[17] + l * 32;
    unsigned* route = (unsigned*)(W_ + WS_ROUTE); bf16* xn2 = (bf16*)(W_ + WS_XN);
    for (int ti = 0; ti < 16; ++ti) { const int t = F.blk * 128 + F.wave * 16 + ti;
        const f32x4* hr = (const f32x4*)(F.out + (size_t)t * D) + F.lane; f32x4 v[4]; float s = 0.f;
#pragma unroll
        for (int j = 0; j < 4; ++j) { v[j] = hr[64 * j]; s += (v[j].x * v[j].x + v[j].y * v[j].y) + (v[j].z * v[j].z + v[j].w * v[j].w); }
        const float rs = 1.0f / sqrtf(wave_sum(s) * (1.0f / D) + EPS);
#pragma unroll
        for (int j = 0; j < 4; ++j) { const f32x4 gj = *((const f32x4*)g2 + F.lane + 64 * j); v[j] = v[j] * rs * gj;
            v2u w; w.x = pk2(v[j].x, v[j].y); w.y = pk2(v[j].z, v[j].w); *((v2u*)(xn2 + (size_t)t * D) + F.lane + 64 * j) = w; }
        LAS float* wlg = (LAS float*)(F.lds + 1024) + F.wave * 64;
#pragma unroll 2
        for (int c = 0; c < 36; ++c) { const f32x4* wp = (const f32x4*)(wr + c * 1024) + F.lane; float a = 0.f;
#pragma unroll
            for (int j = 0; j < 4; ++j) { const f32x4 w = wp[64 * j]; a += (v[j].x * w.x + v[j].y * w.y) + (v[j].z * w.z + v[j].w * w.w); }
            a = wave_sum(a) + (c < 4 ? b1[c & 3] : b2[(c - 4) & 31]);
            if (F.lane == 0) wlg[c] = a; }
        LDS_WAIT(); asm volatile("" ::: "memory");
        float lg[36];
#pragma unroll
        for (int c = 0; c < 36; ++c) lg[c] = wlg[c];
        LDS_WAIT(); asm volatile("" ::: "memory");
        const float m1 = fmaxf(fmaxf(lg[0], lg[1]), fmaxf(lg[2], lg[3]));
        const int gi = (lg[0] == m1) ? 0 : (lg[1] == m1) ? 1 : (lg[2] == m1) ? 2 : 3;
        const float se = (__expf(lg[0] - m1) + __expf(lg[1] - m1)) + (__expf(lg[2] - m1) + __expf(lg[3] - m1));
        const float gval = 1.0f / se;
        float f[8];
#pragma unroll
        for (int j = 0; j < 8; ++j) f[j] = (gi == 0) ? lg[4 + j] : (gi == 1) ? lg[12 + j] : (gi == 2) ? lg[20 + j] : lg[28 + j];
        int i0 = 0; float v0 = f[0];
#pragma unroll
        for (int j = 1; j < 8; ++j) if (f[j] > v0) { v0 = f[j]; i0 = j; }
        int i1 = 0; float v1 = -INFINITY;
#pragma unroll
        for (int j = 0; j < 8; ++j) if (j != i0 && f[j] > v1) { v1 = f[j]; i1 = j; }
        const float a1 = __expf(v1 - v0); const float g0 = gval / (1.0f + a1), g1 = gval * a1 / (1.0f + a1);
        if (F.lane == 0) { const unsigned e0 = (unsigned)(gi * 8 + i0), e1 = (unsigned)(gi * 8 + i1);
            const unsigned p0 = __hip_atomic_fetch_add(lcnt + e0, 1u, __ATOMIC_RELAXED, __HIP_MEMORY_SCOPE_WORKGROUP), p1 = __hip_atomic_fetch_add(lcnt + e1, 1u, __ATOMIC_RELAXED, __HIP_MEMORY_SCOPE_WORKGROUP);
            v4u r0; r0.x = e0; r0.y = e1; r0.z = p0; r0.w = p1; *(v4u*)(route + (size_t)t * 8) = r0;
            v2u r1; r1.x = __builtin_bit_cast(unsigned, g0); r1.y = __builtin_bit_cast(unsigned, g1); *(v2u*)(route + (size_t)t * 8 + 4) = r1; }
    }
    __syncthreads();
    if (F.tid < 32) { const unsigned c = lcnt[F.tid]; const unsigned bb = __hip_atomic_fetch_add(F.ctl + CW_CNT + (l * 32 + F.tid) * 64, c, RLX_AGENT);
        ((unsigned*)(W_ + WS_BBASE))[F.blk * 32 + F.tid] = bb; }
    __syncthreads();
}
__device__ __forceinline__ void phase_gather(Frame& F, int l) {
    unsigned char* const W_ = wsp(F);
    LAS unsigned* base = (LAS unsigned*)F.lds;
    unsigned* tile_e = (unsigned*)(W_ + WS_TILEE);
    if (F.tid == 0) { unsigned acc = 0u; for (int e = 0; e < 32; ++e) { const unsigned c = ald(F.ctl + CW_CNT + (l * 32 + e) * 64); base[e] = acc; acc += (c + 255u) & ~255u; } base[32] = acc >> 8; }
    __syncthreads();
    if (F.blk == 0 && F.tid < 32) { const unsigned c = ald(F.ctl + CW_CNT + (l * 32 + F.tid) * 64); const unsigned nt = (c + 255u) >> 8, t0 = base[F.tid] >> 8;
        for (unsigned r = 0; r < nt; ++r) tile_e[t0 + r] = (unsigned)F.tid;
        if (F.tid == 0) tile_e[511] = base[32]; }
    unsigned* route = (unsigned*)(W_ + WS_ROUTE); const unsigned* bbase = (const unsigned*)(W_ + WS_BBASE) + F.blk * 32;
    float* gslot = (float*)(W_ + WS_GSLOT); const bf16* xn2 = (const bf16*)(W_ + WS_XN); bf16* xg = (bf16*)(W_ + R1_XG);
    for (int ti = 0; ti < 16; ++ti) { const int t = F.blk * 128 + F.wave * 16 + ti;
        const unsigned e0 = ald(route + (size_t)t * 8), e1 = ald(route + (size_t)t * 8 + 1), p0 = ald(route + (size_t)t * 8 + 2), p1 = ald(route + (size_t)t * 8 + 3);
        const unsigned s0 = base[e0] + ald(bbase + e0) + p0, s1 = base[e1] + ald(bbase + e1) + p1;
        if (F.lane == 0) { route[(size_t)t * 8 + 6] = s0; route[(size_t)t * 8 + 7] = s1; gslot[s0] = __builtin_bit_cast(float, ald(route + (size_t)t * 8 + 4)); gslot[s1] = __builtin_bit_cast(float, ald(route + (size_t)t * 8 + 5)); }
        const v4u* src = (const v4u*)(xn2 + (size_t)t * D); const v4u a = src[F.lane], b = src[64 + F.lane];
        v4u* d0 = (v4u*)(xg + (size_t)s0 * D); v4u* d1 = (v4u*)(xg + (size_t)s1 * D);
        d0[F.lane] = a; d0[64 + F.lane] = b; d1[F.lane] = a; d1[64 + F.lane] = b; }
    __syncthreads();
}
#ifndef MK_MULTI
#define MK_MULTI 1
#endif
constexpr int NPHASE = 1 + 10 * DEPTH;
struct Args { const float* in[21]; float* out; unsigned char* ws; int ph_lo, ph_hi; };
static_assert(sizeof(Args) == 23 * 8 + 8, "Args has no padding");

#ifndef PH_MASK
#define PH_MASK 0xffffffffu
#endif
#define PHM(j) ((PH_MASK >> (j)) & 1u)
#define IN(k) (lo <= (k) && (k) < hi)
#define SEAM(k) do { if (IN(k) && IN((k) + 1)) xcd_barrier(bar); } while (0)
template <int l> __device__ __forceinline__ void layer_program(Frame& F, const XcdBarrier& bar, const int lo, const int hi) {
        const int pb = 1 + 10 * l; unsigned char* W_ = wsp(F);
        if (PHM(1) && IN(pb + 0)) {
            pg8::Gemm g{(const bf16*)(W_ + WS_XN), (const bf16*)(W_ + WS_WIN) + (size_t)l * NIN * 1024, T, NIN, D}; pg8::StaticOrder S; S.init(T, NIN, F.G, F.blk);
            pg8::EpiInProj E{(bf16*)(W_ + R1_Z), (bf16*)(W_ + R1_XBC), (bf16*)(W_ + R1_Q), (bf16*)(W_ + R1_K), (bf16*)(W_ + R1_V), (float*)(W_ + R1_DT),
                             (float*)(F.ctl + CW_KSUM) + (size_t)l * 65536, F.in[10] + l * 64, F.in[11] + l * 64, C2, EPS};
            pg8::gemm_phase<pg8::EpiInProj, pg8::StaticOrder, true, true>(F.lds, g, S, E);
        } SEAM(pb + 0);
        if (PHM(2) && IN(pb + 1)) { phase_conv(F, l); } SEAM(pb + 1);
        if (PHM(3) && IN(pb + 2)) { phase_mixer_naive(F, l); } SEAM(pb + 2);
        if (PHM(4) && IN(pb + 3)) { phase_ssdnorm(F); } SEAM(pb + 3);
        if (PHM(5) && IN(pb + 4)) {
            pg8::Gemm g{(const bf16*)(W_ + R1_YMIX), (const bf16*)(W_ + WS_WOUT) + (size_t)l * 1024 * 1024, T, D, D}; pg8::StaticOrder S; S.init(T, D, F.G, F.blk);
            pg8::EpiResid E{l == 0 ? F.in[0] : F.out, F.out, D};
            pg8::gemm_phase<pg8::EpiResid, pg8::StaticOrder, true, true>(F.lds, g, S, E);
        } SEAM(pb + 4);
        if (PHM(6) && IN(pb + 5)) { phase_router(F, l); } SEAM(pb + 5);
        if (PHM(7) && IN(pb + 6)) { phase_gather(F, l); } SEAM(pb + 6);
        if (PHM(8) && IN(pb + 7)) {
            const int nrt = __builtin_amdgcn_readfirstlane((int)ald((const unsigned*)(W_ + WS_TILEE) + 511));
            pg8::Gemm g{(const bf16*)(W_ + R1_XG), (const bf16*)(W_ + WS_WGU) + (size_t)l * 32 * 1024 * 1024, PMAX, 32 * 1024, D};
            pg8::MoeOrder S{(const unsigned*)(W_ + WS_TILEE), 4 * nrt, F.blk}; pg8::EpiSwiGLU E{(bf16*)(W_ + R1_HMID)};
            pg8::gemm_phase<pg8::EpiSwiGLU, pg8::MoeOrder, true, true>(F.lds, g, S, E);
        } SEAM(pb + 7);
        if (PHM(9) && IN(pb + 8)) {
            const int nrt = __builtin_amdgcn_readfirstlane((int)ald((const unsigned*)(W_ + WS_TILEE) + 511));
            pg8::Gemm g{(const bf16*)(W_ + R1_HMID), (const bf16*)(W_ + WS_WD) + (size_t)l * 32 * 1024 * 512, PMAX, 32 * 1024, HID};
            pg8::MoeOrder S{(const unsigned*)(W_ + WS_TILEE), 4 * nrt, F.blk}; pg8::EpiDown E{(bf16*)(W_ + R1_XG), (const float*)(W_ + WS_GSLOT)};
            pg8::gemm_phase<pg8::EpiDown, pg8::MoeOrder, true, true>(F.lds, g, S, E);
        } SEAM(pb + 8);
        if (PHM(10) && IN(pb + 9)) { phase_combine(F, l + 1); } SEAM(pb + 9);
}
__global__ void __launch_bounds__(NTHREADS, 2) hymba_fwd(Args args) {
    extern __shared__ __attribute__((aligned(16))) unsigned char lds[];
    Frame F;
    F.lds = (LAS unsigned char*)lds; F.MISC = (volatile LAS unsigned*)(F.lds + MISC_OFF);
    F.tid = threadIdx.x; F.lane = F.tid & 63; F.wave = __builtin_amdgcn_readfirstlane(F.tid >> 6); F.G = gridDim.x; F.blk = blockIdx.x;
    F.ws = args.ws; F.ctl = (unsigned*)(args.ws + WS_CTL); F.out = args.out;
#pragma unroll
    for (int i = 0; i < 21; ++i) F.in[i] = args.in[i];
    for (int u = F.tid; u < (LDS_BYTES - RING_BYTES) / 4; u += NTHREADS) ((LAS unsigned*)(F.lds + RING_BYTES))[u] = 0u;
    __syncthreads();
    const int lo = args.ph_lo, hi = args.ph_hi;
    XcdBarrier bar; bar.bar = F.ctl + CW_BAR; bar.x = 0; bar.st = nullptr;
    if (hi - lo > 1) bar = xcd_barrier_post(F.ctl + CW_BAR, F.MISC + 8);

    if (PHM(0) && IN(0)) { phase_prologue(F); } SEAM(0);

    layer_program<0>(F, bar, lo, hi);
    layer_program<1>(F, bar, lo, hi);
#undef IN
#undef SEAM
}

extern "C" void kernel_launch(void* const* d_in, const int* in_sizes, int n_in, void* d_out, int out_size, void* d_ws, size_t ws_size, hipStream_t stream) {
    static int ready = 0;
    if (ready == 0) {
        if (n_in != 21 || out_size != T * D || ws_size < WS_END) { fprintf(stderr, "kernel_launch: unexpected shapes (n_in %d out %d ws %zu need %zu)\n", n_in, out_size, ws_size, (size_t)WS_END); ready = -1; return; }
        if (hipFuncSetAttribute((const void*)hymba_fwd, hipFuncAttributeMaxDynamicSharedMemorySize, LDS_BYTES) != hipSuccess) { fprintf(stderr, "kernel_launch: hipFuncSetAttribute failed\n"); ready = -1; return; }
        int per_cu = 0;
        if (hipOccupancyMaxActiveBlocksPerMultiprocessor(&per_cu, (const void*)hymba_fwd, NTHREADS, LDS_BYTES) != hipSuccess || per_cu < 1) fprintf(stderr, "kernel_launch: note: occupancy query says %d\n", per_cu);
        (void)hipGetLastError();
        ready = 1;
    }
    if (ready < 0) return;
    (void)hipMemsetAsync((char*)d_ws + WS_CTL, 0, CTL_ZERO_BYTES, stream);
    Args a{};
    for (int i = 0; i < 21; ++i) a.in[i] = (const float*)d_in[i];
    a.out = (float*)d_out; a.ws = (unsigned char*)d_ws;
#if MK_MULTI
    for (int p = 0; p < NPHASE; ++p) { a.ph_lo = p; a.ph_hi = p + 1; hipLaunchKernelGGL(hymba_fwd, dim3(GRID), dim3(NTHREADS), LDS_BYTES, stream, a); }
#else
    a.ph_lo = 0; a.ph_hi = NPHASE; hipLaunchKernelGGL(hymba_fwd, dim3(GRID), dim3(NTHREADS), LDS_BYTES, stream, a);
#endif
}
```

```cpp
#include <hip/hip_runtime.h>
#include <cstdio>
#include <cstdint>
#include <hip/hip_bf16.h>
#include <cmath>
namespace pg8 {
#define PG8_LAS __attribute__((address_space(3)))
typedef unsigned short bf16_t;
typedef short bf16x8 __attribute__((ext_vector_type(8)));
typedef float f32x4 __attribute__((ext_vector_type(4)));
typedef unsigned u32x4 __attribute__((ext_vector_type(4)));
constexpr int BM = 256, BK = 64, HALF = 128, HTB = HALF * BK * 2  , STAGE_BYTES = 8 * HTB, NXCD = 8, WGM = 8;

__host__ __device__ __forceinline__ int lds_byte(int r, int c) { const int st = (r >> 4) * 2 + (c >> 5), rr = r & 15, cc = c & 31, ob = rr * 64 + cc * 2; return st * 1024 + (ob ^ (((ob >> 9) & 1) << 5)); }
__host__ __device__ __forceinline__ void stage_rc(int b, int& R, int& C) { const int st = b / 1024, sb = b % 1024, swz = sb ^ (((sb >> 9) & 1) << 5); R = (st >> 1) * 16 + swz / 64; C = (st & 1) * 32 + (swz % 64) / 2; }
__host__ __device__ __forceinline__ int perm32(int rho) { const int n = rho >> 4, i = rho & 15; return 8 * (i >> 2) + 4 * n + (i & 3); }

struct Unit { int pm, pn; };
struct Gemm { const bf16_t* A; const bf16_t* Bt; int M, N, K; };

struct StaticOrder {
    int nM, nN, nwg, G, c;
    __host__ __device__ void init(int M, int N, int G_, int c_) { nM = M / BM; nN = N / BM; nwg = nM * nN; G = G_; c = c_; }
    __host__ __device__ bool next(int i, Unit& u) const {
        const long L = (long)i * G + c; if (L >= nwg) return false;
        int wgid = (int)L; { const int q = nwg / NXCD, r = nwg % NXCD, xcd = wgid % NXCD, off = wgid / NXCD; wgid = (xcd < r ? xcd * (q + 1) : r * (q + 1) + (xcd - r) * q) + off; }
        const int nig = WGM * nN, gid = wgid / nig, fm = gid * WGM, gsz = (nM - fm) < WGM ? (nM - fm) : WGM;
        u.pm = fm + ((wgid % nig) % gsz); u.pn = (wgid % nig) / gsz; return true;
    }
    static constexpr bool GATHER = false;
    __device__ __forceinline__ int row_of(const Unit&, int) const { return 0; }
    __device__ __forceinline__ void a_ready(const Unit&) const {}
    __device__ __forceinline__ void done(const Unit&) const {}
};

__device__ __forceinline__ unsigned cvt_pk_bf16(float lo, float hi) { unsigned r; asm volatile("v_cvt_pk_bf16_f32 %0, %1, %2" : "=v"(r) : "v"(lo), "v"(hi)); return r; }
typedef float f32x2 __attribute__((ext_vector_type(2)));
__device__ __forceinline__ float silu_f(float x) { return x * __builtin_amdgcn_rcpf(1.0f + __builtin_amdgcn_exp2f(-1.4426950408889634f * x)); }

struct EpiInProj {
    static constexpr bool PERM = true, AFTER_DRAIN = false; static constexpr int MIDK = 0;
    bf16_t* z; bf16_t* xbc; bf16_t* q; bf16_t* k; bf16_t* v; float* dt; float* ksum;
    const PG8_LAS float* qkg; float qscale; float eps;
    const PG8_LAS float* rsl; mutable int ucount;
    __device__ __forceinline__ void operator()(const f32x4 (&acc)[2][2][4][2], const Unit& u, int wr, int wc, int fr, int fq) const {
        const int pn = u.pn; const int row0 = u.pm * BM + wr * 64 + fr;
        const PG8_LAS float* rp = rsl + ucount * 256 + wr * 64 + fr; ++ucount;
        if (pn <= 4 || pn == 9 || pn == 10) {
            bf16_t* base; int ldc, colt;
            if (pn <= 1) { base = z; ldc = 512; colt = pn * 256; } else if (pn <= 4) { base = xbc; ldc = 768; colt = (pn - 2) * 256; } else { base = v; ldc = 512; colt = (pn - 9) * 256; }
            const int col0 = colt + wc * 32 + 8 * fq;
#pragma unroll
            for (int ai = 0; ai < 2; ++ai)
#pragma unroll
                for (int m = 0; m < 4; ++m) { bf16_t* rowp = base + (size_t)(row0 + ai * HALF + m * 16) * ldc + col0; const float rv = rp[ai * HALF + m * 16];
#pragma unroll
                    for (int bj = 0; bj < 2; ++bj) { const f32x4 v0 = acc[ai][bj][m][0] * rv, v1 = acc[ai][bj][m][1] * rv;
                        u32x4 w; w.x = cvt_pk_bf16(v0[0], v0[1]); w.y = cvt_pk_bf16(v0[2], v0[3]); w.z = cvt_pk_bf16(v1[0], v1[1]); w.w = cvt_pk_bf16(v1[2], v1[3]);
                        *(u32x4*)(rowp + bj * HALF) = w; } }
        } else if (pn <= 8) {
            const bool isk = (pn >= 7); const int hh = 4 * ((pn - 5) & 1) + wc;
            const PG8_LAS float* g = qkg + (isk ? 64 : 0) + 8 * fq; bf16_t* base = isk ? k : q; const float sc = isk ? 1.0f : qscale;
            f32x4 cs[2][2];
#pragma unroll
            for (int bj = 0; bj < 2; ++bj)
#pragma unroll
                for (int n = 0; n < 2; ++n) cs[bj][n] = (f32x4){0.f, 0.f, 0.f, 0.f};
#pragma unroll
            for (int ai = 0; ai < 2; ++ai)
#pragma unroll
                for (int m = 0; m < 4; ++m) {
                    float ss = 0.f;
#pragma unroll
                    for (int bj = 0; bj < 2; ++bj)
#pragma unroll
                        for (int n = 0; n < 2; ++n) { const f32x4 x = acc[ai][bj][m][n]; ss += (x[0] * x[0] + x[1] * x[1]) + (x[2] * x[2] + x[3] * x[3]); }
                    ss += __shfl_xor(ss, 16); ss += __shfl_xor(ss, 32);
                    const float rv = rp[ai * HALF + m * 16]; const float rs = sc * rv / sqrtf(ss * rv * rv * (1.0f / 64.0f) + eps);
                    bf16_t* rowp = base + (size_t)(row0 + ai * HALF + m * 16) * 512 + hh * 64 + 8 * fq;
#pragma unroll
                    for (int bj = 0; bj < 2; ++bj) { const f32x4 g0 = *(const PG8_LAS f32x4*)(g + 32 * bj), g1 = *(const PG8_LAS f32x4*)(g + 32 * bj + 4);
                        const f32x4 v0 = acc[ai][bj][m][0] * rs * g0, v1 = acc[ai][bj][m][1] * rs * g1;
                        if (isk) { cs[bj][0] += v0; cs[bj][1] += v1; }
                        u32x4 w; w.x = cvt_pk_bf16(v0[0], v0[1]); w.y = cvt_pk_bf16(v0[2], v0[3]); w.z = cvt_pk_bf16(v1[0], v1[1]); w.w = cvt_pk_bf16(v1[2], v1[3]);
                        *(u32x4*)(rowp + bj * 32) = w; }
                    asm volatile("" : "+v"(cs[0][0]), "+v"(cs[0][1]), "+v"(cs[1][0]), "+v"(cs[1][1]) :: "memory");
                }
            if (isk) {
                float* kb = ksum + ((size_t)(u.pm >> 4) * 8 + hh) * 16 * 64 + (size_t)(u.pm & 15) * 64;
#pragma unroll
                for (int bj = 0; bj < 2; ++bj)
#pragma unroll
                    for (int n = 0; n < 2; ++n)
#pragma unroll
                        for (int j = 0; j < 4; ++j) { float s = cs[bj][n][j];
                            s += __shfl_xor(s, 1); s += __shfl_xor(s, 2); s += __shfl_xor(s, 4); s += __shfl_xor(s, 8);
                            if (fr == 0) atomicAdd(kb + 32 * bj + 8 * fq + 4 * n + j, s); }
            }
        } else {
            if (wc == 0 && fq == 0) {
#pragma unroll
                for (int ai = 0; ai < 2; ++ai)
#pragma unroll
                    for (int m = 0; m < 4; ++m) { float* rowp = dt + (size_t)(row0 + ai * HALF + m * 16) * 8; const float rv = rp[ai * HALF + m * 16];
                        *(f32x4*)(rowp) = acc[ai][0][m][0] * rv; *(f32x4*)(rowp + 4) = acc[ai][0][m][1] * rv; }
            }
        }
    }
};

template <bool RES_BF16, int MIDK_ = 8> struct EpiResidT {
    static constexpr bool PERM = true, AFTER_DRAIN = false; static constexpr int MIDK = MIDK_;
    const void* resid; bf16_t* out; int ldc; const PG8_LAS float* rsl; float eps;
    mutable int ucount;
    __device__ __forceinline__ void midk(f32x4 (&acc)[2][2][4][2], const Unit& u, int wr, int wc, int fr, int fq) const {
        const PG8_LAS float* rp = rsl + (ucount & 1) * 256 + wr * 64 + fr;
#pragma unroll
        for (int ai = 0; ai < 2; ++ai)
#pragma unroll
            for (int m = 0; m < 4; ++m) { const float rs = rp[ai * HALF + m * 16];
#pragma unroll
                for (int bj = 0; bj < 2; ++bj)
#pragma unroll
                    for (int n = 0; n < 2; ++n) acc[ai][bj][m][n] = acc[ai][bj][m][n] * rs; }
        ++ucount;
    }
    __device__ __forceinline__ void operator()(const f32x4 (&acc)[2][2][4][2], const Unit& u, int wr, int wc, int fr, int fq) const {
        const int row0 = u.pm * BM + wr * 64 + fr, col0 = u.pn * BM + wc * 32 + 8 * fq;
#pragma unroll
        for (int ai = 0; ai < 2; ++ai)
#pragma unroll
            for (int m = 0; m < 4; ++m) { const size_t off = (size_t)(row0 + ai * HALF + m * 16) * ldc + col0;
#pragma unroll
                for (int bj = 0; bj < 2; ++bj) { f32x4 r0, r1;
                    if constexpr (RES_BF16) { const u32x4 w = *(const u32x4*)((const bf16_t*)resid + off + bj * HALF);
                        r0[0] = __builtin_bit_cast(float, w.x << 16); r0[1] = __builtin_bit_cast(float, w.x & 0xffff0000u); r0[2] = __builtin_bit_cast(float, w.y << 16); r0[3] = __builtin_bit_cast(float, w.y & 0xffff0000u);
                        r1[0] = __builtin_bit_cast(float, w.z << 16); r1[1] = __builtin_bit_cast(float, w.z & 0xffff0000u); r1[2] = __builtin_bit_cast(float, w.w << 16); r1[3] = __builtin_bit_cast(float, w.w & 0xffff0000u); }
                    else { r0 = *(const f32x4*)((const float*)resid + off + bj * HALF); r1 = *(const f32x4*)((const float*)resid + off + bj * HALF + 4); }
                    const f32x4 v0 = acc[ai][bj][m][0] + r0, v1 = acc[ai][bj][m][1] + r1;
                    u32x4 o; o.x = cvt_pk_bf16(v0[0], v0[1]); o.y = cvt_pk_bf16(v0[2], v0[3]); o.z = cvt_pk_bf16(v1[0], v1[1]); o.w = cvt_pk_bf16(v1[2], v1[3]); *(u32x4*)(out + off + bj * HALF) = o; } }
    }
};

struct EpiSwiGLU {
    static constexpr bool PERM = true, AFTER_DRAIN = false; static constexpr int MIDK = 0;
    bf16_t* hmid;
    __device__ __forceinline__ void operator()(const f32x4 (&acc)[2][2][4][2], const Unit& u, int wr, int wc, int fr, int fq) const {
        const int row0 = u.pm * BM + wr * 64 + fr, col0 = (u.pn & 3) * 128 + wc * 32 + 8 * fq;
#pragma unroll
        for (int ai = 0; ai < 2; ++ai)
#pragma unroll
            for (int m = 0; m < 4; ++m) { bf16_t* rowp = hmid + (size_t)(row0 + ai * HALF + m * 16) * 512 + col0;
                const f32x4 g0 = acc[ai][0][m][0], g1 = acc[ai][0][m][1], u0 = acc[ai][1][m][0], u1 = acc[ai][1][m][1];
                float r[8];
#pragma unroll
                for (int j = 0; j < 4; ++j) { r[j] = silu_f(g0[j]) * u0[j]; r[4 + j] = silu_f(g1[j]) * u1[j]; }
                u32x4 w; w.x = cvt_pk_bf16(r[0], r[1]); w.y = cvt_pk_bf16(r[2], r[3]); w.z = cvt_pk_bf16(r[4], r[5]); w.w = cvt_pk_bf16(r[6], r[7]);
                *(u32x4*)rowp = w; }
    }
};

struct EpiDown {
    static constexpr bool PERM = true, AFTER_DRAIN = false; static constexpr int MIDK = 0;
    bf16_t* y;
    __device__ __forceinline__ void operator()(const f32x4 (&acc)[2][2][4][2], const Unit& u, int wr, int wc, int fr, int fq) const {
        const int row0 = u.pm * BM + wr * 64 + fr, col0 = (u.pn & 3) * BM + wc * 32 + 8 * fq;
#pragma unroll
        for (int ai = 0; ai < 2; ++ai)
#pragma unroll
            for (int m = 0; m < 4; ++m) { bf16_t* rowp = y + (size_t)(row0 + ai * HALF + m * 16) * 1024 + col0;
#pragma unroll
                for (int bj = 0; bj < 2; ++bj) { const f32x4 v0 = acc[ai][bj][m][0], v1 = acc[ai][bj][m][1];
                    u32x4 w; w.x = cvt_pk_bf16(v0[0], v0[1]); w.y = cvt_pk_bf16(v0[2], v0[3]); w.z = cvt_pk_bf16(v1[0], v1[1]); w.w = cvt_pk_bf16(v1[2], v1[3]);
                    *(u32x4*)(rowp + bj * HALF) = w; } }
    }
};

struct MoeOrder {
    static constexpr bool GATHER = false;
    __device__ __forceinline__ int row_of(const Unit&, int) const { return 0; }
    const PG8_LAS unsigned* tile_e; int nunits, c;
    __device__ __forceinline__ bool next(int i, Unit& u) const {
        const int L = (i * 8 + (c & 7)) * 32 + (c >> 3); if (L >= nunits) return false;
        const int rt = L >> 2; const int e = __builtin_amdgcn_readfirstlane((int)tile_e[rt]);
        u.pm = rt; u.pn = e * 4 + (L & 3); return true;
    }
    __device__ __forceinline__ void a_ready(const Unit&) const {}
    __device__ __forceinline__ void done(const Unit&) const {}
};

template <class Epi, class Sched, bool ALIGN_EPI = false, bool SP2 = false>
__device__ __forceinline__ void gemm_phase(PG8_LAS unsigned char* lds, const Gemm g, const Sched& S, const Epi& E) {
    const int tid = threadIdx.x, wid = __builtin_amdgcn_readfirstlane(tid >> 6), lane = tid & 63, wr = wid >> 2, wc = wid & 3, fr = lane & 15, fq = lane >> 4;
    const int K = g.K, nt = K / BK;
    unsigned voffA[2], voffB[2];
#pragma unroll
    for (int i = 0; i < 2; ++i) { int R, C; stage_rc(tid * 16 + i * 8192, R, C); const int Rb = Epi::PERM ? ((R & ~31) + perm32(R & 31)) : R;
        voffA[i] = (unsigned)(R * K + C) * 2u; voffB[i] = (unsigned)(Rb * K + C) * 2u; }
    constexpr bool GATH = Sched::GATHER;
    unsigned coff[2][2], noff[2][2];
#define PG8_GOFF(dst, unit) do { _Pragma("unroll") for (int _i = 0; _i < 2; ++_i) { int R_, C_; stage_rc(tid * 16 + _i * 8192, R_, C_); \
        _Pragma("unroll") for (int _h = 0; _h < 2; ++_h) dst[_h][_i] = (unsigned)(S.row_of(unit, _h * HALF + R_) * K + C_) * 2u; } } while (0)
    const size_t kstep = (size_t)(BK * 2);
    const size_t hstep = (size_t)HALF * K * 2;
    const size_t tstep = 2 * hstep;
    const unsigned ldsw = (unsigned)wid * 1024u;
    const int aoff = lds_byte(wr * 64 + fr, fq * 8), boff = lds_byte(wc * 32 + fr, fq * 8);
#define PG8_SA(b, h) (((b) * 2 + (h)) * HTB)
#define PG8_SB(b, h) ((4 + (b) * 2 + (h)) * HTB)
#define PG8_STAGE(bufoff, gbase, voff) do { _Pragma("unroll") for (int _i = 0; _i < 2; ++_i) \
        __builtin_amdgcn_global_load_lds((const unsigned*)((const char*)(gbase) + (voff)[_i]), (PG8_LAS unsigned*)(lds + (bufoff) + ldsw + _i * 8192), 16, 0, 0); } while (0)
#define PG8_STAGE_AC(b, h, base) do { if constexpr (GATH) { PG8_STAGE(PG8_SA(b, h), base, coff[h]); } else { PG8_STAGE(PG8_SA(b, h), (base) + (h) * hstep, voffA); } } while (0)
#define PG8_STAGE_AX(b, h, base) do { if constexpr (GATH) { const unsigned so_[2] = {last ? noff[h][0] : coff[h][0], last ? noff[h][1] : coff[h][1]}; PG8_STAGE(PG8_SA(b, h), base, so_); } else { PG8_STAGE(PG8_SA(b, h), (base) + (h) * hstep, voffA); } } while (0)
#define PG8_LDA(dst, b, h) do { _Pragma("unroll") for (int m = 0; m < 4; ++m) _Pragma("unroll") for (int k = 0; k < 2; ++k) dst[m][k] = *(const PG8_LAS bf16x8*)(lds + PG8_SA(b, h) + aoff + m * 2048 + k * 1024); } while (0)
#define PG8_LDB(dst, b, h) do { _Pragma("unroll") for (int n = 0; n < 2; ++n) _Pragma("unroll") for (int k = 0; k < 2; ++k) dst[n][k] = *(const PG8_LAS bf16x8*)(lds + PG8_SB(b, h) + boff + n * 2048 + k * 1024); } while (0)
#define PG8_MMA(ai, bj, At, Bt) do { __builtin_amdgcn_s_setprio(1); _Pragma("unroll") for (int m = 0; m < 4; ++m) _Pragma("unroll") for (int n = 0; n < 2; ++n) _Pragma("unroll") for (int k = 0; k < 2; ++k) \
        acc[ai][bj][m][n] = __builtin_amdgcn_mfma_f32_16x16x32_bf16(Bt[n][k], At[m][k], acc[ai][bj][m][n], 0, 0, 0); __builtin_amdgcn_s_setprio(0); } while (0)
#define PG8_WAIT_V(n) asm volatile("s_waitcnt vmcnt(" #n ")" ::: "memory")
#define PG8_WAIT_L(n) asm volatile("s_waitcnt lgkmcnt(" #n ")" ::: "memory")
#define PG8_BAR __builtin_amdgcn_s_barrier()
#define PG8_SCHED __builtin_amdgcn_sched_barrier(0)
    Unit cur, nxt; int ui = 0;
    if (!S.next(0, cur)) return;
    f32x4 acc[2][2][4][2];
#pragma unroll
    for (int a = 0; a < 2; ++a)
#pragma unroll
        for (int b = 0; b < 2; ++b)
#pragma unroll
            for (int m = 0; m < 4; ++m)
#pragma unroll
                for (int n = 0; n < 2; ++n) acc[a][b][m][n] = (f32x4){0.f, 0.f, 0.f, 0.f};
    bf16x8 At[4][2], B0[2][2], B1[2][2];
    const char* cA = (const char*)g.A + (GATH ? (size_t)0 : (size_t)cur.pm * tstep); const char* cB = (const char*)g.Bt + (size_t)cur.pn * tstep;
    if constexpr (GATH) { PG8_GOFF(coff, cur); _Pragma("unroll") for (int _h = 0; _h < 2; ++_h) { noff[_h][0] = coff[_h][0]; noff[_h][1] = coff[_h][1]; } }
    S.a_ready(cur);
    if constexpr (SP2) {
        PG8_STAGE(PG8_SB(0, 0), cB, voffB); PG8_STAGE(PG8_SB(0, 1), cB + hstep, voffB); PG8_STAGE_AC(0, 0, cA); PG8_STAGE_AC(0, 1, cA);
        if (wr == 1) PG8_BAR;
        PG8_WAIT_V(2); PG8_BAR;
        PG8_STAGE(PG8_SB(1, 0), cB + kstep, voffB); PG8_STAGE_AC(1, 0, cA + kstep); PG8_STAGE(PG8_SB(1, 1), cB + hstep + kstep, voffB);
        PG8_WAIT_V(6); PG8_BAR;
    } else {
        PG8_STAGE(PG8_SB(0, 0), cB, voffB); PG8_STAGE_AC(0, 0, cA); PG8_STAGE(PG8_SB(0, 1), cB + hstep, voffB); PG8_STAGE_AC(0, 1, cA);
        if (wr == 1) PG8_BAR;
        PG8_WAIT_V(4); PG8_BAR;
        PG8_STAGE(PG8_SB(1, 0), cB + kstep, voffB); PG8_STAGE_AC(1, 0, cA + kstep); PG8_STAGE(PG8_SB(1, 1), cB + hstep + kstep, voffB);
        PG8_WAIT_V(6); PG8_BAR;
    }
    for (;;) {
        const bool has_next = S.next(ui + 1, nxt);
        if constexpr (GATH) { if (has_next) PG8_GOFF(noff, nxt); }
        const char* nA = (has_next && !GATH) ? (const char*)g.A + (size_t)nxt.pm * tstep : cA; const char* nB = has_next ? (const char*)g.Bt + (size_t)nxt.pn * tstep : cB;
        for (int t = 0; t < nt; t += 2) {
            const bool last = (t == nt - 2);
            const char* a1 = cA + (size_t)(t + 1) * kstep;
            const char* a2 = last ? nA : cA + (size_t)(t + 2) * kstep; const char* b2 = last ? nB : cB + (size_t)(t + 2) * kstep;
            const char* a3 = a2 + kstep; const char* b3 = b2 + kstep;
            if (last && has_next) S.a_ready(nxt);
            if constexpr (SP2) {
            PG8_LDB(B0, 0, 0); PG8_LDB(B1, 0, 1); PG8_SCHED; PG8_LDA(At, 0, 0); PG8_STAGE_AC(1, 1, a1);
            PG8_WAIT_V(8); PG8_WAIT_L(0); PG8_BAR; PG8_MMA(0, 0, At, B0); PG8_MMA(0, 1, At, B1); PG8_BAR; PG8_SCHED;
            PG8_LDA(At, 0, 1); PG8_STAGE(PG8_SB(0, 0), b2, voffB); PG8_STAGE(PG8_SB(0, 1), b2 + hstep, voffB); PG8_STAGE_AX(0, 0, a2);
            PG8_WAIT_V(8); PG8_WAIT_L(0); PG8_BAR; PG8_MMA(1, 0, At, B0); PG8_MMA(1, 1, At, B1); PG8_BAR; PG8_SCHED;
            PG8_LDB(B0, 1, 0); PG8_LDB(B1, 1, 1); PG8_SCHED; PG8_LDA(At, 1, 0); PG8_STAGE_AX(0, 1, a2);
            PG8_WAIT_V(8); PG8_WAIT_L(0); PG8_BAR; PG8_MMA(0, 0, At, B0); PG8_MMA(0, 1, At, B1); PG8_BAR; PG8_SCHED;
            PG8_LDA(At, 1, 1); PG8_STAGE(PG8_SB(1, 0), b3, voffB); PG8_STAGE(PG8_SB(1, 1), b3 + hstep, voffB); PG8_STAGE_AX(1, 0, a3);
            PG8_WAIT_V(8); PG8_WAIT_L(0); PG8_BAR; PG8_MMA(1, 0, At, B0); PG8_MMA(1, 1, At, B1); PG8_BAR; PG8_SCHED;
            } else {
            PG8_LDB(B0, 0, 0); PG8_SCHED; PG8_LDA(At, 0, 0); PG8_STAGE_AC(1, 1, a1);
            PG8_WAIT_L(8); PG8_BAR; PG8_WAIT_L(0); PG8_MMA(0, 0, At, B0); PG8_BAR; PG8_SCHED;
            PG8_LDB(B1, 0, 1); PG8_STAGE(PG8_SB(0, 0), b2, voffB);
            PG8_BAR; PG8_WAIT_L(0); PG8_MMA(0, 1, At, B1); PG8_BAR;
            PG8_LDA(At, 0, 1); PG8_STAGE_AX(0, 0, a2);
            PG8_BAR; PG8_WAIT_L(0); PG8_MMA(1, 0, At, B0); PG8_BAR; PG8_SCHED;
            PG8_STAGE(PG8_SB(0, 1), b2 + hstep, voffB);
            PG8_WAIT_V(6); PG8_BAR; PG8_MMA(1, 1, At, B1); PG8_BAR;
            PG8_LDB(B0, 1, 0); PG8_SCHED; PG8_LDA(At, 1, 0); PG8_STAGE_AX(0, 1, a2);
            PG8_WAIT_L(8); PG8_BAR; PG8_WAIT_L(0); PG8_MMA(0, 0, At, B0); PG8_BAR; PG8_SCHED;
            PG8_LDB(B1, 1, 1); PG8_STAGE(PG8_SB(1, 0), b3, voffB);
            PG8_BAR; PG8_WAIT_L(0); PG8_MMA(0, 1, At, B1); PG8_BAR;
            PG8_LDA(At, 1, 1); PG8_STAGE_AX(1, 0, a3);
            PG8_BAR; PG8_WAIT_L(0); PG8_MMA(1, 0, At, B0); PG8_BAR; PG8_SCHED;
            PG8_STAGE(PG8_SB(1, 1), b3 + hstep, voffB);
            PG8_WAIT_V(6); PG8_BAR; PG8_MMA(1, 1, At, B1); PG8_BAR;
            }
            if constexpr (Epi::MIDK > 0) { if (t + 2 == Epi::MIDK) E.midk(acc, cur, wr, wc, fr, fq); }
        }
        if constexpr (ALIGN_EPI) { if (wr == 0) PG8_BAR; }
        if constexpr (!Epi::AFTER_DRAIN) { E(acc, cur, wr, wc, fr, fq); S.done(cur); }
        if (!has_next) break;
#pragma unroll
        for (int a = 0; a < 2; ++a)
#pragma unroll
            for (int b = 0; b < 2; ++b)
#pragma unroll
                for (int m = 0; m < 4; ++m)
#pragma unroll
                    for (int n = 0; n < 2; ++n) acc[a][b][m][n] = (f32x4){0.f, 0.f, 0.f, 0.f};
        cur = nxt; cA = nA; cB = nB; ++ui;
        if constexpr (GATH) { _Pragma("unroll") for (int _h = 0; _h < 2; ++_h) { coff[_h][0] = noff[_h][0]; coff[_h][1] = noff[_h][1]; } }
        if constexpr (ALIGN_EPI) { if (wr == 1) PG8_BAR; }
    }
    PG8_WAIT_V(0);
    if constexpr (!ALIGN_EPI) { if (wr == 0) PG8_BAR; }
    PG8_BAR;
    if constexpr (Epi::AFTER_DRAIN) { E.fused(acc, cur, wr, wc, fr, fq, lds, wid, lane); S.done(cur); }
#undef PG8_SA
#undef PG8_SB
#undef PG8_STAGE
#undef PG8_STAGE_AC
#undef PG8_STAGE_AX
#undef PG8_GOFF
#undef PG8_LDA
#undef PG8_LDB
#undef PG8_MMA
#undef PG8_WAIT_V
#undef PG8_WAIT_L
#undef PG8_BAR
#undef PG8_SCHED
}
}
constexpr int NWAVES = 8, NTHREADS = 512;
constexpr int NB = 8, SEQ = 4096, T = NB * SEQ, D = 1024, DEPTH = 2;
constexpr int NH = 8, HD = 64, DI = 512, CCH = 768, NIN = 3072, INCOLS = 2824;
constexpr int NE = 32, HID = 512, PMAX = 2 * T + NE * 256;
constexpr int MB = 256, NMB = SEQ / MB;
constexpr float EPS = 1e-6f, LOG2E = 1.4426950408889634f, C2 = 0.125f * LOG2E;
constexpr int GRID = 256;

constexpr size_t MiB = 1u << 20;
constexpr size_t WS_CTL = 0, CTL_ZERO_BYTES = 1 * MiB;
constexpr size_t WS_WIN = 1 * MiB;
constexpr size_t WS_WOUT = 13 * MiB;
constexpr size_t WS_WGU = 17 * MiB;
constexpr size_t WS_WD = 145 * MiB;
constexpr size_t WS_WR = 209 * MiB;
constexpr size_t WS_TB = WS_WR + 512 * 1024;
constexpr size_t WS_UG = WS_TB + 8192;
constexpr size_t WS_ROUTE = 210 * MiB;
constexpr size_t WS_GSLOT = 211 * MiB;
constexpr size_t WS_BBASE = WS_GSLOT + 512 * 1024;
constexpr size_t WS_TILEE = WS_BBASE + 64 * 1024;
constexpr size_t WS_RS1 = WS_TILEE + 4096 + 131072;
constexpr size_t WS_RS = WS_TILEE + 4096;
constexpr size_t WS_XN = 212 * MiB;
constexpr size_t WS_HB = WS_XN;
constexpr size_t SO_XN = 0;
constexpr size_t WS_R1 = 276 * MiB;
constexpr size_t R1_Z = WS_R1, R1_XBC = WS_R1 + 32 * MiB, R1_Q = WS_R1 + 80 * MiB, R1_K = WS_R1 + 112 * MiB, R1_V = WS_R1 + 144 * MiB, R1_YMIX = WS_R1 + 176 * MiB, R1_DT = WS_R1 + 240 * MiB;
constexpr size_t R1_XG = WS_R1, R1_HMID = WS_R1 + 144 * MiB;
constexpr size_t SS_XT = 0;
constexpr size_t SS_BT = 32 * MiB;
constexpr size_t SS_BC = 40 * MiB;
constexpr size_t SS_SSQ = WS_R1 + 242 * MiB;
constexpr size_t SS_DEC = WS_R1 + 244 * MiB;
constexpr size_t SS_S = 64 * MiB;
constexpr size_t WS_RSSLOT = WS_R1 + 241 * MiB;
constexpr size_t WS_END = WS_R1 + 245 * MiB;
static_assert((size_t)PMAX * 2048 <= 144 * MiB && (size_t)PMAX * 1024 <= 72 * MiB && R1_HMID + 72 * MiB <= WS_END, "R1 map");
constexpr int CW_BAR = 4096;
constexpr int CW_CNT = 8192;
constexpr int CW_KSUM = 65536;
static_assert((CW_KSUM + 2 * 65536) * 4 <= (int)CTL_ZERO_BYTES && CW_CNT + 64 * 64 <= CW_KSUM, "CTL map");

constexpr int RING_BYTES = 131072, MISC_OFF = RING_BYTES + 320, LDS_BYTES = 147456;

#define GAS __attribute__((address_space(1)))
#define LAS __attribute__((address_space(3)))
typedef unsigned short bf16;
typedef unsigned v4u __attribute__((ext_vector_type(4)));
typedef unsigned v2u __attribute__((ext_vector_type(2)));
typedef float f32x4 __attribute__((ext_vector_type(4)));
typedef GAS unsigned gu32;
#define RLX_AGENT __ATOMIC_RELAXED, __HIP_MEMORY_SCOPE_AGENT
#define LDS_WAIT() asm volatile("s_waitcnt lgkmcnt(0)" ::: "memory")
__device__ __forceinline__ unsigned f2bf(float f) { unsigned u = __builtin_bit_cast(unsigned, f); return (u + 0x7fffu + ((u >> 16) & 1u)) >> 16; }
__device__ __forceinline__ unsigned pk2(float lo, float hi) { return f2bf(lo) | (f2bf(hi) << 16); }
__device__ __forceinline__ float bflo(unsigned w) { return __builtin_bit_cast(float, w << 16); }
__device__ __forceinline__ float bfhi(unsigned w) { return __builtin_bit_cast(float, w & 0xffff0000u); }
__device__ __forceinline__ float bf1(bf16 b) { return __builtin_bit_cast(float, (unsigned)b << 16); }
__device__ __forceinline__ unsigned ald(const unsigned* p) { return __hip_atomic_load(p, __ATOMIC_RELAXED, __HIP_MEMORY_SCOPE_AGENT); }

#define XB_TMO      128
#define XB_XCNT(j)  (256  + 64 * (j))
#define XB_XSUB(j)  (1280 + 64 * (j))
#define XB_XGEN(j)  (2304 + 64 * (j))
#define XB_TOP      3328
#define XB_TOPGEN   3392
#define XCD_BAR_WORDS 3456
#define XB_SPIN_CAP (1u << 18)

__device__ __forceinline__ unsigned xb_ld(unsigned* p)              { return __hip_atomic_load(p, __ATOMIC_RELAXED, __HIP_MEMORY_SCOPE_AGENT); }
__device__ __forceinline__ unsigned xb_add(unsigned* p, unsigned v) { return __hip_atomic_fetch_add(p, v, __ATOMIC_RELAXED, __HIP_MEMORY_SCOPE_AGENT); }
__device__ __forceinline__ unsigned xb_xcc_id() { return (unsigned)__builtin_amdgcn_s_getreg((3 << 11) | 20) & 0xFu; }
#define XB_SPIN(cond, bar) do { unsigned _sp = 0; while (cond) { __builtin_amdgcn_s_sleep(1); \
    if ((++_sp & 255u) == 0u) { if (xb_ld(&(bar)[XB_TMO])) break; if (_sp > XB_SPIN_CAP) { atomicAdd(&(bar)[XB_TMO], 1u); break; } } } } while (0)

struct XcdBarrier {
    unsigned* bar; unsigned x;
    volatile LAS unsigned* st;
};

__device__ __forceinline__ XcdBarrier xcd_barrier_post(unsigned* bar, volatile LAS unsigned* st) {
    XcdBarrier b; b.bar = bar; b.x = xb_xcc_id(); b.st = st;
    if (threadIdx.x == 0) (void)xb_add(&bar[XB_XCNT(b.x)], 1u);
    return b;
}
__device__ __forceinline__ void xcd_barrier_complete(unsigned* bar, unsigned x, unsigned& nloc, unsigned& nx) {
    const unsigned G = gridDim.x * gridDim.y * gridDim.z;
    unsigned sum, cnt, mine, sp = 0u;
    for (;;) {
        sum = 0u; cnt = 0u; mine = 0u;
#pragma unroll
        for (unsigned j = 0; j < 16; ++j) { const unsigned c = xb_ld(&bar[XB_XCNT(j)]); sum += c; cnt += (c > 0u) ? 1u : 0u; mine = (j == x) ? c : mine; }
        if (sum == G) break;
        __builtin_amdgcn_s_sleep(1);
        if ((++sp & 255u) == 0u) { if (xb_ld(&bar[XB_TMO])) break; if (sp > XB_SPIN_CAP) { atomicAdd(&bar[XB_TMO], 1u); break; } }
    }
    nloc = mine > 0u ? mine : 1u; nx = cnt > 0u ? cnt : 1u;
}

__device__ __forceinline__ void xcd_barrier(const XcdBarrier& b) {
    asm volatile("s_waitcnt vmcnt(0)" ::: "memory");
    __syncthreads();
    if (threadIdx.x == 0) {
        unsigned* bar = b.bar;
        __builtin_amdgcn_s_waitcnt(0);
        unsigned nloc = b.st[0], nx = b.st[1];
        if (nloc == 0u) { xcd_barrier_complete(bar, b.x, nloc, nx); b.st[0] = nloc; b.st[1] = nx; }
        const unsigned old = xb_add(&bar[XB_XSUB(b.x)], 1u);
        const unsigned gen = old / nloc;
        if (old + 1u == (gen + 1u) * nloc) {
            __builtin_amdgcn_fence(__ATOMIC_RELEASE, "agent");
            asm volatile("s_waitcnt vmcnt(0)" ::: "memory");
            const unsigned og = xb_add(&bar[XB_TOP], 1u);
            const unsigned tg = og / nx;
            if (og + 1u == (tg + 1u) * nx) xb_add(&bar[XB_TOPGEN], 1u);
            else XB_SPIN(xb_ld(&bar[XB_TOPGEN]) == tg, bar);
            __builtin_amdgcn_fence(__ATOMIC_ACQUIRE, "agent");
            xb_add(&bar[XB_XGEN(b.x)], 1u);
            asm volatile("s_waitcnt vmcnt(0)" ::: "memory");
        } else {
            XB_SPIN(xb_ld(&bar[XB_XGEN(b.x)]) == gen, bar);
            __builtin_amdgcn_fence(__ATOMIC_ACQUIRE, "agent");
            asm volatile("s_waitcnt vmcnt(0)" ::: "memory");
        }
    }
    __syncthreads();
}
namespace attn_body {
using bf16=__hip_bfloat16;
using bf16x8=__attribute__((ext_vector_type(8)))short;
using s16x4=__attribute__((ext_vector_type(4)))short;
using f32x16=__attribute__((ext_vector_type(16)))float;
using u32x4=__attribute__((ext_vector_type(4)))unsigned;
constexpr int BATCH=8,NHEAD=8,SEQ=4096,D=64,DM=NHEAD*D,OPITCH=1024,OCOL0=512;
constexpr int NW=8,QBLK=32,QB=QBLK*NW,KVBLK=64,NQB=SEQ/QB;
constexpr float MBIG=256.f;
constexpr int ATTN_PITCH=DM, ATTN_UNIT_ROWS=QB;
__device__ __forceinline__ int crow(int r,int hi){return (r&3)+8*(r>>2)+4*hi;}
#define SBAR() __builtin_amdgcn_sched_barrier(0)
typedef __attribute__((address_space(3))) const float* lds_fptr;
__device__ __forceinline__ void biasadd(f32x16&p0,f32x16&p1,lds_fptr ub){
  #pragma unroll
  for(int r=0;r<16;++r){const int o=(r&3)+8*(r>>2); p0[r]+=ub[o]; p1[r]+=ub[o+32];}
}

constexpr int NSLOT=3, SLOTB=8192;
constexpr int LDS_K=0, LDS_V=NSLOT*SLOTB, LDS_WS=2*NSLOT*SLOTB, LDS_OST=LDS_WS+NW*64*4, LDS_U=LDS_OST+NW*4096, LDS_KS=LDS_U+768*4, LDS_SM=LDS_KS+16*64*4, LDS_BYTES=LDS_SM+NW*64*4;
constexpr float C2=0.125f*1.4426950408889634f;
__device__ __forceinline__ void glds16(const void*gsrc,unsigned lds_dst){unsigned keep;
  asm volatile("s_mov_b32 %0, m0\n\ts_mov_b32 m0, %2\n\ts_nop 0\n\tglobal_load_lds_dwordx4 %1, off\n\ts_mov_b32 m0, %0":"=&s"(keep):"v"(gsrc),"s"(lds_dst):"memory");}
__device__ __forceinline__ float max3f(float a,float b,float c){float r;asm("v_max3_f32 %0, %1, %2, %3":"=v"(r):"v"(a),"v"(b),"v"(c));return r;}
__device__ __forceinline__ float max2f(float a,float b){float r;asm("v_max_f32_e32 %0, %1, %2":"=v"(r):"v"(a),"v"(b));return r;}
__device__ __forceinline__ float fadd_s(float a,float b){float r;asm("v_add_f32_e32 %0, %1, %2":"=v"(r):"v"(a),"v"(b));return r;}
__device__ __forceinline__ float fsub_s(float a,float b){float r;asm("v_sub_f32_e32 %0, %1, %2":"=v"(r):"v"(a),"v"(b));return r;}
typedef float f32x2_t __attribute__((ext_vector_type(2))); typedef __bf16 bf16x2_t __attribute__((ext_vector_type(2)));
__device__ __forceinline__ unsigned cvtpk_s(float lo,float hi){f32x2_t v={lo,hi};bf16x2_t b=__builtin_convertvector(v,bf16x2_t);return __builtin_bit_cast(unsigned,b);}
#define WAIT_BAR(N) asm volatile("s_waitcnt vmcnt(" #N ") lgkmcnt(0)\n\ts_barrier":::"memory")

__device__ __forceinline__ void qkt(f32x16&p0,f32x16&p1,const char*Kslot,const bf16x8*qr,const f32x16&negm,int r32,int hi){
  const char*kb=Kslot+hi*1024+r32*16;
  #pragma unroll
  for(int d0=0;d0<4;++d0){
    const bf16x8 b0=*reinterpret_cast<const bf16x8*>(kb+d0*2048);
    const bf16x8 b1=*reinterpret_cast<const bf16x8*>(kb+d0*2048+512);
    if(d0==0){p0=__builtin_amdgcn_mfma_f32_32x32x16_bf16(b0,qr[0],negm,0,0,0);p1=__builtin_amdgcn_mfma_f32_32x32x16_bf16(b1,qr[0],negm,0,0,0);}
    else{p0=__builtin_amdgcn_mfma_f32_32x32x16_bf16(b0,qr[d0],p0,0,0,0);p1=__builtin_amdgcn_mfma_f32_32x32x16_bf16(b1,qr[d0],p1,0,0,0);}}
}
typedef __attribute__((address_space(3))) const char* lds_cptr;
typedef short v4i16_t __attribute__((ext_vector_type(4)));
__device__ __forceinline__ void kload8(bf16x8*kf,lds_cptr kp){
  kf[0]=*(const __attribute__((address_space(3))) bf16x8*)(kp);      kf[1]=*(const __attribute__((address_space(3))) bf16x8*)(kp+512);
  kf[2]=*(const __attribute__((address_space(3))) bf16x8*)(kp+2048); kf[3]=*(const __attribute__((address_space(3))) bf16x8*)(kp+2560);
  kf[4]=*(const __attribute__((address_space(3))) bf16x8*)(kp+4096); kf[5]=*(const __attribute__((address_space(3))) bf16x8*)(kp+4608);
  kf[6]=*(const __attribute__((address_space(3))) bf16x8*)(kp+6144); kf[7]=*(const __attribute__((address_space(3))) bf16x8*)(kp+6656);
}
__device__ __forceinline__ void kload2(bf16x8*kf,lds_cptr kp,int j){ kf[2*j]=*(const __attribute__((address_space(3))) bf16x8*)(kp+j*2048); kf[2*j+1]=*(const __attribute__((address_space(3))) bf16x8*)(kp+j*2048+512); }
__device__ __forceinline__ s16x4 vtr(lds_cptr p){ return __builtin_bit_cast(s16x4,__builtin_amdgcn_ds_read_tr16_b64_v4i16((__attribute__((address_space(3))) v4i16_t*)p)); }
__device__ __forceinline__ float rowmax(const f32x16&p0,const f32x16&p1){
  float a=max3f(p0[0],p0[1],p1[0]),b=max3f(p0[2],p0[3],p1[1]);a=max3f(a,p1[2],p1[3]);
  #pragma unroll
  for(int r=4;r<16;r+=4){a=max3f(a,p0[r],p0[r+1]);b=max3f(b,p0[r+2],p0[r+3]);a=max3f(a,p1[r],p1[r+1]);b=max3f(b,p1[r+2],p1[r+3]);}
  const float m=max2f(a,b);
  auto rr=__builtin_amdgcn_permlane32_swap(__float_as_uint(m),__float_as_uint(m),false,false);
  return max2f(__uint_as_float(rr[0]),__uint_as_float(rr[1]));
}
__device__ __forceinline__ void pv(f32x16*o,int vb,bf16x8 pa0,bf16x8 pa1,bf16x8 pa2,bf16x8 pa3){
  #pragma unroll
  for(int d0=0;d0<2;++d0){s16x4 lo[4],hi[4];
    #pragma unroll
    for(int ks=0;ks<4;++ks){
      asm volatile("ds_read_b64_tr_b16 %0,%1 offset:%c2":"=&v"(lo[ks]):"v"(vb),"i"(d0*4096+ks*1024):"memory");
      asm volatile("ds_read_b64_tr_b16 %0,%1 offset:%c2":"=&v"(hi[ks]):"v"(vb),"i"(d0*4096+ks*1024+512):"memory");}
    asm volatile("s_waitcnt lgkmcnt(0)":::"memory");SBAR();
    #define PK(k) (bf16x8){lo[k][0],lo[k][1],lo[k][2],lo[k][3],hi[k][0],hi[k][1],hi[k][2],hi[k][3]}
    o[d0]=__builtin_amdgcn_mfma_f32_32x32x16_bf16(pa0,PK(0),o[d0],0,0,0);
    o[d0]=__builtin_amdgcn_mfma_f32_32x32x16_bf16(pa1,PK(1),o[d0],0,0,0);
    o[d0]=__builtin_amdgcn_mfma_f32_32x32x16_bf16(pa2,PK(2),o[d0],0,0,0);
    o[d0]=__builtin_amdgcn_mfma_f32_32x32x16_bf16(pa3,PK(3),o[d0],0,0,0);
    #undef PK
  }
}

#ifndef ATTN_STORE16
#define ATTN_STORE16(p,v) (*(u32x4*)(p)=(v))
#endif
template<int THRL> __device__ __forceinline__ void attn_unit(int b,int h,int qb,const bf16*Q,const bf16*K,const bf16*V,bf16*O,const float*UG,const float*KSUM,char*shm){
  const int tid=threadIdx.x,lane=tid&63,r32=lane&31,hi=lane>>5; const int wid=__builtin_amdgcn_readfirstlane(tid>>6);
  const long rowbase=(long)b*SEQ; const int q0=qb*QB;
  const bf16*Qw=Q+(rowbase+q0+wid*QBLK)*DM+h*D;
  const bf16*Kh=K+rowbase*DM+h*D,*Vh=V+rowbase*DM+h*D;
  const unsigned lds0=(unsigned)(uintptr_t)shm;
  float*wsf=(float*)(shm+LDS_WS)+wid*64;
  const bf16*ksrc=Kh+(long)lane*DM+wid*8;
  const bf16*vsrc=Vh+(long)(16*(wid&3)+(lane>>2))*DM+(wid>>2)*32+(lane&3)*8;
  const unsigned kdst=lds0+LDS_K+wid*1024, vdst=lds0+LDS_V+wid*1024;
  #define DMA_K(t,slot) glds16(ksrc+(long)(t)*KVBLK*DM,(unsigned)__builtin_amdgcn_readfirstlane(kdst+(slot)))
  #define DMA_V(t,slot) glds16(vsrc+(long)(t)*KVBLK*DM,(unsigned)__builtin_amdgcn_readfirstlane(vdst+(slot)))
  const int vb0=(int)(lds0+LDS_V)+((lane>>4)&1)*32+(lane&3)*8+(4*hi+((lane&15)>>2))*64;
  const char*Kbase=shm+LDS_K; bf16x8 kf[8];
  const lds_cptr shm3=(lds_cptr)shm; const lds_cptr kp0=shm3+LDS_K+hi*1024+r32*16; const lds_cptr vp0=shm3+LDS_V+((lane>>4)&1)*32+(lane&3)*8+(4*hi+((lane&15)>>2))*64;
  const int NT=(q0+QB)/KVBLK;
  const float*ugp=UG+(long)h*768; const float*ksp=KSUM+((long)b*NHEAD+h)*1024;
  const float tu0=ugp[tid], tu1=(tid<256)?ugp[512+tid]:0.f, tk0=ksp[tid], tk1=ksp[512+tid];
  DMA_K(0,0);DMA_V(0,0);DMA_K(1,SLOTB);
  bf16x8 qr[4];
  #pragma unroll
  for(int d0=0;d0<4;++d0)qr[d0]=*reinterpret_cast<const bf16x8*>(&Qw[(long)r32*DM+d0*16+hi*8]);
  float mhat=0.f,l_reg=0.f;f32x16 o[2];o[0]=f32x16{};o[1]=f32x16{};f32x16 negm=f32x16{};
  const int qrel=wid*QBLK+r32;
  { float*Ul=(float*)(shm+LDS_U),*KSl=(float*)(shm+LDS_KS); Ul[tid]=tu0; if(tid<256)Ul[512+tid]=tu1; KSl[tid]=tk0; KSl[512+tid]=tk1; }
  typedef __attribute__((address_space(3))) unsigned* lds_uptr;
  #define LANEID() ((int)__builtin_amdgcn_mbcnt_hi(~0u,__builtin_amdgcn_mbcnt_lo(~0u,0u)))
  #define SMP() ((lds_uptr)((lds_cptr)shm+LDS_SM+wid*256)+LANEID())
  #define CMASK(P0,P1,t) do{int jb_=(t)-(NT-8); if(jb_>=0){ const int l_=LANEID(); biasadd(P0,P1,(lds_fptr)((lds_cptr)shm+LDS_U)+(4*(l_>>5)-(wid*QBLK+(l_&31))+255+64*jb_)); } }while(0)
  #define SETBLK(n_) do{ const int n__=(n_); float cb_=((*SMP()>>n__)&1u)?0.f:-MBIG; if(n__<qb-1)cb_+=*(lds_fptr)((lds_cptr)shm+LDS_U); cb_-=mhat; _Pragma("unroll") for(int r=0;r<16;++r)negm[r]=cb_; asm volatile("":"+v"(negm)); }while(0)
  bool resc=false;
  #define START(P0,P1) do{ const float rm=rowmax(P0,P1); resc=false; \
    { const float dl=rm; mhat=fadd_s(mhat,dl); \
      _Pragma("unroll") for(int r=0;r<16;++r){P0[r]=fsub_s(P0[r],dl);P1[r]=fsub_s(P1[r],dl);} \
      _Pragma("unroll") for(int r=0;r<16;++r)negm[r]-=dl; asm volatile("":"+v"(negm)); } \
    _Pragma("unroll") for(int r=0;r<16;++r)P0[r]=__builtin_amdgcn_exp2f(P0[r]); }while(0)
  #define RESC() do{ if(resc){ asm volatile("s_waitcnt lgkmcnt(0)":::"memory"); \
      _Pragma("unroll") for(int d_=0;d_<2;++d_) _Pragma("unroll") for(int r=0;r<16;++r)o[d_][r]*=wsf[crow(r,hi)]; } }while(0)
  f32x16 pA0,pA1,pB0,pB1;
  int sl_prev=0,sl_cur=0,sl_next=SLOTB;
  #define ROT() do{sl_prev=sl_cur;sl_cur=sl_next;sl_next=(sl_next==(NSLOT-1)*SLOTB)?0:sl_next+SLOTB;}while(0)
  DMA_K(2,2*SLOTB);
  WAIT_BAR(3);
  { unsigned selmask; if(qb<=3) selmask=(1u<<qb)-1u; else {
      float qv[32];
      _Pragma("unroll") for(int d0=0;d0<4;++d0) _Pragma("unroll") for(int j=0;j<8;++j) qv[8*d0+j]=__uint_as_float(((unsigned)(unsigned short)qr[d0][j])<<16);
      float v1=-INFINITY,v2=-INFINITY,v3=-INFINITY; int i1=0,i2=0,i3=0;
      const lds_fptr ksl=(lds_fptr)((lds_cptr)shm+LDS_KS)+8*hi;
      for(int n=0;n<qb;++n){ float a=0.f;
        _Pragma("unroll") for(int d0=0;d0<4;++d0) _Pragma("unroll") for(int j=0;j<8;++j) a+=qv[8*d0+j]*ksl[n*64+16*d0+j];
        { auto rr=__builtin_amdgcn_permlane32_swap(__float_as_uint(a),__float_as_uint(a),false,false); a=__uint_as_float(rr[0])+__uint_as_float(rr[1]); }
        if(a>v1){v3=v2;i3=i2;v2=v1;i2=i1;v1=a;i1=n;} else if(a>v2){v3=v2;i3=i2;v2=a;i2=n;} else if(a>v3){v3=a;i3=n;} }
      selmask=(1u<<i1)|(1u<<i2)|(1u<<i3); }
    selmask|=1u<<qb; *SMP()=selmask; }
  SETBLK(0);
  qkt(pA0,pA1,Kbase,qr,negm,r32,hi);asm volatile("s_nop 15\n\ts_nop 7":"+v"(pA0),"+v"(pA1));CMASK(pA0,pA1,0);
  START(pA0,pA1);
  _Pragma("unroll") for(int r=0;r<16;++r)pA1[r]=__builtin_amdgcn_exp2f(pA1[r]);
  WAIT_BAR(0);
  DMA_K(3,0);DMA_V(1,SLOTB);
  ROT();
  kload8(kf,kp0+sl_cur);
  WAIT_BAR(2);
  s16x4 vlo[8],vhi[8]; u32x4 pw0,pw1,pw2,pw3;
  #define PKW(P,B) cvtpk_s(P[B],P[B+1])
  #define PAF(k) __builtin_bit_cast(bf16x8,pw##k)
  #define VFR(i) (bf16x8){vlo[i][0],vlo[i][1],vlo[i][2],vlo[i][3],vhi[i][0],vhi[i][1],vhi[i][2],vhi[i][3]}
  #define PIN(x) asm volatile("":"+v"(x))
  #define MX3(a,b,c) __builtin_fmaxf(__builtin_fmaxf((a),(b)),(c))
  #define GAPA(MF,A0,A1,A2,A3,W0,W1,PW) do{ MF; sacc+=A0; sacc+=A1; sacc+=A2; sacc+=A3; PIN(sacc); W0; W1; PIN(PW); SBAR(); }while(0)
  #define EX(v) __builtin_amdgcn_exp2f(v)
  #define GAPB(MF,X,B) do{ MF; X[B]=EX(X[B]); X[B+1]=EX(X[B+1]); X[B+2]=EX(X[B+2]); X[B+3]=EX(X[B+3]); PIN(X); SBAR(); }while(0)
  #define VRD(i) do{ vlo[i]=vtr(vp_+(((i)>>2)*4096+((i)&3)*1024)); vhi[i]=vtr(vp_+(((i)>>2)*4096+((i)&3)*1024+512)); }while(0)
  #define KRD(G,j) do{ if(G){ kload2(kf,kp0+sl_next,j); SBAR(); } }while(0)
  #define STEP(C0,C1,P0,P1,t,GK,GV,GL) do{ if((((t))&3)==0){SETBLK((t)>>2);} SBAR(); \
    const lds_cptr vp_=vp0+sl_prev; \
    VRD(0); SBAR(); float sacc=(P0[0]+P0[1]); \
    GAPA(C0=__builtin_amdgcn_mfma_f32_32x32x16_bf16(kf[0],qr[0],negm,0,0,0), P0[2],P0[3],P0[4],P0[5],     pw0[0]=PKW(P0,0), pw0[1]=PKW(P0,2), pw0); \
    VRD(4); SBAR(); GAPA(C1=__builtin_amdgcn_mfma_f32_32x32x16_bf16(kf[1],qr[0],negm,0,0,0), P0[6],P0[7],P0[8],P0[9],     pw0[2]=PKW(P0,4), pw0[3]=PKW(P0,6), pw0); \
    VRD(1); SBAR(); GAPA(C0=__builtin_amdgcn_mfma_f32_32x32x16_bf16(kf[2],qr[1],C0,0,0,0),   P0[10],P0[11],P0[12],P0[13], pw1[0]=PKW(P0,8), pw1[1]=PKW(P0,10), pw1); \
    VRD(5); SBAR(); GAPA(C1=__builtin_amdgcn_mfma_f32_32x32x16_bf16(kf[3],qr[1],C1,0,0,0),   P0[14],P0[15],P1[0],P1[1],   pw1[2]=PKW(P0,12),pw1[3]=PKW(P0,14), pw1); \
    VRD(2); SBAR(); GAPA(C0=__builtin_amdgcn_mfma_f32_32x32x16_bf16(kf[4],qr[2],C0,0,0,0),   P1[2],P1[3],P1[4],P1[5],     pw2[0]=PKW(P1,0), pw2[1]=PKW(P1,2), pw2); \
    VRD(6); SBAR(); GAPA(C1=__builtin_amdgcn_mfma_f32_32x32x16_bf16(kf[5],qr[2],C1,0,0,0),   P1[6],P1[7],P1[8],P1[9],     pw2[2]=PKW(P1,4), pw2[3]=PKW(P1,6), pw2); \
    VRD(3); SBAR(); GAPA(C0=__builtin_amdgcn_mfma_f32_32x32x16_bf16(kf[6],qr[3],C0,0,0,0),   P1[10],P1[11],P1[12],P1[13], pw3[0]=PKW(P1,8), pw3[1]=PKW(P1,10), pw3); \
    VRD(7); SBAR(); GAPA(C1=__builtin_amdgcn_mfma_f32_32x32x16_bf16(kf[7],qr[3],C1,0,0,0),   P1[14],P1[15],0.f,0.f,       pw3[2]=PKW(P1,12),pw3[3]=PKW(P1,14), pw3); \
    l_reg+=sacc; \
    if(GK){DMA_K((t)+3,sl_cur);} if(GV){DMA_V((t)+1,sl_next);} \
    CMASK(C0,C1,t); \
    { float a=MX3(C0[0],C0[1],C1[0]),b=MX3(C0[2],C0[3],C1[1]); a=MX3(a,C1[2],C1[3]); \
      _Pragma("unroll") for(int r=4;r<16;r+=4){a=MX3(a,C0[r],C0[r+1]);b=MX3(b,C0[r+2],C0[r+3]);a=MX3(a,C1[r],C1[r+1]);b=MX3(b,C1[r+2],C1[r+3]);} \
      float rm=__builtin_fmaxf(a,b); { auto rr=__builtin_amdgcn_permlane32_swap(__float_as_uint(rm),__float_as_uint(rm),false,false); rm=__builtin_fmaxf(__uint_as_float(rr[0]),__uint_as_float(rr[1])); } \
      resc=false; \
      if(__builtin_expect(__any(rm>(float)THRL),0)){ const float dl=__builtin_fmaxf(rm,0.f); mhat+=dl; \
        _Pragma("unroll") for(int r=0;r<16;++r){C0[r]-=dl;C1[r]-=dl;} \
        _Pragma("unroll") for(int r=0;r<16;++r)negm[r]-=dl; asm volatile("":"+v"(negm)); \
        const float f=__builtin_amdgcn_exp2f(-dl); l_reg*=f; if(hi==0)wsf[r32]=f; resc=true; } } \
    SBAR(); \
    GAPB(o[0]=__builtin_amdgcn_mfma_f32_32x32x16_bf16(PAF(0),VFR(0),o[0],0,0,0), C0,0); \
    GAPB(o[1]=__builtin_amdgcn_mfma_f32_32x32x16_bf16(PAF(0),VFR(4),o[1],0,0,0), C0,4); \
    KRD(GL,0); GAPB(o[0]=__builtin_amdgcn_mfma_f32_32x32x16_bf16(PAF(1),VFR(1),o[0],0,0,0), C0,8); \
    KRD(GL,1); GAPB(o[1]=__builtin_amdgcn_mfma_f32_32x32x16_bf16(PAF(1),VFR(5),o[1],0,0,0), C0,12); \
    KRD(GL,2); GAPB(o[0]=__builtin_amdgcn_mfma_f32_32x32x16_bf16(PAF(2),VFR(2),o[0],0,0,0), C1,0); \
    KRD(GL,3); GAPB(o[1]=__builtin_amdgcn_mfma_f32_32x32x16_bf16(PAF(2),VFR(6),o[1],0,0,0), C1,4); \
    GAPB(o[0]=__builtin_amdgcn_mfma_f32_32x32x16_bf16(PAF(3),VFR(3),o[0],0,0,0), C1,8); \
    GAPB(o[1]=__builtin_amdgcn_mfma_f32_32x32x16_bf16(PAF(3),VFR(7),o[1],0,0,0), C1,12); \
    }while(0)
  int t=1;
  for(;t+5<NT;t+=2){
    STEP(pB0,pB1,pA0,pA1,t,true,true,true);     WAIT_BAR(2); RESC(); ROT();
    STEP(pA0,pA1,pB0,pB1,t+1,true,true,true);   WAIT_BAR(2); RESC(); ROT();
  }
  #define ENDW(tt) do{ if((tt)+3<NT){WAIT_BAR(2);} else if((tt)+2<NT){WAIT_BAR(1);} else {WAIT_BAR(0);} }while(0)
  for(;t+1<NT;t+=2){
    STEP(pB0,pB1,pA0,pA1,t,(t+3<NT),(t+1<NT),(t+1<NT));       ENDW(t);   RESC(); ROT();
    STEP(pA0,pA1,pB0,pB1,t+1,(t+4<NT),(t+2<NT),(t+2<NT));     ENDW(t+1); RESC(); ROT();
  }
  STEP(pB0,pB1,pA0,pA1,NT-1,false,false,false); RESC();
  { float sacc=pB0[0]+pB0[1]; _Pragma("unroll") for(int r=2;r<16;++r)sacc+=pB0[r]; _Pragma("unroll") for(int r=0;r<16;++r)sacc+=pB1[r]; l_reg+=sacc;
    pw0=(u32x4){PKW(pB0,0),PKW(pB0,2),PKW(pB0,4),PKW(pB0,6)};pw1=(u32x4){PKW(pB0,8),PKW(pB0,10),PKW(pB0,12),PKW(pB0,14)};pw2=(u32x4){PKW(pB1,0),PKW(pB1,2),PKW(pB1,4),PKW(pB1,6)};pw3=(u32x4){PKW(pB1,8),PKW(pB1,10),PKW(pB1,12),PKW(pB1,14)};
    SBAR(); pv(o,vb0+sl_cur,PAF(0),PAF(1),PAF(2),PAF(3)); }
  #undef PKW
  #undef PAF
  #undef VFR
  #undef PIN
  #undef MX3
  #undef GAPA
  #undef GAPB
  #undef EX
  #undef VRD
  #undef KRD
  #undef STEP
  #undef ENDW
  {auto rr=__builtin_amdgcn_permlane32_swap(__float_as_uint(l_reg),__float_as_uint(l_reg),false,false);l_reg=__uint_as_float(rr[0])+__uint_as_float(rr[1]);}
  if(hi==0)wsf[32+r32]=l_reg;asm volatile("s_waitcnt lgkmcnt(0)":::"memory");
  float rli[16];
  #pragma unroll
  for(int r=0;r<16;++r)rli[r]=__builtin_amdgcn_rcpf(wsf[32+crow(r,hi)]);
  bf16*Ow=O+(rowbase+q0+wid*QBLK)*OPITCH+OCOL0+h*D;
  { bf16*stg=(bf16*)(shm+LDS_OST)+wid*2048;
    #pragma unroll
    for(int r=0;r<16;++r){const int orow=crow(r,hi);
      #pragma unroll
      for(int d0=0;d0<2;++d0)stg[orow*64+d0*32+r32]=__float2bfloat16(o[d0][r]*rli[r]);}
    asm volatile("s_waitcnt lgkmcnt(0)":::"memory");
    #pragma unroll
    for(int i=0;i<4;++i){const int row=i*8+(lane>>3),ch=lane&7; const u32x4 v=*(const u32x4*)(stg+row*64+ch*8); ATTN_STORE16(Ow+(long)row*OPITCH+ch*8,v);} }
  asm volatile("s_waitcnt lgkmcnt(0)\n\ts_barrier":::"memory");
  #undef DMA_K
  #undef DMA_V
  #undef CMASK
  #undef SETBLK
  #undef SMP
  #undef LANEID
  #undef START
  #undef RESC
  #undef ROT
}
constexpr int ATTN_LDS_BYTES=LDS_BYTES;
struct AttnTensors { const bf16* Q; const bf16* K; const bf16* V; bf16* O; const float* UG; const float* KSUM; };
struct AttnUnit { int bh; int qb; };
struct StaticOrder {
  int vcu;
  __device__ __forceinline__ explicit StaticOrder(int grid,int block):vcu((block%8)*(grid/8)+block/8){}
  __device__ __forceinline__ bool next(int i,AttnUnit&u)const{ if(i>=4)return false; const int s=vcu&3; u.bh=vcu>>2; u.qb=(i==0)?15-s:(i==1)?s:(i==2)?11-s:4+s; return true; }
  __device__ __forceinline__ void a_ready(const AttnUnit&)const{}
  __device__ __forceinline__ void done(const AttnUnit&)const{}
};
template<class Sched,int THRL=8> __device__ __forceinline__ void attn_phase(char*lds,const AttnTensors&T,const Sched&S){
  AttnUnit u;
  for(int i=0;S.next(i,u);++i){ S.a_ready(u); attn_unit<THRL>(u.bh/NHEAD,u.bh%NHEAD,u.qb,T.Q,T.K,T.V,T.O,T.UG,T.KSUM,lds); S.done(u); }
}
#undef SBAR
#undef WAIT_BAR
}
struct Frame {
    LAS unsigned char* lds; volatile LAS unsigned* MISC; unsigned* ctl; unsigned char* ws;
    int tid, lane, wave, G, blk;
    const float* const* in; float* out;
};
#ifndef REP_MASK
#define REP_MASK 0u
#endif
#define REPS(j) for (int rep_ = 0; rep_ < (((REP_MASK >> (j)) & 1u) ? 2 : 1); ++rep_)
#ifndef SSD_NAIVE
#define SSD_NAIVE 0
#endif
#ifndef ATTN_NAIVE
#define ATTN_NAIVE 0
#endif
#ifndef ATTN_PROBE
#define ATTN_PROBE 0
#endif
constexpr int CW_SCAN = 2304;
constexpr int CW_WQ = 2048;
__device__ __forceinline__ unsigned char* wsp(const Frame& F) { return F.ws; }

__device__ __forceinline__ float wave_sum(float v) {
#pragma unroll
    for (int o = 1; o < 64; o <<= 1) v += __shfl_xor(v, o);
    return v;
}
__device__ __forceinline__ float wave_max(float v) {
#pragma unroll
    for (int o = 1; o < 64; o <<= 1) v = fmaxf(v, __shfl_xor(v, o));
    return v;
}

__device__ __forceinline__ void tr_item64(const float* W, int ldn, int k0, int c0, int nvalid, bf16* WT, int ldk, int dbase, int dstep32, const float* kscale, LAS unsigned short* tl, int lane) {
    const int n4 = (lane & 15) * 4, kq = lane >> 4;
    f32x4 v[16];
#pragma unroll
    for (int i = 0; i < 16; ++i) v[i] = (n4 < nvalid) ? *(const f32x4*)(W + (size_t)(k0 + 4 * i + kq) * ldn + c0 + n4) : (f32x4){0.f, 0.f, 0.f, 0.f};
#pragma unroll
    for (int i = 0; i < 16; ++i) { const int kk = 4 * i + kq; const float s = kscale ? kscale[k0 + kk] : 1.0f; v2u p; p.x = pk2(v[i].x * s, v[i].y * s); p.y = pk2(v[i].z * s, v[i].w * s); *(LAS v2u*)(tl + kk * 68 + n4) = p; }
    LDS_WAIT(); asm volatile("" ::: "memory");
    const int c = lane & 7;
#pragma unroll
    for (int j = 0; j < 8; ++j) { const int n = (lane >> 3) + 8 * j; const LAS unsigned short* s = tl + (8 * c) * 68 + n;
        v4u o; o.x = (unsigned)s[0] | ((unsigned)s[68] << 16); o.y = (unsigned)s[136] | ((unsigned)s[204] << 16); o.z = (unsigned)s[272] | ((unsigned)s[340] << 16); o.w = (unsigned)s[408] | ((unsigned)s[476] << 16);
        if (n < nvalid) *(v4u*)(WT + (size_t)(dbase + (n >> 5) * dstep32 + (n & 31)) * ldk + k0 + 8 * c) = o; }
    LDS_WAIT(); asm volatile("" ::: "memory");
}
constexpr int IT_IN = 16 * 45, IT_OUT = 256, IT_G = 4096, IT_LAYER = IT_IN + IT_OUT + 3 * IT_G;
__device__ __forceinline__ void prologue_item(Frame& F, int it, LAS unsigned short* tl, int lane) {
    unsigned char* const W_ = wsp(F);
    const int l = it / IT_LAYER; int r = it % IT_LAYER;
    bf16* Win_t = (bf16*)(W_ + WS_WIN) + (size_t)l * NIN * 1024; bf16* Wout_t = (bf16*)(W_ + WS_WOUT) + (size_t)l * 1024 * 1024;
    bf16* Wgu_t = (bf16*)(W_ + WS_WGU) + (size_t)l * 32 * 1024 * 1024; bf16* Wd_t = (bf16*)(W_ + WS_WD) + (size_t)l * 32 * 1024 * 512;
    if (r < IT_IN) { const int kb = r / 45, cb = r % 45; int c0, nv = 64, dbase, dstep = 32;
        if (cb < 8) { c0 = 64 * cb; dbase = c0; }
        else if (cb < 20) { c0 = 512 + 64 * (cb - 8); dbase = c0; }
        else if (cb == 20) { c0 = 1280; nv = 8; dbase = 2816; }
        else if (cb < 29) { const int hd = cb - 21; c0 = 1288 + 64 * hd; dbase = 256 * (5 + (hd >> 2)) + 32 * (hd & 3); dstep = 128; }
        else if (cb < 37) { const int hd = cb - 29; c0 = 1800 + 64 * hd; dbase = 256 * (7 + (hd >> 2)) + 32 * (hd & 3); dstep = 128; }
        else { const int j = cb - 37; c0 = 2312 + 64 * j; dbase = 2304 + 64 * j; }
        tr_item64(F.in[3] + (size_t)l * 1024 * INCOLS, INCOLS, 64 * kb, c0, nv, Win_t, 1024, dbase, dstep, F.in[2] + l * D, tl, lane); return; }
    r -= IT_IN;
    if (r < IT_OUT) { const int kb = r >> 4, nb = r & 15;
        tr_item64(F.in[12] + (size_t)l * 1024 * 1024, 1024, 64 * kb, 64 * nb, 64, Wout_t, 1024, 64 * nb, 32, (kb < 8) ? F.in[9] + l * 512 : nullptr, tl, lane); return; }
    r -= IT_OUT;
    if (r < 2 * IT_G) { const int up = r >= IT_G; if (up) r -= IT_G; const int e = r >> 7, q = r & 127, kb = q >> 3, nb = q & 7;
        tr_item64(F.in[up ? 19 : 18] + (size_t)(l * 32 + e) * 1024 * 512, 512, 64 * kb, 64 * nb, 64, Wgu_t + (size_t)e * 1024 * 1024, 1024, 256 * (nb >> 1) + 128 * up + 64 * (nb & 1), 32, nullptr, tl, lane); return; }
    r -= 2 * IT_G;
    { const int e = r >> 7, q = r & 127, kb = q >> 4, nb = q & 15;
        tr_item64(F.in[20] + (size_t)(l * 32 + e) * 512 * 1024, 1024, 64 * kb, 64 * nb, 64, Wd_t + (size_t)e * 1024 * 512, 512, 64 * nb, 32, nullptr, tl, lane); }
}
__device__ __forceinline__ void moe_convert_all(Frame& F, int l) {
    int ln = F.lane; asm volatile("" : "+v"(ln));
    LAS unsigned short* scr = (LAS unsigned short*)(F.lds + F.wave * 16384);
    const int gw = F.blk * NWAVES + F.wave;
#pragma unroll 1
    for (int j = 0; j < 6; ++j) prologue_item(F, l * IT_LAYER + IT_IN + IT_OUT + j * (GRID * NWAVES) + gw, scr, ln);
    __syncthreads();
}
__device__ __forceinline__ void rms_row_store(const f32x4 (&v)[4], const float* g, bf16* orow, int lane) {
    float s = 0.f;
#pragma unroll
    for (int j = 0; j < 4; ++j) s += (v[j].x * v[j].x + v[j].y * v[j].y) + (v[j].z * v[j].z + v[j].w * v[j].w);
    const float rs = 1.0f / sqrtf(wave_sum(s) * (1.0f / D) + EPS);
#pragma unroll
    for (int j = 0; j < 4; ++j) { const f32x4 gj = *((const f32x4*)g + lane + 64 * j); const f32x4 o = v[j] * rs * gj;
        v2u w; w.x = pk2(o.x, o.y); w.y = pk2(o.z, o.w); *((v2u*)orow + lane + 64 * j) = w; }
}
__device__ __forceinline__ void phase_prologue(Frame& F) {
    unsigned char* const W_ = wsp(F);
    LAS unsigned short* scr = (LAS unsigned short*)(F.lds + F.wave * 16384);
    const int gw = F.blk * NWAVES + F.wave, NGW = F.G * NWAVES;
    constexpr int IT_ESS = IT_IN + IT_OUT;
    for (int it = gw; it < DEPTH * IT_ESS; it += NGW) prologue_item(F, (it / IT_ESS) * IT_LAYER + (it % IT_ESS), scr, F.lane);
    for (int r = gw; r < DEPTH * 248; r += NGW) { const int l = r / 248, rr = r % 248; v4u* p = (v4u*)((bf16*)(W_ + WS_WIN) + ((size_t)l * NIN + 2824 + rr) * 1024);
        p[F.lane] = (v4u){0u, 0u, 0u, 0u}; p[64 + F.lane] = (v4u){0u, 0u, 0u, 0u}; }
    { bf16* wrh = (bf16*)(W_ + WS_WR); bf16* wrl = wrh + DEPTH * 64 * 1024;
      for (int i = F.blk * NTHREADS + F.tid; i < DEPTH * 64 * 1024; i += F.G * NTHREADS) { const int l = i >> 16, c = (i >> 10) & 63, k = i & 1023; float v = 0.f;
          if (c < 36) v = F.in[13][l * D + k] * ((c < 4) ? F.in[14][((size_t)l * 1024 + k) * 4 + c] : F.in[16][((size_t)l * 1024 + k) * 32 + (c - 4)]);
          const unsigned h = f2bf(v); const float r = v - __builtin_bit_cast(float, h << 16); wrh[i] = (bf16)h; wrl[i] = (bf16)f2bf(r); } }
    float* tb = (float*)(W_ + WS_TB);
    { const int i = F.blk * NTHREADS + F.tid;
      if (i < 1024) { const int h = i >> 7, d = i & 127; int bk = d; if (d >= 16) { bk = 16 + (int)(log2f((float)d * (1.0f / 16.0f)) * (16.0f / 3.0f)); bk = bk > 31 ? 31 : bk; } tb[i] = F.in[1][bk * 8 + h] * LOG2E; }
      else if (i < 1032) tb[i] = F.in[1][31 * 8 + (i - 1024)] * LOG2E; }
    { float* ug = (float*)(W_ + WS_UG);
      for (int i = F.blk * NTHREADS + F.tid; i < 8 * 768; i += F.G * NTHREADS) { const int h = i / 768, d = 511 - (i % 768); float v;
          if (d < 0) v = -1e30f; else { int bk = d; if (d >= 16) { bk = 16 + (int)(log2f((float)d * (1.0f / 16.0f)) * (16.0f / 3.0f)); bk = bk > 31 ? 31 : bk; } v = F.in[1][bk * 8 + h] * LOG2E; }
          ug[i] = v; } }
    bf16* hb = (bf16*)(W_ + WS_HB); float* rs1 = (float*)(W_ + WS_RS1);
    for (int t = gw; t < T; t += NGW) { const f32x4* xr = (const f32x4*)(F.in[0] + (size_t)t * D) + F.lane; float s = 0.f;
#pragma unroll
        for (int j = 0; j < 4; ++j) { const f32x4 v = xr[64 * j]; v2u w; w.x = pk2(v.x, v.y); w.y = pk2(v.z, v.w); *((v2u*)(hb + (size_t)t * D) + F.lane + 64 * j) = w;
            const float a0 = bflo(w.x), a1 = bfhi(w.x), a2 = bflo(w.y), a3 = bfhi(w.y); s += (a0 * a0 + a1 * a1) + (a2 * a2 + a3 * a3); }
        s = wave_sum(s); if (F.lane == 0) rs1[t] = 1.0f / sqrtf(s * (1.0f / D) + EPS); }
}
template <bool DUMMY = false> __device__ __forceinline__ void phase_combine(Frame& F, int lnext) {
    unsigned char* const W_ = wsp(F);
    const int gw = F.blk * NWAVES + F.wave; const int t0 = gw * 16;
    const unsigned* route = (const unsigned*)(W_ + WS_ROUTE); const bf16* y = (const bf16*)(W_ + R1_XG); bf16* hb = (bf16*)(W_ + WS_HB);
    float* rs1 = (float*)(W_ + (DUMMY ? R1_HMID : WS_RS1));
    const v4u rw = *(const v4u*)(route + (size_t)(t0 + (F.lane & 15)) * 8 + 4);
#pragma unroll 1
    for (int i4 = 0; i4 < 16; i4 += 4) {
        v2u hv[4][4], ya[4][4], yb[4][4]; float g0[4], g1[4];
#pragma unroll
        for (int q = 0; q < 4; ++q) { const unsigned s0 = (unsigned)__shfl((int)rw.z, i4 + q), s1 = (unsigned)__shfl((int)rw.w, i4 + q); g0[q] = __builtin_bit_cast(float, __shfl((int)rw.x, i4 + q)); g1[q] = __builtin_bit_cast(float, __shfl((int)rw.y, i4 + q));
            const v2u* hr = (const v2u*)(hb + (size_t)(t0 + i4 + q) * D) + F.lane; const v2u* y0 = (const v2u*)(y + (size_t)s0 * D) + F.lane; const v2u* y1 = (const v2u*)(y + (size_t)s1 * D) + F.lane;
#pragma unroll
            for (int j = 0; j < 4; ++j) { hv[q][j] = hr[64 * j]; ya[q][j] = y0[64 * j]; yb[q][j] = y1[64 * j]; } }
#pragma unroll
        for (int q = 0; q < 4; ++q) { const int t = t0 + i4 + q; f32x4 v[4];
#pragma unroll
            for (int j = 0; j < 4; ++j) { const v2u h2 = hv[q][j], a = ya[q][j], b = yb[q][j];
                v[j].x = bflo(h2.x) + (g0[q] * bflo(a.x) + g1[q] * bflo(b.x)); v[j].y = bfhi(h2.x) + (g0[q] * bfhi(a.x) + g1[q] * bfhi(b.x)); v[j].z = bflo(h2.y) + (g0[q] * bflo(a.y) + g1[q] * bflo(b.y)); v[j].w = bfhi(h2.y) + (g0[q] * bfhi(a.y) + g1[q] * bfhi(b.y)); }
            if (lnext < DEPTH) { v2u* hw = DUMMY ? (v2u*)((unsigned char*)F.out + 64 * MiB + (size_t)t * D * 2) + F.lane : (v2u*)(hb + (size_t)t * D) + F.lane;
                float ss = 0.f;
#pragma unroll
                for (int j = 0; j < 4; ++j) { v2u w; w.x = pk2(v[j].x, v[j].y); w.y = pk2(v[j].z, v[j].w); hw[64 * j] = w; const float a0 = bflo(w.x), a1 = bfhi(w.x), a2 = bflo(w.y), a3 = bfhi(w.y); ss += (a0 * a0 + a1 * a1) + (a2 * a2 + a3 * a3); }
                ss = wave_sum(ss); if (F.lane == 0) rs1[t] = 1.0f / sqrtf(ss * (1.0f / D) + EPS);
            } else {
#pragma unroll
                for (int j = 0; j < 4; ++j) *((f32x4*)(F.out + (size_t)t * D) + F.lane + 64 * j) = v[j];
            } }
    }
}
__device__ __forceinline__ void phase_conv(Frame& F, int l) {
    unsigned char* const W_ = wsp(F);
    const bf16* xbc = (const bf16*)(W_ + R1_XBC); bf16* xact = (bf16*)(W_ + WS_XN);
    const float* cw = F.in[4] + (size_t)l * 4 * CCH; const float* cb = F.in[5] + (size_t)l * CCH;
    for (int i = F.blk * NTHREADS + F.tid; i < T * 96; i += F.G * NTHREADS) { const int t = i / 96, c0 = (i % 96) * 8, s = t % SEQ;
        float a[8];
#pragma unroll
        for (int q = 0; q < 8; ++q) a[q] = cb[c0 + q];
#pragma unroll
        for (int j = 0; j < 4; ++j) { if (s - 3 + j >= 0) { const v4u w = *(const v4u*)(xbc + (size_t)(t - 3 + j) * CCH + c0); const float* wj = cw + j * CCH + c0;
            a[0] += wj[0] * bflo(w.x); a[1] += wj[1] * bfhi(w.x); a[2] += wj[2] * bflo(w.y); a[3] += wj[3] * bfhi(w.y); a[4] += wj[4] * bflo(w.z); a[5] += wj[5] * bfhi(w.z); a[6] += wj[6] * bflo(w.w); a[7] += wj[7] * bfhi(w.w); } }
#pragma unroll
        for (int q = 0; q < 8; ++q) a[q] = a[q] / (1.0f + __expf(-a[q]));
        v4u o; o.x = pk2(a[0], a[1]); o.y = pk2(a[2], a[3]); o.z = pk2(a[4], a[5]); o.w = pk2(a[6], a[7]);
        *(v4u*)(xact + (size_t)t * CCH + c0) = o; }
}
__device__ __forceinline__ void ssd_naive_item(Frame& F, int l, int item) {
    unsigned char* const W_ = wsp(F);
    const bf16* xact = (const bf16*)(W_ + WS_XN); const float* dtb = (const float*)(W_ + R1_DT); const bf16* zb = (const bf16*)(W_ + R1_Z); bf16* ymix = (bf16*)(W_ + R1_YMIX);
    const int lane = F.lane, pi = lane >> 4, ng = lane & 15;
    const int b = item >> 7, head = (item >> 4) & 7, pq = item & 15, p = 4 * pq + pi, g = head >> 2;
    const float A = -__expf(F.in[7][l * 8 + head]), dtbias = F.in[6][l * 8 + head], Dk = F.in[8][l * 8 + head];
    float h0 = 0.f, h1 = 0.f, h2 = 0.f, h3 = 0.f;
    const size_t r0 = (size_t)b * SEQ;
#pragma unroll 4
    for (int t = 0; t < SEQ; ++t) { const size_t row = r0 + t;
        const float dr = dtb[row * 8 + head] + dtbias; const float dtv = fmaxf(dr, 0.f) + log1pf(__expf(-fabsf(dr))); const float dA = __expf(dtv * A);
        const float x = bf1(xact[row * CCH + head * 64 + p]);
        const v2u bw = *(const v2u*)(xact + row * CCH + 512 + g * 64 + 4 * ng), cw = *(const v2u*)(xact + row * CCH + 640 + g * 64 + 4 * ng);
        const float xdt = x * dtv;
        h0 = h0 * dA + xdt * bflo(bw.x); h1 = h1 * dA + xdt * bfhi(bw.x); h2 = h2 * dA + xdt * bflo(bw.y); h3 = h3 * dA + xdt * bfhi(bw.y);
        float part = (h0 * bflo(cw.x) + h1 * bfhi(cw.x)) + (h2 * bflo(cw.y) + h3 * bfhi(cw.y));
        part += __shfl_xor(part, 1); part += __shfl_xor(part, 2); part += __shfl_xor(part, 4); part += __shfl_xor(part, 8);
        const float yv = part + Dk * x; const float zt = bf1(zb[row * DI + head * 64 + p]); const float yg = yv * zt / (1.0f + __expf(-zt));
        if (ng == 0) ymix[row * 1024 + head * 64 + p] = (bf16)f2bf(yg);
    }
}
__device__ __forceinline__ void attn_naive_query(Frame& F, int b, int h, int s, const float* ksum) {
    unsigned char* const W_ = wsp(F);
    const bf16* qbuf = (const bf16*)(W_ + R1_Q); const bf16* kbuf = (const bf16*)(W_ + R1_K); const bf16* vbuf = (const bf16*)(W_ + R1_V); bf16* ymix = (bf16*)(W_ + R1_YMIX);
    const float* tb = (const float*)(W_ + WS_TB);
    const int lane = F.lane, qb = s >> 8; const size_t rowq = (size_t)b * SEQ + s;
    float qf[64];
    { const v4u* qp = (const v4u*)(qbuf + rowq * 512 + h * 64);
#pragma unroll
      for (int i = 0; i < 8; ++i) { const v4u w = qp[i]; qf[8 * i] = bflo(w.x); qf[8 * i + 1] = bfhi(w.x); qf[8 * i + 2] = bflo(w.y); qf[8 * i + 3] = bfhi(w.y); qf[8 * i + 4] = bflo(w.z); qf[8 * i + 5] = bfhi(w.z); qf[8 * i + 6] = bflo(w.w); qf[8 * i + 7] = bfhi(w.w); } }
    float gv = -INFINITY;
    if (lane < qb) { const f32x4* kp = (const f32x4*)(ksum + (((size_t)b * 8 + h) * 16 + lane) * 64); float a = 0.f;
#pragma unroll
        for (int i = 0; i < 16; ++i) { const f32x4 kv = kp[i]; a += (qf[4 * i] * kv.x + qf[4 * i + 1] * kv.y) + (qf[4 * i + 2] * kv.z + qf[4 * i + 3] * kv.w); }
        gv = a; }
    unsigned selmask = 0u;
    for (int r = 0; r < 3; ++r) { float best = gv; int bi = lane;
#pragma unroll
        for (int o = 1; o < 64; o <<= 1) { const float ob = __shfl_xor(best, o); const int oi = __shfl_xor(bi, o); if (ob > best || (ob == best && oi < bi)) { best = ob; bi = oi; } }
        if (best > -INFINITY) selmask |= 1u << bi;
        if (lane == bi) gv = -INFINITY; }
    selmask = (unsigned)__builtin_amdgcn_readfirstlane((int)selmask) | (1u << qb);
    float m = -INFINITY, lsum = 0.f, o = 0.f;
    for (int bi2 = 0; bi2 <= qb; ++bi2) { const int n = qb - bi2;
        if (!((selmask >> n) & 1u)) continue;
        for (int tt = 0; tt < 4; ++tt) { const int key0 = n * 256 + tt * 64; if (key0 > s) break; const int key = key0 + lane;
            const v4u* kp = (const v4u*)(kbuf + ((size_t)b * SEQ + key) * 512 + h * 64); float sc = 0.f;
#pragma unroll
            for (int i = 0; i < 8; ++i) { const v4u w = kp[i]; sc += (qf[8 * i] * bflo(w.x) + qf[8 * i + 1] * bfhi(w.x)) + (qf[8 * i + 2] * bflo(w.y) + qf[8 * i + 3] * bfhi(w.y)) + (qf[8 * i + 4] * bflo(w.z) + qf[8 * i + 5] * bfhi(w.z)) + (qf[8 * i + 6] * bflo(w.w) + qf[8 * i + 7] * bfhi(w.w)); }
            const int dist = s - key; const float bias = (dist < 128) ? tb[h * 128 + (dist < 0 ? 0 : dist)] : tb[1024 + h];
            sc = (dist < 0) ? -INFINITY : sc + bias;
            const float mn = fmaxf(m, wave_max(sc)); const float f = __builtin_amdgcn_exp2f(m - mn), p = __builtin_amdgcn_exp2f(sc - mn); m = mn;
            lsum = lsum * f + wave_sum(p); o *= f;
            const bf16* vp = vbuf + ((size_t)b * SEQ + key0) * 512 + h * 64 + lane;
#pragma unroll 16
            for (int j = 0; j < 64; ++j) { const float pj = __builtin_bit_cast(float, __builtin_amdgcn_readlane(__builtin_bit_cast(int, p), j)); o += pj * bf1(vp[(size_t)j * 512]); }
        } }
#if ATTN_PROBE
    { const size_t ix = rowq * 1024 + 512 + h * 64 + lane; const float fast = bf1(ymix[ix]); ymix[ix] = (bf16)f2bf(fast + (float)ATTN_PROBE * (fast - o / lsum)); }
#else
    ymix[rowq * 1024 + 512 + h * 64 + lane] = (bf16)f2bf(o / lsum);
#endif
}
namespace ssd {
typedef short bf16x8 __attribute__((ext_vector_type(8)));
typedef short bf16x4 __attribute__((ext_vector_type(4)));
typedef float f32x16 __attribute__((ext_vector_type(16)));
typedef float f32x2_t __attribute__((ext_vector_type(2))); typedef __bf16 bf16x2_t __attribute__((ext_vector_type(2)));
__device__ __forceinline__ unsigned cvtpk(float lo, float hi) { f32x2_t v = {lo, hi}; bf16x2_t b = __builtin_convertvector(v, bf16x2_t); return __builtin_bit_cast(unsigned, b); }
__device__ __forceinline__ int crow(int r, int hi) { return (r & 3) + 8 * (r >> 2) + 4 * hi; }
__device__ __forceinline__ float softplus_f(float x) { return fmaxf(x, 0.f) + log1pf(__expf(-fabsf(x))); }
__device__ __forceinline__ void chunk_scalars(const float* dtraw, int t0, int head, float dtbias, float A, int lane, float& dt0, float& dt1, float& cs0, float& cs1) {
    dt0 = softplus_f(dtraw[(size_t)(t0 + lane) * 8 + head] + dtbias); dt1 = softplus_f(dtraw[(size_t)(t0 + 64 + lane) * 8 + head] + dtbias);
    float v0 = dt0 * A, v1 = dt1 * A;
#pragma unroll
    for (int o = 1; o < 64; o <<= 1) { const float a = __shfl_up(v0, o), b = __shfl_up(v1, o); if (lane >= o) { v0 += a; v1 += b; } }
    cs0 = v0; cs1 = v1 + __shfl(v0, 63);
}
}

__device__ __forceinline__ void phase_ssd_prep(Frame& F, int l) {
    unsigned char* const W_ = wsp(F);
    const bf16* xbc = (const bf16*)(W_ + R1_XBC); bf16* XT = (bf16*)((unsigned char*)F.out + SS_XT); bf16* BT = (bf16*)((unsigned char*)F.out + SS_BT); bf16* BC = (bf16*)((unsigned char*)F.out + SS_BC);
    const float* cw = F.in[4] + (size_t)l * 4 * CCH; const float* cb = F.in[5] + (size_t)l * CCH;
    for (int i = F.tid; i < 16 * 96; i += NTHREADS) { const int tgl = i & 7, cgl = (i >> 3) & 7, wv_ = i >> 6, cgo = wv_ % 12, tgo = wv_ / 12, b = F.blk >> 5; const int cg = cgo * 8 + cgl, tg = (F.blk & 31) * 16 + tgo * 8 + tgl; const int c0 = cg * 8, s0 = tg * 8; const size_t r0 = (size_t)b * SEQ + s0;
        float w[4][8], bias[8];
#pragma unroll
        for (int j = 0; j < 4; ++j) { const f32x4 a = *(const f32x4*)(cw + j * CCH + c0), b2 = *(const f32x4*)(cw + j * CCH + c0 + 4); w[j][0] = a.x; w[j][1] = a.y; w[j][2] = a.z; w[j][3] = a.w; w[j][4] = b2.x; w[j][5] = b2.y; w[j][6] = b2.z; w[j][7] = b2.w; }
        { const f32x4 a = *(const f32x4*)(cb + c0), b2 = *(const f32x4*)(cb + c0 + 4); bias[0] = a.x; bias[1] = a.y; bias[2] = a.z; bias[3] = a.w; bias[4] = b2.x; bias[5] = b2.y; bias[6] = b2.z; bias[7] = b2.w; }
        v4u xin[11];
#pragma unroll
        for (int j = 0; j < 11; ++j) xin[j] = (s0 - 3 + j >= 0) ? *(const v4u*)(xbc + (r0 + j - 3) * CCH + c0) : (v4u){0u, 0u, 0u, 0u};
        unsigned o[8][8];
#pragma unroll
        for (int t = 0; t < 8; ++t) {
            float a[8];
#pragma unroll
            for (int q = 0; q < 8; ++q) a[q] = bias[q];
#pragma unroll
            for (int j = 0; j < 4; ++j) { const v4u x = xin[t + j];
                a[0] += w[j][0] * bflo(x.x); a[1] += w[j][1] * bfhi(x.x); a[2] += w[j][2] * bflo(x.y); a[3] += w[j][3] * bfhi(x.y); a[4] += w[j][4] * bflo(x.z); a[5] += w[j][5] * bfhi(x.z); a[6] += w[j][6] * bflo(x.w); a[7] += w[j][7] * bfhi(x.w); }
#pragma unroll
            for (int q = 0; q < 8; ++q) o[t][q] = f2bf(a[q] * __builtin_amdgcn_rcpf(1.0f + __builtin_amdgcn_exp2f(-LOG2E * a[q])));
        }
        if (c0 >= 512) {
#pragma unroll
            for (int t = 0; t < 8; ++t) { v4u pk; pk.x = o[t][0] | (o[t][1] << 16); pk.y = o[t][2] | (o[t][3] << 16); pk.z = o[t][4] | (o[t][5] << 16); pk.w = o[t][6] | (o[t][7] << 16); *(v4u*)(BC + (r0 + t) * 256 + (c0 - 512)) = pk; } }
        if (c0 < 640) {
#pragma unroll
            for (int q = 0; q < 8; ++q) { v4u pk; pk.x = o[0][q] | (o[1][q] << 16); pk.y = o[2][q] | (o[3][q] << 16); pk.z = o[4][q] | (o[5][q] << 16); pk.w = o[6][q] | (o[7][q] << 16); const int c = c0 + q;
                bf16* dst = (c0 < 512) ? XT + ((size_t)(b * 8 + (c >> 6)) * 64 + (c & 63)) * SEQ + s0 : BT + ((size_t)(b * 2 + ((c - 512) >> 6)) * 64 + ((c - 512) & 63)) * SEQ + s0;
                *(v4u*)dst = pk; } }
    }
}
__device__ __forceinline__ void ssd_states_item(Frame& F, int l, int wgi) {
    unsigned char* const W_ = wsp(F);
    const int lane = F.lane, r32 = lane & 31, hi = lane >> 5;
    const int b = wgi >> 6, c = (wgi >> 1) & 31, g = wgi & 1, head = g * 4 + (F.wave >> 1), ph = F.wave & 1;
    const int t0 = b * SEQ + c * 128; const int item = ((b * 8 + head) * 2 + ph) * 32 + c;
    LAS float* SC = (LAS float*)(F.lds + F.wave * 8192);
    const bf16* bt = (const bf16*)((unsigned char*)F.out + SS_BT) + ((size_t)(b * 2 + g) * 64 + r32) * SEQ + c * 128 + 8 * hi;
    const bf16* xt = (const bf16*)((unsigned char*)F.out + SS_XT) + ((size_t)(b * 8 + head) * 64 + ph * 32 + r32) * SEQ + c * 128 + 8 * hi;
    ssd::bf16x8 fa0[8], fa1[8]; v4u fx[8];
#pragma unroll
    for (int k = 0; k < 8; ++k) { fa0[k] = *(const ssd::bf16x8*)(bt + 16 * k); fa1[k] = *(const ssd::bf16x8*)(bt + (size_t)32 * SEQ + 16 * k); fx[k] = *(const v4u*)(xt + 16 * k); }
    float dt0, dt1, cs0, cs1; ssd::chunk_scalars((const float*)(W_ + R1_DT), t0, head, F.in[6][l * 8 + head], -__expf(F.in[7][l * 8 + head]), lane, dt0, dt1, cs0, cs1);
    const float cend = __shfl(cs1, 63);
    SC[lane] = dt0 * __expf(cend - cs0); SC[64 + lane] = dt1 * __expf(cend - cs1);
    LDS_WAIT(); asm volatile("" ::: "memory");
    ssd::f32x16 acc0 = {}, acc1 = {};
#pragma unroll
    for (int k = 0; k < 8; ++k) {
        const v4u xw = fx[k];
        const f32x4 s0 = *(const LAS f32x4*)(SC + 16 * k + 8 * hi), s1 = *(const LAS f32x4*)(SC + 16 * k + 8 * hi + 4);
        v4u xs; xs.x = ssd::cvtpk(bflo(xw.x) * s0.x, bfhi(xw.x) * s0.y); xs.y = ssd::cvtpk(bflo(xw.y) * s0.z, bfhi(xw.y) * s0.w); xs.z = ssd::cvtpk(bflo(xw.z) * s1.x, bfhi(xw.z) * s1.y); xs.w = ssd::cvtpk(bflo(xw.w) * s1.z, bfhi(xw.w) * s1.w);
        const ssd::bf16x8 xb = __builtin_bit_cast(ssd::bf16x8, xs);
        acc0 = __builtin_amdgcn_mfma_f32_32x32x16_bf16(fa0[k], xb, acc0, 0, 0, 0); acc1 = __builtin_amdgcn_mfma_f32_32x32x16_bf16(fa1[k], xb, acc1, 0, 0, 0);
    }
    float* S = (float*)((unsigned char*)F.out + SS_S) + (size_t)item * 2048 + lane;
#pragma unroll
    for (int r = 0; r < 16; ++r) { S[r * 64] = acc0[r]; S[(16 + r) * 64] = acc1[r]; }
    if (lane == 0) ((float*)(W_ + SS_DEC))[item] = __expf(cend);
    LDS_WAIT(); asm volatile("" ::: "memory");
}
__device__ __forceinline__ void phase_ssd_scan(Frame& F, unsigned* ctr) {
    unsigned char* const W_ = wsp(F);
    const f32x4* S4 = (const f32x4*)((unsigned char*)F.out + SS_S); const float* dec = (const float*)(W_ + SS_DEC);
    const __amdgpu_buffer_rsrc_t rs = __builtin_amdgcn_make_buffer_rsrc((void*)((unsigned char*)F.out + SS_S), 0, 32 * 1024 * 1024, 0x00020000);
    for (int i = F.blk * NTHREADS + F.tid; i < 128 * 512; i += F.G * NTHREADS) { const int bhp = i >> 9, e4 = i & 511; f32x4 hs = {0.f, 0.f, 0.f, 0.f};
#pragma unroll
        for (int half = 0; half < 2; ++half) { f32x4 sv[16]; float dv[16];
#pragma unroll
            for (int c = 0; c < 16; ++c) { sv[c] = S4[(size_t)(bhp * 32 + half * 16 + c) * 512 + e4]; dv[c] = dec[bhp * 32 + half * 16 + c]; }
#pragma unroll
            for (int c = 0; c < 16; ++c) { __builtin_amdgcn_raw_buffer_store_b128(__builtin_bit_cast(v4u, hs), rs, (int)(((size_t)(bhp * 32 + half * 16 + c) * 512 + e4) * 16), 0, 16); hs = hs * dv[c] + sv[c]; } } }
    asm volatile("s_waitcnt vmcnt(0)" ::: "memory");
    __syncthreads();
    if (F.tid == 0) __hip_atomic_fetch_add(ctr, 1u, RLX_AGENT);
}
__device__ __forceinline__ void ssd_scan_wait(Frame& F, unsigned* ctr) {
    if (F.tid == 0) { unsigned sp = 0;
        while (ald(ctr) < (unsigned)F.G) { __builtin_amdgcn_s_sleep(2); if (++sp > (1u << 22)) { __hip_atomic_store(F.ctl + 1, 0x5CA0u, RLX_AGENT); break; } }
        __builtin_amdgcn_fence(__ATOMIC_ACQUIRE, "agent");
        asm volatile("s_waitcnt vmcnt(0)" ::: "memory"); }
    __syncthreads();
}
__device__ __forceinline__ void ssd_output_item(Frame& F, int l, int wgi) {
    unsigned char* const W_ = wsp(F);
    const int lane = F.lane, r32 = lane & 31, hi = lane >> 5;
    const int b = wgi >> 6, c = (wgi >> 1) & 31, g = wgi & 1, head = g * 4 + (F.wave >> 1), ph = F.wave & 1;
    const int t0 = b * SEQ + c * 128; const int item = ((b * 8 + head) * 2 + ph) * 32 + c;
    LAS float* ACS = (LAS float*)(F.lds + F.wave * 8192); LAS float* DTV = ACS + 128; LAS float* WV = ACS + 256; LAS float* EC = ACS + 384; LAS float* ST = ACS + 512;
    const float Dk = F.in[8][l * 8 + head];
    LAS unsigned char* BL = F.lds + 65536; LAS unsigned char* CL = BL + 128 * 144;
    v4u sb[2], sc2[2];
    { const bf16* src = (const bf16*)((unsigned char*)F.out + SS_BC) + (size_t)t0 * 256 + g * 64;
#pragma unroll
      for (int i = 0; i < 2; ++i) { const int pc = F.tid + 512 * i, row = pc >> 3, ch = pc & 7; sb[i] = *(const v4u*)(src + (size_t)row * 256 + ch * 8); sc2[i] = *(const v4u*)(src + (size_t)row * 256 + 128 + ch * 8); } }
    const bf16* xt = (const bf16*)((unsigned char*)F.out + SS_XT) + ((size_t)(b * 8 + head) * 64 + ph * 32 + r32) * SEQ + c * 128 + 4 * hi;
    ssd::bf16x8 xfa[4][2];
#pragma unroll
    for (int st = 0; st < 4; ++st)
#pragma unroll
        for (int k2 = 0; k2 < 2; ++k2) { const v2u lo = *(const v2u*)(xt + 32 * st + 16 * k2), hi2 = *(const v2u*)(xt + 32 * st + 16 * k2 + 8); v4u w; w.x = lo.x; w.y = lo.y; w.z = hi2.x; w.w = hi2.y; xfa[st][k2] = __builtin_bit_cast(ssd::bf16x8, w); }
    float hv[2][2][8];
    { const float* Hp = (const float*)((unsigned char*)F.out + SS_S) + (size_t)item * 2048 + lane;
#pragma unroll
      for (int nt = 0; nt < 2; ++nt)
#pragma unroll
          for (int k2 = 0; k2 < 2; ++k2)
#pragma unroll
              for (int j = 0; j < 8; ++j) hv[nt][k2][j] = Hp[(nt * 16 + 8 * k2 + j) * 64]; }
    { float dt0, dt1, cs0, cs1; ssd::chunk_scalars((const float*)(W_ + R1_DT), t0, head, F.in[6][l * 8 + head], -__expf(F.in[7][l * 8 + head]), lane, dt0, dt1, cs0, cs1);
      ACS[lane] = cs0; ACS[64 + lane] = cs1; DTV[lane] = dt0; DTV[64 + lane] = dt1; EC[lane] = __expf(cs0); EC[64 + lane] = __expf(cs1);
      const float e0 = __shfl(cs0, lane | 31), e1 = __shfl(cs1, lane | 31);
      WV[lane] = dt0 * __expf(e0 - cs0); WV[64 + lane] = dt1 * __expf(e1 - cs1); }
#pragma unroll
    for (int i = 0; i < 2; ++i) { const int pc = F.tid + 512 * i, row = pc >> 3, ch = pc & 7; *(LAS v4u*)(BL + row * 144 + ch * 16) = sb[i]; *(LAS v4u*)(CL + row * 144 + ch * 16) = sc2[i]; }
    __syncthreads();
    v4u hb[2][2];
#pragma unroll
    for (int nt = 0; nt < 2; ++nt)
#pragma unroll
        for (int k2 = 0; k2 < 2; ++k2) { hb[nt][k2].x = ssd::cvtpk(hv[nt][k2][0], hv[nt][k2][1]); hb[nt][k2].y = ssd::cvtpk(hv[nt][k2][2], hv[nt][k2][3]); hb[nt][k2].z = ssd::cvtpk(hv[nt][k2][4], hv[nt][k2][5]); hb[nt][k2].w = ssd::cvtpk(hv[nt][k2][6], hv[nt][k2][7]); }
    const bf16* zb = (const bf16*)(W_ + R1_Z); bf16* ymix = (bf16*)(W_ + R1_YMIX); float* ssq = (float*)(W_ + SS_SSQ);
#define SSD_LOAD_S(st_) \
        ssd::bf16x8 bf[4]; \
        _Pragma("unroll") for (int k = 0; k < 4; ++k) bf[k] = *(const LAS ssd::bf16x8*)(BL + (32 * (st_) + r32) * 144 + 32 * k + 16 * hi);
#define SSD_APPLY(XF0, XF1) do { \
        v4u p0, p1; p0.x = ssd::cvtpk(Tt[0], Tt[1]); p0.y = ssd::cvtpk(Tt[2], Tt[3]); p0.z = ssd::cvtpk(Tt[4], Tt[5]); p0.w = ssd::cvtpk(Tt[6], Tt[7]); \
        p1.x = ssd::cvtpk(Tt[8], Tt[9]); p1.y = ssd::cvtpk(Tt[10], Tt[11]); p1.z = ssd::cvtpk(Tt[12], Tt[13]); p1.w = ssd::cvtpk(Tt[14], Tt[15]); \
        Yt = __builtin_amdgcn_mfma_f32_32x32x16_bf16(__builtin_bit_cast(ssd::bf16x8, p0), XF0, Yt, 0, 0, 0); \
        Yt = __builtin_amdgcn_mfma_f32_32x32x16_bf16(__builtin_bit_cast(ssd::bf16x8, p1), XF1, Yt, 0, 0, 0); } while (0)
#pragma unroll 1
    for (int lt = 0; lt < 4; ++lt) {
        const int lr = lane >> 1, c0 = (lane & 1) * 16; const size_t row = (size_t)t0 + 32 * lt + lr;
        const v4u z0 = *(const v4u*)(zb + row * DI + head * 64 + ph * 32 + c0), z1 = *(const v4u*)(zb + row * DI + head * 64 + ph * 32 + c0 + 8);
        ssd::f32x16 Yt = {};
        ssd::bf16x8 cf[4];
#pragma unroll
        for (int k = 0; k < 4; ++k) cf[k] = *(const LAS ssd::bf16x8*)(CL + (32 * lt + r32) * 144 + 32 * k + 16 * hi);
        const float al = ACS[32 * lt + r32];
#pragma unroll 1
        for (int st = 0; st < lt; ++st) {
            SSD_LOAD_S(st)
            ssd::f32x16 Tt = {};
#pragma unroll
            for (int k = 0; k < 4; ++k) Tt = __builtin_amdgcn_mfma_f32_32x32x16_bf16(bf[k], cf[k], Tt, 0, 0, 0);
            const float sc = __expf(al - ACS[32 * st + 31]);
#pragma unroll
            for (int q = 0; q < 4; ++q) { const f32x4 a = *(const LAS f32x4*)(WV + 32 * st + 4 * hi + 8 * q); Tt[4 * q] *= sc * a.x; Tt[4 * q + 1] *= sc * a.y; Tt[4 * q + 2] *= sc * a.z; Tt[4 * q + 3] *= sc * a.w; }
            const ssd::bf16x8 x0 = (st == 0) ? xfa[0][0] : (st == 1) ? xfa[1][0] : xfa[2][0], x1 = (st == 0) ? xfa[0][1] : (st == 1) ? xfa[1][1] : xfa[2][1];
            SSD_APPLY(x0, x1);
        }
        {
            SSD_LOAD_S(lt)
            ssd::f32x16 Tt = {};
#pragma unroll
            for (int k = 0; k < 4; ++k) Tt = __builtin_amdgcn_mfma_f32_32x32x16_bf16(bf[k], cf[k], Tt, 0, 0, 0);
#pragma unroll
            for (int q = 0; q < 4; ++q) { const f32x4 as4 = *(const LAS f32x4*)(ACS + 32 * lt + 4 * hi + 8 * q), d4 = *(const LAS f32x4*)(DTV + 32 * lt + 4 * hi + 8 * q);
#pragma unroll
                for (int i = 0; i < 4; ++i) { const int r = 4 * q + i, sl = 4 * hi + 8 * q + i; const float f = (sl <= r32) ? __expf(al - as4[i]) * d4[i] : 0.f; Tt[r] = Tt[r] * f + ((sl == r32) ? Dk : 0.f); } }
            const ssd::bf16x8 x0 = (lt == 0) ? xfa[0][0] : (lt == 1) ? xfa[1][0] : (lt == 2) ? xfa[2][0] : xfa[3][0], x1 = (lt == 0) ? xfa[0][1] : (lt == 1) ? xfa[1][1] : (lt == 2) ? xfa[2][1] : xfa[3][1];
            SSD_APPLY(x0, x1);
        }
        { ssd::f32x16 Yo = {};
#pragma unroll
          for (int nt = 0; nt < 2; ++nt)
#pragma unroll
              for (int k2 = 0; k2 < 2; ++k2) { LAS unsigned char* cp = CL + (32 * lt + r32) * 144 + 64 * nt + 32 * k2 + 8 * hi;
                  const v2u lo = *(const LAS v2u*)cp, hi2 = *(const LAS v2u*)(cp + 16); v4u w; w.x = lo.x; w.y = lo.y; w.z = hi2.x; w.w = hi2.y;
                  Yo = __builtin_amdgcn_mfma_f32_32x32x16_bf16(__builtin_bit_cast(ssd::bf16x8, w), __builtin_bit_cast(ssd::bf16x8, hb[nt][k2]), Yo, 0, 0, 0); }
#pragma unroll
          for (int q = 0; q < 4; ++q) { const f32x4 e = *(const LAS f32x4*)(EC + 32 * lt + 4 * hi + 8 * q); Yt[4 * q] += e.x * Yo[4 * q]; Yt[4 * q + 1] += e.y * Yo[4 * q + 1]; Yt[4 * q + 2] += e.z * Yo[4 * q + 2]; Yt[4 * q + 3] += e.w * Yo[4 * q + 3]; } }
#pragma unroll
        for (int r = 0; r < 16; ++r) ST[ssd::crow(r, hi) * 36 + r32] = Yt[r];
        LDS_WAIT(); asm volatile("" ::: "memory");
        float yv[16];
#pragma unroll
        for (int q = 0; q < 4; ++q) { const f32x4 a = *(const LAS f32x4*)(ST + lr * 36 + c0 + 4 * q); yv[4 * q] = a.x; yv[4 * q + 1] = a.y; yv[4 * q + 2] = a.z; yv[4 * q + 3] = a.w; }
        const float zf[16] = {bflo(z0.x), bfhi(z0.x), bflo(z0.y), bfhi(z0.y), bflo(z0.z), bfhi(z0.z), bflo(z0.w), bfhi(z0.w), bflo(z1.x), bfhi(z1.x), bflo(z1.y), bfhi(z1.y), bflo(z1.z), bfhi(z1.z), bflo(z1.w), bfhi(z1.w)};
        float sq = 0.f;
#pragma unroll
        for (int j = 0; j < 16; ++j) { yv[j] = yv[j] * zf[j] * __builtin_amdgcn_rcpf(1.0f + __builtin_amdgcn_exp2f(-LOG2E * zf[j])); sq += yv[j] * yv[j]; }
        sq += __shfl_xor(sq, 1);
        if ((lane & 1) == 0) ssq[row * 16 + head * 2 + ph] = sq;
        v4u o0, o1; o0.x = pk2(yv[0], yv[1]); o0.y = pk2(yv[2], yv[3]); o0.z = pk2(yv[4], yv[5]); o0.w = pk2(yv[6], yv[7]); o1.x = pk2(yv[8], yv[9]); o1.y = pk2(yv[10], yv[11]); o1.z = pk2(yv[12], yv[13]); o1.w = pk2(yv[14], yv[15]);
        bf16* op = ymix + row * 1024 + head * 64 + ph * 32 + c0; *(v4u*)op = o0; *(v4u*)(op + 8) = o1;
        LDS_WAIT(); asm volatile("" ::: "memory");
    }
#undef SSD_LOAD_S
#undef SSD_APPLY
    __syncthreads();
}
__device__ __forceinline__ void phase_ssd_states(Frame& F, int l) {
    asm volatile("s_waitcnt vmcnt(0)" ::: "memory"); __syncthreads();
    ssd_states_item(F, l, 2 * F.blk); ssd_states_item(F, l, 2 * F.blk + 1); }
__device__ __forceinline__ void phase_ssd_output(Frame& F, int l) { for (int w = F.blk; w < 512; w += F.G) ssd_output_item(F, l, w); }
__device__ __forceinline__ void phase_mixer_naive(Frame& F, int l, const XcdBarrier& bar) {
    unsigned char* const W_ = wsp(F);
    const int gw = F.blk * NWAVES + F.wave;
#if SSD_NAIVE
    if ((gw & 1) == 0 && (gw >> 1) < 1024) ssd_naive_item(F, l, gw >> 1);
#else
    unsigned* sctr = F.ctl + CW_SCAN + 64 * l;
    phase_ssd_scan(F, sctr);
#endif
    const float* ksum = (const float*)(F.ctl + CW_KSUM) + (size_t)l * 65536;
#if ATTN_NAIVE
    unsigned* wq = F.ctl + CW_WQ + 64 * l;
    for (;;) { unsigned c = 0u; if (F.lane == 0) c = __hip_atomic_fetch_add(wq, 1u, RLX_AGENT); c = (unsigned)__builtin_amdgcn_readfirstlane((int)c);
        if (c >= 8192u) break;
        const int bh = (int)(c >> 7), s0 = (int)(c & 127u) * 32;
        for (int i = 0; i < 32; ++i) attn_naive_query(F, bh >> 3, bh & 7, s0 + i, ksum); }
#else
    __syncthreads();
    const attn_body::AttnTensors AT{(const attn_body::bf16*)(W_ + R1_Q), (const attn_body::bf16*)(W_ + R1_K), (const attn_body::bf16*)(W_ + R1_V), (attn_body::bf16*)(W_ + R1_YMIX), (const float*)(W_ + WS_UG), ksum};
    const attn_body::StaticOrder S(F.G, F.blk);
    if (F.blk & 1) { REPS(14) moe_convert_all(F, l); }
    REPS(3) attn_body::attn_phase<attn_body::StaticOrder>((char*)F.lds, AT, S);
    if (!(F.blk & 1)) { REPS(14) moe_convert_all(F, l); }
    ssd_scan_wait(F, sctr);
    phase_ssd_output(F, l);
#if ATTN_PROBE
    xcd_barrier(bar);
    { unsigned* wq = F.ctl + CW_WQ + 64 * l;
      for (;;) { unsigned c = 0u; if (F.lane == 0) c = __hip_atomic_fetch_add(wq, 1u, RLX_AGENT); c = (unsigned)__builtin_amdgcn_readfirstlane((int)c);
        if (c >= 8192u) break;
        const int bh = (int)(c >> 7), s0 = (int)(c & 127u) * 32;
        for (int i = 0; i < 32; ++i) attn_naive_query(F, bh >> 3, bh & 7, s0 + i, ksum); } }
#endif
#endif
}
__device__ __forceinline__ void phase_ssdnorm(Frame& F) {
    unsigned char* const W_ = wsp(F);
    const int gw = F.blk * NWAVES + F.wave, NGW = F.G * NWAVES; bf16* ymix = (bf16*)(W_ + R1_YMIX);
    for (int t = gw; t < T; t += NGW) { v4u* p = (v4u*)(ymix + (size_t)t * 1024) + F.lane; const v4u w = *p;
        float a[8] = {bflo(w.x), bfhi(w.x), bflo(w.y), bfhi(w.y), bflo(w.z), bfhi(w.z), bflo(w.w), bfhi(w.w)};
#if SSD_NAIVE
        float s = 0.f;
#pragma unroll
        for (int q = 0; q < 8; ++q) s += a[q] * a[q];
        s = wave_sum(s);
#else
        const f32x4* sp = (const f32x4*)((const float*)(W_ + SS_SSQ) + (size_t)t * 16); const f32x4 s0 = sp[0], s1 = sp[1], s2 = sp[2], s3 = sp[3];
        const float s = ((s0.x + s0.y) + (s0.z + s0.w)) + ((s1.x + s1.y) + (s1.z + s1.w)) + (((s2.x + s2.y) + (s2.z + s2.w)) + ((s3.x + s3.y) + (s3.z + s3.w)));
#endif
        const float rs = 1.0f / sqrtf(s * (1.0f / DI) + EPS);
        v4u o; o.x = pk2(a[0] * rs, a[1] * rs); o.y = pk2(a[2] * rs, a[3] * rs); o.z = pk2(a[4] * rs, a[5] * rs); o.w = pk2(a[6] * rs, a[7] * rs); *p = o; }
}
__device__ __forceinline__ void phase_router(Frame& F, int l, int cl) {
    unsigned char* const W_ = wsp(F);
    typedef short bf16x8 __attribute__((ext_vector_type(8)));
    LAS unsigned* lcnt = (LAS unsigned*)F.lds;
    if (F.tid < 32) lcnt[F.tid] = 0u;
    __syncthreads();
    const bf16* wrh = (const bf16*)(W_ + WS_WR) + (size_t)l * 64 * 1024; const bf16* wrl = wrh + DEPTH * 64 * 1024;
    const float* b1 = F.in[15] + l * 4; const float* b2 = F.in[17] + l * 32;
    unsigned* route = (unsigned*)(W_ + WS_ROUTE); float* rsb = (float*)(W_ + WS_RS);
    const int lane = F.lane, i16 = lane & 15, kq = lane >> 4;
    const int t = F.blk * 128 + F.wave * 16 + i16;
    const bf16* hrow = (const bf16*)(W_ + WS_HB) + (size_t)t * D + 8 * kq;
    constexpr int WROW = 528, WBUF = 2 * 48 * WROW;
    LAS unsigned char* wl0 = F.lds + 2048;
    v4u stg[6];
#define RT_LOAD(ch) do { _Pragma("unroll") for (int i_ = 0; i_ < 6; ++i_) { const int pc = F.tid + 512 * i_, part = pc / 1536, rr = (pc % 1536) >> 5, cc = pc & 31; \
        stg[i_] = *(const v4u*)((part ? wrl : wrh) + (size_t)rr * 1024 + (ch) * 256 + cc * 8); } } while (0)
#define RT_STORE(buf) do { _Pragma("unroll") for (int i_ = 0; i_ < 6; ++i_) { const int pc = F.tid + 512 * i_, part = pc / 1536, rr = (pc % 1536) >> 5, cc = pc & 31; \
        *(LAS v4u*)(wl0 + (buf) * WBUF + (part * 48 + rr) * WROW + cc * 16) = stg[i_]; } } while (0)
    f32x4 acc[3] = {{0.f, 0.f, 0.f, 0.f}, {0.f, 0.f, 0.f, 0.f}, {0.f, 0.f, 0.f, 0.f}}; float ss = 0.f;
    RT_LOAD(0); RT_STORE(0);
    __syncthreads();
#pragma unroll 1
    for (int ch = 0; ch < 4; ++ch) {
        v4u xw[8];
#pragma unroll
        for (int k8 = 0; k8 < 8; ++k8) xw[k8] = *(const v4u*)(hrow + ch * 256 + 32 * k8);
        if (ch < 3) RT_LOAD(ch + 1);
        const LAS unsigned char* wb = wl0 + (ch & 1) * WBUF + i16 * WROW + 16 * kq;
#pragma unroll
        for (int k8 = 0; k8 < 8; ++k8) {
            { const v4u x = xw[k8]; const float a0 = bflo(x.x), a1 = bfhi(x.x), a2 = bflo(x.y), a3 = bfhi(x.y), a4 = bflo(x.z), a5 = bfhi(x.z), a6 = bflo(x.w), a7 = bfhi(x.w); ss += ((a0 * a0 + a1 * a1) + (a2 * a2 + a3 * a3)) + ((a4 * a4 + a5 * a5) + (a6 * a6 + a7 * a7)); }
            const bf16x8 xhv = __builtin_bit_cast(bf16x8, xw[k8]);
#pragma unroll
            for (int nt = 0; nt < 3; ++nt) { const bf16x8 wh = *(const LAS bf16x8*)(wb + nt * 16 * WROW + 64 * k8), wl = *(const LAS bf16x8*)(wb + (48 + nt * 16) * WROW + 64 * k8);
                acc[nt] = __builtin_amdgcn_mfma_f32_16x16x32_bf16(wh, xhv, acc[nt], 0, 0, 0); acc[nt] = __builtin_amdgcn_mfma_f32_16x16x32_bf16(wl, xhv, acc[nt], 0, 0, 0); }
        }
        if (ch < 3) { RT_STORE((ch + 1) & 1); }
        __syncthreads();
    }
#undef RT_LOAD
#undef RT_STORE
    ss += __shfl_xor(ss, 16); ss += __shfl_xor(ss, 32);
    const float rs = 1.0f / sqrtf(ss * (1.0f / D) + EPS);
    float lg[36];
#pragma unroll
    for (int nt = 0; nt < 3; ++nt)
#pragma unroll
        for (int r = 0; r < 4; ++r) {
#pragma unroll
            for (int q = 0; q < 4; ++q) { const int c = 16 * nt + 4 * q + r; if (c < 36) { const float v = __shfl(acc[nt][r], i16 + 16 * q); lg[c] = v * rs + ((c < 4) ? b1[c & 3] : b2[(c - 4) & 31]); } } }
    const float m1 = fmaxf(fmaxf(lg[0], lg[1]), fmaxf(lg[2], lg[3]));
    const int gi = (lg[0] == m1) ? 0 : (lg[1] == m1) ? 1 : (lg[2] == m1) ? 2 : 3;
    const float se = (__expf(lg[0] - m1) + __expf(lg[1] - m1)) + (__expf(lg[2] - m1) + __expf(lg[3] - m1));
    const float gval = 1.0f / se;
    float f[8];
#pragma unroll
    for (int j = 0; j < 8; ++j) f[j] = (gi == 0) ? lg[4 + j] : (gi == 1) ? lg[12 + j] : (gi == 2) ? lg[20 + j] : lg[28 + j];
    int i0 = 0; float v0 = f[0];
#pragma unroll
    for (int j = 1; j < 8; ++j) if (f[j] > v0) { v0 = f[j]; i0 = j; }
    int i1 = 0; float v1 = -INFINITY;
#pragma unroll
    for (int j = 0; j < 8; ++j) if (j != i0 && f[j] > v1) { v1 = f[j]; i1 = j; }
    const float a1 = __expf(v1 - v0); const float g0 = gval / (1.0f + a1), g1 = gval * a1 / (1.0f + a1);
    if (kq == 0) { const unsigned e0 = (unsigned)(gi * 8 + i0), e1 = (unsigned)(gi * 8 + i1);
        const unsigned p0 = __hip_atomic_fetch_add(lcnt + e0, 1u, __ATOMIC_RELAXED, __HIP_MEMORY_SCOPE_WORKGROUP), p1 = __hip_atomic_fetch_add(lcnt + e1, 1u, __ATOMIC_RELAXED, __HIP_MEMORY_SCOPE_WORKGROUP);
        v4u r0; r0.x = e0; r0.y = e1; r0.z = p0; r0.w = p1; *(v4u*)(route + (size_t)t * 8) = r0;
        v2u r1; r1.x = __builtin_bit_cast(unsigned, g0); r1.y = __builtin_bit_cast(unsigned, g1); *(v2u*)(route + (size_t)t * 8 + 4) = r1;
        rsb[t] = rs; }
    __syncthreads();
    if (F.tid < 32) { const unsigned c = lcnt[F.tid]; const unsigned bb = __hip_atomic_fetch_add(F.ctl + CW_CNT + (cl * 32 + F.tid) * 64, c, RLX_AGENT);
        ((unsigned*)(W_ + WS_BBASE))[F.blk * 32 + F.tid] = bb; }
    __syncthreads();
}
__device__ __forceinline__ void phase_gather(Frame& F, int l) {
    unsigned char* const W_ = wsp(F);
    LAS unsigned* base = (LAS unsigned*)F.lds;
    unsigned* tile_e = (unsigned*)(W_ + WS_TILEE);
    if (F.tid < 32) base[96 + F.tid] = ald(F.ctl + CW_CNT + (l * 32 + F.tid) * 64);
    LDS_WAIT(); asm volatile("" ::: "memory");
    if (F.tid == 0) { unsigned acc = 0u; for (int e = 0; e < 32; ++e) { const unsigned c = base[96 + e]; base[e] = acc; acc += (c + 255u) & ~255u; } base[32] = acc >> 8; }
    __syncthreads();
    if (F.blk == 0 && F.tid < 32) { const unsigned c = base[96 + F.tid]; const unsigned nt = (c + 255u) >> 8, t0 = base[F.tid] >> 8;
        for (unsigned r = 0; r < nt; ++r) tile_e[t0 + r] = (unsigned)F.tid;
        if (F.tid == 0) tile_e[511] = base[32]; }
    unsigned* route = (unsigned*)(W_ + WS_ROUTE); const unsigned* bbase = (const unsigned*)(W_ + WS_BBASE) + F.blk * 32;
    if (F.tid >= 64 && F.tid < 96) base[64 + (F.tid - 64)] = base[F.tid - 64] + ald(bbase + (F.tid - 64));
    __syncthreads();
    bf16* xg = (bf16*)(W_ + R1_XG); const float* rsb = (const float*)(W_ + WS_RS); const bf16* hb = (const bf16*)(W_ + WS_HB); const float* g2 = F.in[13] + (size_t)l * D;
    f32x4 gv[4];
#pragma unroll
    for (int j = 0; j < 4; ++j) gv[j] = *((const f32x4*)g2 + F.lane + 64 * j);
    const int t0 = F.blk * 128 + F.wave * 16; const int tl = t0 + (F.lane & 15);
    const v4u rw = *(const v4u*)(route + (size_t)tl * 8);
    const unsigned sl0 = base[64 + rw.x] + rw.z, sl1 = base[64 + rw.y] + rw.w; const float rsl = rsb[tl];
    if (F.lane < 16) { v2u sw; sw.x = sl0; sw.y = sl1; *(v2u*)(route + (size_t)tl * 8 + 6) = sw; }
#pragma unroll 4
    for (int ti = 0; ti < 16; ++ti) { const int t = t0 + ti;
        const unsigned s0 = (unsigned)__shfl((int)sl0, ti), s1 = (unsigned)__shfl((int)sl1, ti); const float rs = __shfl(rsl, ti);
        const v2u* hr = (const v2u*)(hb + (size_t)t * D) + F.lane; v2u* d0 = (v2u*)(xg + (size_t)s0 * D) + F.lane; v2u* d1 = (v2u*)(xg + (size_t)s1 * D) + F.lane;
#pragma unroll
        for (int j = 0; j < 4; ++j) { const v2u hv = hr[64 * j]; v2u w; w.x = pk2(bflo(hv.x) * rs * gv[j].x, bfhi(hv.x) * rs * gv[j].y); w.y = pk2(bflo(hv.y) * rs * gv[j].z, bfhi(hv.y) * rs * gv[j].w); d0[64 * j] = w; d1[64 * j] = w; } }
    __syncthreads();
}
#ifndef MK_MULTI
#define MK_MULTI 0
#endif
constexpr int PPL = 12;
constexpr int NPHASE = 1 + PPL * DEPTH;
struct Args { const float* in[21]; float* out; unsigned char* ws; int ph_lo, ph_hi; };
static_assert(sizeof(Args) == 23 * 8 + 8, "Args has no padding");

#ifndef PH_MASK
#define PH_MASK 0xffffffffu
#endif
#define PHM(j) ((PH_MASK >> (j)) & 1u)
#define IN(k) (lo <= (k) && (k) < hi)
#ifndef BAR_TWICE
#define BAR_TWICE 0
#endif
#define SEAM(k) do { if (IN(k) && IN((k) + 1)) { xcd_barrier(bar); if (BAR_TWICE) xcd_barrier(bar); } } while (0)
constexpr int TLE_OFF = RING_BYTES + 12288;
constexpr int RS1_OFF = RING_BYTES + 8704;
constexpr int QKG_OFF = RING_BYTES + 8192;
constexpr int RS_OFF = RING_BYTES + 4096;
template <class Sched> __device__ __forceinline__ void ssd_row_scales(Frame& F, const Sched& S, const float* ssq) {
    LAS float* rl = (LAS float*)(F.lds + RS_OFF); pg8::Unit u;
    const int ui = F.tid >> 8, r = F.tid & 255;
    if (S.next(ui, u)) { const f32x4* sp = (const f32x4*)(ssq + (size_t)(u.pm * 256 + r) * 16); f32x4 s4 = sp[0]; s4 = s4 + sp[1]; s4 = s4 + sp[2]; s4 = s4 + sp[3];
        rl[ui * 256 + r] = 1.0f / sqrtf(((s4[0] + s4[1]) + (s4[2] + s4[3])) * (1.0f / 512.0f) + EPS); }
    __syncthreads();
}
__device__ __forceinline__ int moe_tile_table(Frame& F, const unsigned* tile_e) {
    LAS unsigned* tl = (LAS unsigned*)(F.lds + TLE_OFF);
    if (F.tid < 320) tl[F.tid] = ald(tile_e + F.tid);
    if (F.tid == 511) tl[511] = ald(tile_e + 511);
    __syncthreads();
    return __builtin_amdgcn_readfirstlane((int)tl[511]);
}
template <int l> __device__ __forceinline__ void layer_program(Frame& F, const XcdBarrier& bar, const int lo, const int hi) {
        const int pb = 1 + PPL * l; unsigned char* W_ = wsp(F);
#if (REP_MASK & 2u)
        if (PHM(1) && IN(pb + 0)) { {
            pg8::Gemm g{(const bf16*)(W_ + WS_HB), (const bf16*)(W_ + WS_WIN) + (size_t)l * NIN * 1024, T, NIN, D}; pg8::StaticOrder S; S.init(T, NIN, F.G, F.blk);
            if (F.tid < 128) ((LAS float*)(F.lds + QKG_OFF))[F.tid] = (F.tid < 64) ? F.in[10][l * 64 + F.tid] : F.in[11][l * 64 + F.tid - 64];
            { LAS float* rl = (LAS float*)(F.lds + RS1_OFF); const float* rs1 = (const float*)(W_ + WS_RS1);
              for (int i = F.tid; i < 6 * 256; i += NTHREADS) { pg8::Unit u; if (S.next(i >> 8, u)) rl[i] = rs1[u.pm * 256 + (i & 255)]; } }
            __syncthreads();
            pg8::EpiInProj E{(bf16*)(W_ + R1_Z), (bf16*)(W_ + R1_XBC), (bf16*)(W_ + R1_Q), (bf16*)(W_ + R1_K), (bf16*)(W_ + R1_V), (float*)(W_ + R1_DT),
                             (float*)(F.ctl + CW_KSUM) + (size_t)l * 65536, (const LAS float*)(F.lds + QKG_OFF), C2, EPS, (const LAS float*)(F.lds + RS1_OFF), 0};
            pg8::gemm_phase<pg8::EpiInProj, pg8::StaticOrder, true, true>(F.lds, g, S, E);
        }        }
#endif
        if (PHM(1) && IN(pb + 0)) { {
            pg8::Gemm g{(const bf16*)(W_ + WS_HB), (const bf16*)(W_ + WS_WIN) + (size_t)l * NIN * 1024, T, NIN, D}; pg8::StaticOrder S; S.init(T, NIN, F.G, F.blk);
            if (F.tid < 128) ((LAS float*)(F.lds + QKG_OFF))[F.tid] = (F.tid < 64) ? F.in[10][l * 64 + F.tid] : F.in[11][l * 64 + F.tid - 64];
            { LAS float* rl = (LAS float*)(F.lds + RS1_OFF); const float* rs1 = (const float*)(W_ + WS_RS1);
              for (int i = F.tid; i < 6 * 256; i += NTHREADS) { pg8::Unit u; if (S.next(i >> 8, u)) rl[i] = rs1[u.pm * 256 + (i & 255)]; } }
            __syncthreads();
            pg8::EpiInProj E{(bf16*)(W_ + R1_Z), (bf16*)(W_ + R1_XBC), (bf16*)(W_ + R1_Q), (bf16*)(W_ + R1_K), (bf16*)(W_ + R1_V), (float*)(W_ + R1_DT),
                             (float*)(F.ctl + CW_KSUM) + (size_t)l * 65536, (const LAS float*)(F.lds + QKG_OFF), C2, EPS, (const LAS float*)(F.lds + RS1_OFF), 0};
            pg8::gemm_phase<pg8::EpiInProj, pg8::StaticOrder, true, true>(F.lds, g, S, E);
        }        } SEAM(pb + 0);
#if SSD_NAIVE
        if (PHM(2) && IN(pb + 1)) { REPS(2) phase_conv(F, l); } SEAM(pb + 1);
        SEAM(pb + 2);
        if (PHM(3) && IN(pb + 3)) { phase_mixer_naive(F, l, bar); } SEAM(pb + 3);
        SEAM(pb + 4);
#else
        if (PHM(2) && IN(pb + 1)) { phase_ssd_prep(F, l); phase_ssd_states(F, l); } SEAM(pb + 1);
        if (PHM(3) && IN(pb + 3)) { phase_mixer_naive(F, l, bar); } SEAM(pb + 3);
#endif
#if SSD_NAIVE
        if (PHM(4) && IN(pb + 5)) { REPS(4) phase_ssdnorm(F); } SEAM(pb + 5);
#endif
#ifndef OUT_ALIGN
#define OUT_ALIGN true
#endif
#ifndef PROBE_MIDK
#define PROBE_MIDK 8
#endif
#ifndef PROBE_ALIGN
#define PROBE_ALIGN true
#endif
#if (REP_MASK & 0x2000u)
        if constexpr (l == 0) {
        if (PHM(5) && IN(pb + 6)) { {
            pg8::Gemm g{(const bf16*)(W_ + R1_YMIX), (const bf16*)(W_ + WS_WOUT) + (size_t)l * 1024 * 1024, T, D, D}; pg8::StaticOrder S; S.init(T, D, F.G, F.blk);
            ssd_row_scales(F, S, (const float*)(W_ + SS_SSQ));
            if constexpr (l == 0) { pg8::EpiResidT<false, PROBE_MIDK> E{F.in[0], (bf16*)(W_ + WS_HB), D, (const LAS float*)(F.lds + RS_OFF), EPS, 0}; pg8::gemm_phase<pg8::EpiResidT<false, PROBE_MIDK>, pg8::StaticOrder, PROBE_ALIGN, true>(F.lds, g, S, E); }
            else { pg8::EpiResidT<true> E{(const bf16*)(W_ + WS_HB), (bf16*)(W_ + WS_HB), D, (const LAS float*)(F.lds + RS_OFF), EPS, 0}; pg8::gemm_phase<pg8::EpiResidT<true>, pg8::StaticOrder, OUT_ALIGN, true>(F.lds, g, S, E); }
        }        }
        }
#endif
        if (PHM(5) && IN(pb + 6)) { {
            pg8::Gemm g{(const bf16*)(W_ + R1_YMIX), (const bf16*)(W_ + WS_WOUT) + (size_t)l * 1024 * 1024, T, D, D}; pg8::StaticOrder S; S.init(T, D, F.G, F.blk);
            ssd_row_scales(F, S, (const float*)(W_ + SS_SSQ));
            if constexpr (l == 0) { pg8::EpiResidT<false> E{F.in[0], (bf16*)(W_ + WS_HB), D, (const LAS float*)(F.lds + RS_OFF), EPS, 0}; pg8::gemm_phase<pg8::EpiResidT<false>, pg8::StaticOrder, OUT_ALIGN, true>(F.lds, g, S, E); }
            else { pg8::EpiResidT<true> E{(const bf16*)(W_ + WS_HB), (bf16*)(W_ + WS_HB), D, (const LAS float*)(F.lds + RS_OFF), EPS, 0}; pg8::gemm_phase<pg8::EpiResidT<true>, pg8::StaticOrder, OUT_ALIGN, true>(F.lds, g, S, E); }
        }        } SEAM(pb + 6);
        if (PHM(6) && IN(pb + 7)) {
#if (REP_MASK & 0x40u)
            phase_router(F, l, l + 2);
#endif
            phase_router(F, l, l); } SEAM(pb + 7);
        if (PHM(7) && IN(pb + 8)) { REPS(7) phase_gather(F, l); } SEAM(pb + 8);
        if (PHM(8) && IN(pb + 9)) { REPS(8) {
            const int nrt = moe_tile_table(F, (const unsigned*)(W_ + WS_TILEE));
            pg8::Gemm g{(const bf16*)(W_ + R1_XG), (const bf16*)(W_ + WS_WGU) + (size_t)l * 32 * 1024 * 1024, PMAX, 32 * 1024, D};
            pg8::MoeOrder S{(const LAS unsigned*)(F.lds + TLE_OFF), 4 * nrt, F.blk}; pg8::EpiSwiGLU E{(bf16*)(W_ + R1_HMID)};
            pg8::gemm_phase<pg8::EpiSwiGLU, pg8::MoeOrder, true, true>(F.lds, g, S, E);
        }        } SEAM(pb + 9);
        if (PHM(9) && IN(pb + 10)) { REPS(9) {
            const int nrt = moe_tile_table(F, (const unsigned*)(W_ + WS_TILEE));
            pg8::Gemm g{(const bf16*)(W_ + R1_HMID), (const bf16*)(W_ + WS_WD) + (size_t)l * 32 * 1024 * 512, PMAX, 32 * 1024, HID};
            pg8::MoeOrder S{(const LAS unsigned*)(F.lds + TLE_OFF), 4 * nrt, F.blk}; pg8::EpiDown E{(bf16*)(W_ + R1_XG)};
            pg8::gemm_phase<pg8::EpiDown, pg8::MoeOrder, true, true>(F.lds, g, S, E);
        }        } SEAM(pb + 10);
        if (PHM(10) && IN(pb + 11)) {
#if (REP_MASK & 0x400u)
            if constexpr (l == 0) phase_combine<true>(F, l + 1);
#endif
            phase_combine<false>(F, l + 1); } SEAM(pb + 11);
}
__global__ void __launch_bounds__(NTHREADS, 2) hymba_fwd(Args args) {
    extern __shared__ __attribute__((aligned(16))) unsigned char lds[];
    Frame F;
    F.lds = (LAS unsigned char*)lds; F.MISC = (volatile LAS unsigned*)(F.lds + MISC_OFF);
    F.tid = threadIdx.x; F.lane = F.tid & 63; F.wave = __builtin_amdgcn_readfirstlane(F.tid >> 6); F.G = gridDim.x; F.blk = blockIdx.x;
    F.ws = args.ws; F.ctl = (unsigned*)(args.ws + WS_CTL); F.out = args.out;
    F.in = (const float* const*)__builtin_amdgcn_kernarg_segment_ptr();
    for (int u = F.tid; u < (LDS_BYTES - RING_BYTES) / 4; u += NTHREADS) ((LAS unsigned*)(F.lds + RING_BYTES))[u] = 0u;
    __syncthreads();
    const int lo = args.ph_lo, hi = args.ph_hi;
    XcdBarrier bar; bar.bar = F.ctl + CW_BAR; bar.x = 0; bar.st = nullptr;
    if (hi - lo > 1) bar = xcd_barrier_post(F.ctl + CW_BAR, F.MISC + 8);

    if (PHM(0) && IN(0)) { REPS(0) phase_prologue(F); } SEAM(0);

    layer_program<0>(F, bar, lo, hi);
    layer_program<1>(F, bar, lo, hi);
#undef IN
#undef SEAM
}

extern "C" void kernel_launch(void* const* d_in, const int* in_sizes, int n_in, void* d_out, int out_size, void* d_ws, size_t ws_size, hipStream_t stream) {
    static int ready = 0;
    if (ready == 0) {
        if (n_in != 21 || out_size != T * D || ws_size < WS_END) { fprintf(stderr, "kernel_launch: unexpected shapes (n_in %d out %d ws %zu need %zu)\n", n_in, out_size, ws_size, (size_t)WS_END); ready = -1; return; }
        if (hipFuncSetAttribute((const void*)hymba_fwd, hipFuncAttributeMaxDynamicSharedMemorySize, LDS_BYTES) != hipSuccess) { fprintf(stderr, "kernel_launch: hipFuncSetAttribute failed\n"); ready = -1; return; }
        int per_cu = 0;
        if (hipOccupancyMaxActiveBlocksPerMultiprocessor(&per_cu, (const void*)hymba_fwd, NTHREADS, LDS_BYTES) != hipSuccess || per_cu < 1) fprintf(stderr, "kernel_launch: note: occupancy query says %d\n", per_cu);
        (void)hipGetLastError();
        ready = 1;
    }
    if (ready < 0) return;
    (void)hipMemsetAsync((char*)d_ws + WS_CTL, 0, CTL_ZERO_BYTES, stream);
    Args a{};
    for (int i = 0; i < 21; ++i) a.in[i] = (const float*)d_in[i];
    a.out = (float*)d_out; a.ws = (unsigned char*)d_ws;
#if MK_MULTI
    for (int p = 0; p < NPHASE; ++p) { a.ph_lo = p; a.ph_hi = p + 1; hipLaunchKernelGGL(hymba_fwd, dim3(GRID), dim3(NTHREADS), LDS_BYTES, stream, a); }
#else
    a.ph_lo = 0; a.ph_hi = NPHASE; hipLaunchKernelGGL(hymba_fwd, dim3(GRID), dim3(NTHREADS), LDS_BYTES, stream, a);
#endif
}
```

```cpp
#include <hip/hip_runtime.h>
#include <cstdio>
#include <cstdint>
#include <hip/hip_bf16.h>
#include <cmath>
namespace pg8 {
#define PG8_LAS __attribute__((address_space(3)))
typedef unsigned short bf16_t;
typedef short bf16x8 __attribute__((ext_vector_type(8)));
typedef float f32x4 __attribute__((ext_vector_type(4)));
typedef unsigned u32x4 __attribute__((ext_vector_type(4)));
constexpr int BM = 256, BK = 64, HALF = 128, HTB = HALF * BK * 2  , STAGE_BYTES = 8 * HTB, NXCD = 8, WGM = 8;

__host__ __device__ __forceinline__ int lds_byte(int r, int c) { const int st = (r >> 4) * 2 + (c >> 5), rr = r & 15, cc = c & 31, ob = rr * 64 + cc * 2; return st * 1024 + (ob ^ (((ob >> 9) & 1) << 5)); }
__host__ __device__ __forceinline__ void stage_rc(int b, int& R, int& C) { const int st = b / 1024, sb = b % 1024, swz = sb ^ (((sb >> 9) & 1) << 5); R = (st >> 1) * 16 + swz / 64; C = (st & 1) * 32 + (swz % 64) / 2; }
__host__ __device__ __forceinline__ int perm32(int rho) { const int n = rho >> 4, i = rho & 15; return 8 * (i >> 2) + 4 * n + (i & 3); }

struct Unit { int pm, pn; };
struct Gemm { const bf16_t* A; const bf16_t* Bt; int M, N, K; };

struct StaticOrder {
    int nM, nN, nwg, G, c;
    __host__ __device__ void init(int M, int N, int G_, int c_) { nM = M / BM; nN = N / BM; nwg = nM * nN; G = G_; c = c_; }
    __host__ __device__ bool next(int i, Unit& u) const {
        const long L = (long)i * G + c; if (L >= nwg) return false;
        int wgid = (int)L; { const int q = nwg / NXCD, r = nwg % NXCD, xcd = wgid % NXCD, off = wgid / NXCD; wgid = (xcd < r ? xcd * (q + 1) : r * (q + 1) + (xcd - r) * q) + off; }
        const int nig = WGM * nN, gid = wgid / nig, fm = gid * WGM, gsz = (nM - fm) < WGM ? (nM - fm) : WGM;
        u.pm = fm + ((wgid % nig) % gsz); u.pn = (wgid % nig) / gsz; return true;
    }
    static constexpr bool GATHER = false;
    __device__ __forceinline__ int row_of(const Unit&, int) const { return 0; }
    __device__ __forceinline__ void a_ready(const Unit&) const {}
    __device__ __forceinline__ void done(const Unit&) const {}
};

__device__ __forceinline__ unsigned cvt_pk_bf16(float lo, float hi) { unsigned r; asm volatile("v_cvt_pk_bf16_f32 %0, %1, %2" : "=v"(r) : "v"(lo), "v"(hi)); return r; }
typedef float f32x2 __attribute__((ext_vector_type(2)));
#ifndef EPI_SC1
#define EPI_SC1 0
#endif
__device__ __forceinline__ float silu_f(float x) { return x * __builtin_amdgcn_rcpf(1.0f + __builtin_amdgcn_exp2f(-1.4426950408889634f * x)); }

struct EpiInProj {
    static constexpr bool PERM = true, AFTER_DRAIN = false; static constexpr int MIDK = 0;
    bf16_t* z; bf16_t* xbc; bf16_t* q; bf16_t* k; bf16_t* v; float* dt; float* ksum;
    const PG8_LAS float* qkg; float qscale; float eps;
    const PG8_LAS float* rsl; mutable int ucount;
    __device__ __forceinline__ void operator()(const f32x4 (&acc)[2][2][4][2], const Unit& u, int wr, int wc, int fr, int fq) const {
        const int pn = u.pn; const int row0 = u.pm * BM + wr * 64 + fr;
        const PG8_LAS float* rp = rsl + ucount * 256 + wr * 64 + fr; ++ucount;
        if (pn <= 4 || pn == 9 || pn == 10) {
            bf16_t* base; int ldc, colt;
            if (pn <= 1) { base = z; ldc = 512; colt = pn * 256; } else if (pn <= 4) { base = xbc; ldc = 768; colt = (pn - 2) * 256; } else { base = v; ldc = 512; colt = (pn - 9) * 256; }
            const int col0 = colt + wc * 32 + 8 * fq;
#pragma unroll
            for (int ai = 0; ai < 2; ++ai)
#pragma unroll
                for (int m = 0; m < 4; ++m) { bf16_t* rowp = base + (size_t)(row0 + ai * HALF + m * 16) * ldc + col0; const float rv = rp[ai * HALF + m * 16];
#pragma unroll
                    for (int bj = 0; bj < 2; ++bj) { const f32x4 v0 = acc[ai][bj][m][0] * rv, v1 = acc[ai][bj][m][1] * rv;
                        u32x4 w; w.x = cvt_pk_bf16(v0[0], v0[1]); w.y = cvt_pk_bf16(v0[2], v0[3]); w.z = cvt_pk_bf16(v1[0], v1[1]); w.w = cvt_pk_bf16(v1[2], v1[3]);
                        *(u32x4*)(rowp + bj * HALF) = w; } }
        } else if (pn <= 8) {
            const bool isk = (pn >= 7); const int hh = 4 * ((pn - 5) & 1) + wc;
            const PG8_LAS float* g = qkg + (isk ? 64 : 0) + 8 * fq; bf16_t* base = isk ? k : q; const float sc = isk ? 1.0f : qscale;
            f32x4 cs[2][2];
#pragma unroll
            for (int bj = 0; bj < 2; ++bj)
#pragma unroll
                for (int n = 0; n < 2; ++n) cs[bj][n] = (f32x4){0.f, 0.f, 0.f, 0.f};
#pragma unroll
            for (int ai = 0; ai < 2; ++ai)
#pragma unroll
                for (int m = 0; m < 4; ++m) {
                    float ss = 0.f;
#pragma unroll
                    for (int bj = 0; bj < 2; ++bj)
#pragma unroll
                        for (int n = 0; n < 2; ++n) { const f32x4 x = acc[ai][bj][m][n]; ss += (x[0] * x[0] + x[1] * x[1]) + (x[2] * x[2] + x[3] * x[3]); }
                    ss += __shfl_xor(ss, 16); ss += __shfl_xor(ss, 32);
                    const float rv = rp[ai * HALF + m * 16]; const float rs = sc * rv / sqrtf(ss * rv * rv * (1.0f / 64.0f) + eps);
                    bf16_t* rowp = base + (size_t)(row0 + ai * HALF + m * 16) * 512 + hh * 64 + 8 * fq;
#pragma unroll
                    for (int bj = 0; bj < 2; ++bj) { const f32x4 g0 = *(const PG8_LAS f32x4*)(g + 32 * bj), g1 = *(const PG8_LAS f32x4*)(g + 32 * bj + 4);
                        const f32x4 v0 = acc[ai][bj][m][0] * rs * g0, v1 = acc[ai][bj][m][1] * rs * g1;
                        if (isk) { cs[bj][0] += v0; cs[bj][1] += v1; }
                        u32x4 w; w.x = cvt_pk_bf16(v0[0], v0[1]); w.y = cvt_pk_bf16(v0[2], v0[3]); w.z = cvt_pk_bf16(v1[0], v1[1]); w.w = cvt_pk_bf16(v1[2], v1[3]);
                        *(u32x4*)(rowp + bj * 32) = w; }
                    asm volatile("" : "+v"(cs[0][0]), "+v"(cs[0][1]), "+v"(cs[1][0]), "+v"(cs[1][1]) :: "memory");
                }
            if (isk) {
                float* kb = ksum + ((size_t)(u.pm >> 4) * 8 + hh) * 16 * 64 + (size_t)(u.pm & 15) * 64;
#pragma unroll
                for (int bj = 0; bj < 2; ++bj)
#pragma unroll
                    for (int n = 0; n < 2; ++n)
#pragma unroll
                        for (int j = 0; j < 4; ++j) { float s = cs[bj][n][j];
                            s += __shfl_xor(s, 1); s += __shfl_xor(s, 2); s += __shfl_xor(s, 4); s += __shfl_xor(s, 8);
                            if (fr == 0) atomicAdd(kb + 32 * bj + 8 * fq + 4 * n + j, s); }
            }
        } else {
            if (wc == 0 && fq == 0) {
#pragma unroll
                for (int ai = 0; ai < 2; ++ai)
#pragma unroll
                    for (int m = 0; m < 4; ++m) { float* rowp = dt + (size_t)(row0 + ai * HALF + m * 16) * 8; const float rv = rp[ai * HALF + m * 16];
                        *(f32x4*)(rowp) = acc[ai][0][m][0] * rv; *(f32x4*)(rowp + 4) = acc[ai][0][m][1] * rv; }
            }
        }
    }
};

template <bool RES_BF16, int MIDK_ = 8> struct EpiResidT {
    static constexpr bool PERM = true, AFTER_DRAIN = false; static constexpr int MIDK = MIDK_;
    const void* resid; bf16_t* out; int ldc; const PG8_LAS float* rsl; float eps;
    mutable int ucount;
    __device__ __forceinline__ void midk(f32x4 (&acc)[2][2][4][2], const Unit& u, int wr, int wc, int fr, int fq) const {
        const PG8_LAS float* rp = rsl + (ucount & 1) * 256 + wr * 64 + fr;
#pragma unroll
        for (int ai = 0; ai < 2; ++ai)
#pragma unroll
            for (int m = 0; m < 4; ++m) { const float rs = rp[ai * HALF + m * 16];
#pragma unroll
                for (int bj = 0; bj < 2; ++bj)
#pragma unroll
                    for (int n = 0; n < 2; ++n) acc[ai][bj][m][n] = acc[ai][bj][m][n] * rs; }
        ++ucount;
    }
    __device__ __forceinline__ void operator()(const f32x4 (&acc)[2][2][4][2], const Unit& u, int wr, int wc, int fr, int fq) const {
        const int row0 = u.pm * BM + wr * 64 + fr, col0 = u.pn * BM + wc * 32 + 8 * fq;
#pragma unroll
        for (int ai = 0; ai < 2; ++ai)
#pragma unroll
            for (int m = 0; m < 4; ++m) { const size_t off = (size_t)(row0 + ai * HALF + m * 16) * ldc + col0;
#pragma unroll
                for (int bj = 0; bj < 2; ++bj) { f32x4 r0, r1;
                    if constexpr (RES_BF16) { const u32x4 w = *(const u32x4*)((const bf16_t*)resid + off + bj * HALF);
                        r0[0] = __builtin_bit_cast(float, w.x << 16); r0[1] = __builtin_bit_cast(float, w.x & 0xffff0000u); r0[2] = __builtin_bit_cast(float, w.y << 16); r0[3] = __builtin_bit_cast(float, w.y & 0xffff0000u);
                        r1[0] = __builtin_bit_cast(float, w.z << 16); r1[1] = __builtin_bit_cast(float, w.z & 0xffff0000u); r1[2] = __builtin_bit_cast(float, w.w << 16); r1[3] = __builtin_bit_cast(float, w.w & 0xffff0000u); }
                    else { r0 = *(const f32x4*)((const float*)resid + off + bj * HALF); r1 = *(const f32x4*)((const float*)resid + off + bj * HALF + 4); }
                    const f32x4 v0 = acc[ai][bj][m][0] + r0, v1 = acc[ai][bj][m][1] + r1;
                    u32x4 o; o.x = cvt_pk_bf16(v0[0], v0[1]); o.y = cvt_pk_bf16(v0[2], v0[3]); o.z = cvt_pk_bf16(v1[0], v1[1]); o.w = cvt_pk_bf16(v1[2], v1[3]); *(u32x4*)(out + off + bj * HALF) = o; } }
    }
};

template <bool SC1> struct EpiSwiGLUT {
    static constexpr bool PERM = true, AFTER_DRAIN = false; static constexpr int MIDK = 0;
    bf16_t* hmid;
    __device__ __forceinline__ void operator()(const f32x4 (&acc)[2][2][4][2], const Unit& u, int wr, int wc, int fr, int fq) const {
        const int row0 = u.pm * BM + wr * 64 + fr, col0 = (u.pn & 3) * 128 + wc * 32 + 8 * fq;
#pragma unroll
        for (int ai = 0; ai < 2; ++ai)
#pragma unroll
            for (int m = 0; m < 4; ++m) { const size_t ro = (size_t)(row0 + ai * HALF + m * 16) * 512 + col0;
                const f32x4 g0 = acc[ai][0][m][0], g1 = acc[ai][0][m][1], u0 = acc[ai][1][m][0], u1 = acc[ai][1][m][1];
                float r[8];
#pragma unroll
                for (int j = 0; j < 4; ++j) { r[j] = silu_f(g0[j]) * u0[j]; r[4 + j] = silu_f(g1[j]) * u1[j]; }
                u32x4 w; w.x = cvt_pk_bf16(r[0], r[1]); w.y = cvt_pk_bf16(r[2], r[3]); w.z = cvt_pk_bf16(r[4], r[5]); w.w = cvt_pk_bf16(r[6], r[7]);
                if constexpr (SC1) __builtin_amdgcn_raw_buffer_store_b128(w, __builtin_amdgcn_make_buffer_rsrc((void*)hmid, 0, 0x7fffffff, 0x00020000), (int)(ro * 2), 0, 16);
                else *(u32x4*)(hmid + ro) = w; }
    }
};
typedef EpiSwiGLUT<false> EpiSwiGLU;

struct EpiDown {
    static constexpr bool PERM = true, AFTER_DRAIN = false; static constexpr int MIDK = 0;
    bf16_t* y;
    __device__ __forceinline__ void operator()(const f32x4 (&acc)[2][2][4][2], const Unit& u, int wr, int wc, int fr, int fq) const {
        const int row0 = u.pm * BM + wr * 64 + fr, col0 = (u.pn & 3) * BM + wc * 32 + 8 * fq;
#if EPI_SC1
        const __amdgpu_buffer_rsrc_t rs = __builtin_amdgcn_make_buffer_rsrc((void*)y, 0, 0x7fffffff, 0x00020000);
#endif
#pragma unroll
        for (int ai = 0; ai < 2; ++ai)
#pragma unroll
            for (int m = 0; m < 4; ++m) { const size_t ro = (size_t)(row0 + ai * HALF + m * 16) * 1024 + col0;
#pragma unroll
                for (int bj = 0; bj < 2; ++bj) { const f32x4 v0 = acc[ai][bj][m][0], v1 = acc[ai][bj][m][1];
                    u32x4 w; w.x = cvt_pk_bf16(v0[0], v0[1]); w.y = cvt_pk_bf16(v0[2], v0[3]); w.z = cvt_pk_bf16(v1[0], v1[1]); w.w = cvt_pk_bf16(v1[2], v1[3]);
#if EPI_SC1
                    __builtin_amdgcn_raw_buffer_store_b128(w, rs, (int)((ro + bj * HALF) * 2), 0, 16);
#else
                    *(u32x4*)(y + ro + bj * HALF) = w;
#endif
                } }
    }
};

struct MoeOrder {
    static constexpr bool GATHER = false;
    __device__ __forceinline__ int row_of(const Unit&, int) const { return 0; }
    const PG8_LAS unsigned* tile_e; int nunits, c;
    __device__ __forceinline__ bool next(int i, Unit& u) const {
        const int L = (i * 8 + (c & 7)) * 32 + (c >> 3); if (L >= nunits) return false;
        const int rt = L >> 2; const int e = __builtin_amdgcn_readfirstlane((int)tile_e[rt]);
        u.pm = rt; u.pn = e * 4 + (L & 3); return true;
    }
    __device__ __forceinline__ void a_ready(const Unit&) const {}
    __device__ __forceinline__ void done(const Unit&) const {}
};
struct MoeTailOrder {
    static constexpr bool GATHER = false;
    __device__ __forceinline__ int row_of(const Unit&, int) const { return 0; }
    const PG8_LAS unsigned* tile_e; int nunits, c;
    __device__ __forceinline__ bool next(int i, Unit& u) const {
        const int L = 1024 + (c & 7) * 32 + (c >> 3); if (i > 0 || L >= nunits) return false;
        const int rt = L >> 2; const int e = __builtin_amdgcn_readfirstlane((int)tile_e[rt]);
        u.pm = rt; u.pn = e * 4 + (L & 3); return true;
    }
    __device__ __forceinline__ void a_ready(const Unit&) const {}
    __device__ __forceinline__ void done(const Unit&) const {}
};
struct MoeDownOrder {
    static constexpr bool GATHER = false;
    __device__ __forceinline__ int row_of(const Unit&, int) const { return 0; }
    const PG8_LAS unsigned* tile_e; int nunits, c, nT; const unsigned* tailcnt; unsigned* tmo;
    __device__ __forceinline__ bool next(int i, Unit& u) const {
        const int x = c & 7; int chunk;
        if (x < nT) chunk = 2 * (8 - nT) + i * 8 + x;
        else chunk = (i < 2) ? i * (8 - nT) + (x - nT) : 2 * (8 - nT) + (i - 2) * 8 + x;
        const int L = chunk * 32 + (c >> 3); if (L >= nunits) return false;
        const int rt = L >> 2; const int e = __builtin_amdgcn_readfirstlane((int)tile_e[rt]);
        u.pm = rt; u.pn = e * 4 + (L & 3); return true;
    }
    __device__ __forceinline__ void a_ready(const Unit& u) const {
        if (u.pm >= 256) {
            if (threadIdx.x < 64) { const unsigned* w = tailcnt + (size_t)(u.pm - 256) * 64; unsigned sp = 0;
                while ((unsigned)__builtin_amdgcn_readfirstlane(__hip_atomic_load(w, __ATOMIC_RELAXED, __HIP_MEMORY_SCOPE_AGENT)) < 32u) {
                    __builtin_amdgcn_s_sleep(2); if (++sp > (1u << 22)) { if (threadIdx.x == 0) __hip_atomic_store(tmo, 0x7A11u, __ATOMIC_RELAXED, __HIP_MEMORY_SCOPE_AGENT); break; } }
                __builtin_amdgcn_fence(__ATOMIC_ACQUIRE, "agent");
                asm volatile("s_waitcnt vmcnt(0)" ::: "memory"); }
            asm volatile("" ::: "memory"); __builtin_amdgcn_s_barrier(); asm volatile("" ::: "memory");
        }
    }
    __device__ __forceinline__ void done(const Unit&) const {}
};
template <class Epi, class Sched, bool ALIGN_EPI = false, bool SP2 = false>
__device__ __forceinline__ void gemm_phase(PG8_LAS unsigned char* lds, const Gemm g, const Sched& S, const Epi& E) {
    const int tid = threadIdx.x, wid = __builtin_amdgcn_readfirstlane(tid >> 6), lane = tid & 63, wr = wid >> 2, wc = wid & 3, fr = lane & 15, fq = lane >> 4;
    const int K = g.K, nt = K / BK;
    unsigned voffA[2], voffB[2];
#pragma unroll
    for (int i = 0; i < 2; ++i) { int R, C; stage_rc(tid * 16 + i * 8192, R, C); const int Rb = Epi::PERM ? ((R & ~31) + perm32(R & 31)) : R;
        voffA[i] = (unsigned)(R * K + C) * 2u; voffB[i] = (unsigned)(Rb * K + C) * 2u; }
    constexpr bool GATH = Sched::GATHER;
    unsigned coff[2][2], noff[2][2];
#define PG8_GOFF(dst, unit) do { _Pragma("unroll") for (int _i = 0; _i < 2; ++_i) { int R_, C_; stage_rc(tid * 16 + _i * 8192, R_, C_); \
        _Pragma("unroll") for (int _h = 0; _h < 2; ++_h) dst[_h][_i] = (unsigned)(S.row_of(unit, _h * HALF + R_) * K + C_) * 2u; } } while (0)
    const size_t kstep = (size_t)(BK * 2);
    const size_t hstep = (size_t)HALF * K * 2;
    const size_t tstep = 2 * hstep;
    const unsigned ldsw = (unsigned)wid * 1024u;
    const int aoff = lds_byte(wr * 64 + fr, fq * 8), boff = lds_byte(wc * 32 + fr, fq * 8);
#define PG8_SA(b, h) (((b) * 2 + (h)) * HTB)
#define PG8_SB(b, h) ((4 + (b) * 2 + (h)) * HTB)
#define PG8_STAGE(bufoff, gbase, voff) do { _Pragma("unroll") for (int _i = 0; _i < 2; ++_i) \
        __builtin_amdgcn_global_load_lds((const unsigned*)((const char*)(gbase) + (voff)[_i]), (PG8_LAS unsigned*)(lds + (bufoff) + ldsw + _i * 8192), 16, 0, 0); } while (0)
#define PG8_STAGE_AC(b, h, base) do { if constexpr (GATH) { PG8_STAGE(PG8_SA(b, h), base, coff[h]); } else { PG8_STAGE(PG8_SA(b, h), (base) + (h) * hstep, voffA); } } while (0)
#define PG8_STAGE_AX(b, h, base) do { if constexpr (GATH) { const unsigned so_[2] = {last ? noff[h][0] : coff[h][0], last ? noff[h][1] : coff[h][1]}; PG8_STAGE(PG8_SA(b, h), base, so_); } else { PG8_STAGE(PG8_SA(b, h), (base) + (h) * hstep, voffA); } } while (0)
#define PG8_LDA(dst, b, h) do { _Pragma("unroll") for (int m = 0; m < 4; ++m) _Pragma("unroll") for (int k = 0; k < 2; ++k) dst[m][k] = *(const PG8_LAS bf16x8*)(lds + PG8_SA(b, h) + aoff + m * 2048 + k * 1024); } while (0)
#define PG8_LDB(dst, b, h) do { _Pragma("unroll") for (int n = 0; n < 2; ++n) _Pragma("unroll") for (int k = 0; k < 2; ++k) dst[n][k] = *(const PG8_LAS bf16x8*)(lds + PG8_SB(b, h) + boff + n * 2048 + k * 1024); } while (0)
#define PG8_MMA(ai, bj, At, Bt) do { __builtin_amdgcn_s_setprio(1); _Pragma("unroll") for (int m = 0; m < 4; ++m) _Pragma("unroll") for (int n = 0; n < 2; ++n) _Pragma("unroll") for (int k = 0; k < 2; ++k) \
        acc[ai][bj][m][n] = __builtin_amdgcn_mfma_f32_16x16x32_bf16(Bt[n][k], At[m][k], acc[ai][bj][m][n], 0, 0, 0); __builtin_amdgcn_s_setprio(0); } while (0)
#define PG8_WAIT_V(n) asm volatile("s_waitcnt vmcnt(" #n ")" ::: "memory")
#define PG8_WAIT_L(n) asm volatile("s_waitcnt lgkmcnt(" #n ")" ::: "memory")
#define PG8_BAR __builtin_amdgcn_s_barrier()
#define PG8_SCHED __builtin_amdgcn_sched_barrier(0)
    Unit cur, nxt; int ui = 0;
    if (!S.next(0, cur)) return;
    f32x4 acc[2][2][4][2];
#pragma unroll
    for (int a = 0; a < 2; ++a)
#pragma unroll
        for (int b = 0; b < 2; ++b)
#pragma unroll
            for (int m = 0; m < 4; ++m)
#pragma unroll
                for (int n = 0; n < 2; ++n) acc[a][b][m][n] = (f32x4){0.f, 0.f, 0.f, 0.f};
    bf16x8 At[4][2], B0[2][2], B1[2][2];
    const char* cA = (const char*)g.A + (GATH ? (size_t)0 : (size_t)cur.pm * tstep); const char* cB = (const char*)g.Bt + (size_t)cur.pn * tstep;
    if constexpr (GATH) { PG8_GOFF(coff, cur); _Pragma("unroll") for (int _h = 0; _h < 2; ++_h) { noff[_h][0] = coff[_h][0]; noff[_h][1] = coff[_h][1]; } }
    S.a_ready(cur);
    if constexpr (SP2) {
        PG8_STAGE(PG8_SB(0, 0), cB, voffB); PG8_STAGE(PG8_SB(0, 1), cB + hstep, voffB); PG8_STAGE_AC(0, 0, cA); PG8_STAGE_AC(0, 1, cA);
        if (wr == 1) PG8_BAR;
        PG8_WAIT_V(2); PG8_BAR;
        PG8_STAGE(PG8_SB(1, 0), cB + kstep, voffB); PG8_STAGE_AC(1, 0, cA + kstep); PG8_STAGE(PG8_SB(1, 1), cB + hstep + kstep, voffB);
        PG8_WAIT_V(6); PG8_BAR;
    } else {
        PG8_STAGE(PG8_SB(0, 0), cB, voffB); PG8_STAGE_AC(0, 0, cA); PG8_STAGE(PG8_SB(0, 1), cB + hstep, voffB); PG8_STAGE_AC(0, 1, cA);
        if (wr == 1) PG8_BAR;
        PG8_WAIT_V(4); PG8_BAR;
        PG8_STAGE(PG8_SB(1, 0), cB + kstep, voffB); PG8_STAGE_AC(1, 0, cA + kstep); PG8_STAGE(PG8_SB(1, 1), cB + hstep + kstep, voffB);
        PG8_WAIT_V(6); PG8_BAR;
    }
    for (;;) {
        const bool has_next = S.next(ui + 1, nxt);
        if constexpr (GATH) { if (has_next) PG8_GOFF(noff, nxt); }
        const char* nA = (has_next && !GATH) ? (const char*)g.A + (size_t)nxt.pm * tstep : cA; const char* nB = has_next ? (const char*)g.Bt + (size_t)nxt.pn * tstep : cB;
        for (int t = 0; t < nt; t += 2) {
            const bool last = (t == nt - 2);
            const char* a1 = cA + (size_t)(t + 1) * kstep;
            const char* a2 = last ? nA : cA + (size_t)(t + 2) * kstep; const char* b2 = last ? nB : cB + (size_t)(t + 2) * kstep;
            const char* a3 = a2 + kstep; const char* b3 = b2 + kstep;
            if (last && has_next) S.a_ready(nxt);
            if constexpr (SP2) {
            PG8_LDB(B0, 0, 0); PG8_LDB(B1, 0, 1); PG8_SCHED; PG8_LDA(At, 0, 0); PG8_STAGE_AC(1, 1, a1);
            PG8_WAIT_V(8); PG8_WAIT_L(0); PG8_BAR; PG8_MMA(0, 0, At, B0); PG8_MMA(0, 1, At, B1); PG8_BAR; PG8_SCHED;
            PG8_LDA(At, 0, 1); PG8_STAGE(PG8_SB(0, 0), b2, voffB); PG8_STAGE(PG8_SB(0, 1), b2 + hstep, voffB); PG8_STAGE_AX(0, 0, a2);
            PG8_WAIT_V(8); PG8_WAIT_L(0); PG8_BAR; PG8_MMA(1, 0, At, B0); PG8_MMA(1, 1, At, B1); PG8_BAR; PG8_SCHED;
            PG8_LDB(B0, 1, 0); PG8_LDB(B1, 1, 1); PG8_SCHED; PG8_LDA(At, 1, 0); PG8_STAGE_AX(0, 1, a2);
            PG8_WAIT_V(8); PG8_WAIT_L(0); PG8_BAR; PG8_MMA(0, 0, At, B0); PG8_MMA(0, 1, At, B1); PG8_BAR; PG8_SCHED;
            PG8_LDA(At, 1, 1); PG8_STAGE(PG8_SB(1, 0), b3, voffB); PG8_STAGE(PG8_SB(1, 1), b3 + hstep, voffB); PG8_STAGE_AX(1, 0, a3);
            PG8_WAIT_V(8); PG8_WAIT_L(0); PG8_BAR; PG8_MMA(1, 0, At, B0); PG8_MMA(1, 1, At, B1); PG8_BAR; PG8_SCHED;
            } else {
            PG8_LDB(B0, 0, 0); PG8_SCHED; PG8_LDA(At, 0, 0); PG8_STAGE_AC(1, 1, a1);
            PG8_WAIT_L(8); PG8_BAR; PG8_WAIT_L(0); PG8_MMA(0, 0, At, B0); PG8_BAR; PG8_SCHED;
            PG8_LDB(B1, 0, 1); PG8_STAGE(PG8_SB(0, 0), b2, voffB);
            PG8_BAR; PG8_WAIT_L(0); PG8_MMA(0, 1, At, B1); PG8_BAR;
            PG8_LDA(At, 0, 1); PG8_STAGE_AX(0, 0, a2);
            PG8_BAR; PG8_WAIT_L(0); PG8_MMA(1, 0, At, B0); PG8_BAR; PG8_SCHED;
            PG8_STAGE(PG8_SB(0, 1), b2 + hstep, voffB);
            PG8_WAIT_V(6); PG8_BAR; PG8_MMA(1, 1, At, B1); PG8_BAR;
            PG8_LDB(B0, 1, 0); PG8_SCHED; PG8_LDA(At, 1, 0); PG8_STAGE_AX(0, 1, a2);
            PG8_WAIT_L(8); PG8_BAR; PG8_WAIT_L(0); PG8_MMA(0, 0, At, B0); PG8_BAR; PG8_SCHED;
            PG8_LDB(B1, 1, 1); PG8_STAGE(PG8_SB(1, 0), b3, voffB);
            PG8_BAR; PG8_WAIT_L(0); PG8_MMA(0, 1, At, B1); PG8_BAR;
            PG8_LDA(At, 1, 1); PG8_STAGE_AX(1, 0, a3);
            PG8_BAR; PG8_WAIT_L(0); PG8_MMA(1, 0, At, B0); PG8_BAR; PG8_SCHED;
            PG8_STAGE(PG8_SB(1, 1), b3 + hstep, voffB);
            PG8_WAIT_V(6); PG8_BAR; PG8_MMA(1, 1, At, B1); PG8_BAR;
            }
            if constexpr (Epi::MIDK > 0) { if (t + 2 == Epi::MIDK) E.midk(acc, cur, wr, wc, fr, fq); }
        }
        if constexpr (ALIGN_EPI) { if (wr == 0) PG8_BAR; }
        if constexpr (!Epi::AFTER_DRAIN) { E(acc, cur, wr, wc, fr, fq); S.done(cur); }
        if (!has_next) break;
#pragma unroll
        for (int a = 0; a < 2; ++a)
#pragma unroll
            for (int b = 0; b < 2; ++b)
#pragma unroll
                for (int m = 0; m < 4; ++m)
#pragma unroll
                    for (int n = 0; n < 2; ++n) acc[a][b][m][n] = (f32x4){0.f, 0.f, 0.f, 0.f};
        cur = nxt; cA = nA; cB = nB; ++ui;
        if constexpr (GATH) { _Pragma("unroll") for (int _h = 0; _h < 2; ++_h) { coff[_h][0] = noff[_h][0]; coff[_h][1] = noff[_h][1]; } }
        if constexpr (ALIGN_EPI) { if (wr == 1) PG8_BAR; }
    }
    PG8_WAIT_V(0);
    if constexpr (!ALIGN_EPI) { if (wr == 0) PG8_BAR; }
    PG8_BAR;
    if constexpr (Epi::AFTER_DRAIN) { E.fused(acc, cur, wr, wc, fr, fq, lds, wid, lane); S.done(cur); }
#undef PG8_SA
#undef PG8_SB
#undef PG8_STAGE
#undef PG8_STAGE_AC
#undef PG8_STAGE_AX
#undef PG8_GOFF
#undef PG8_LDA
#undef PG8_LDB
#undef PG8_MMA
#undef PG8_WAIT_V
#undef PG8_WAIT_L
#undef PG8_BAR
#undef PG8_SCHED
}
}
constexpr int NWAVES = 8, NTHREADS = 512;
constexpr int NB = 8, SEQ = 4096, T = NB * SEQ, D = 1024, DEPTH = 2;
constexpr int NH = 8, HD = 64, DI = 512, CCH = 768, NIN = 3072, INCOLS = 2824;
constexpr int NE = 32, HID = 512, PMAX = 2 * T + NE * 256;
constexpr int MB = 256, NMB = SEQ / MB;
constexpr float EPS = 1e-6f, LOG2E = 1.4426950408889634f, C2 = 0.125f * LOG2E;
constexpr int GRID = 256;

constexpr size_t MiB = 1u << 20;
constexpr size_t WS_CTL = 0, CTL_ZERO_BYTES = 1 * MiB;
constexpr size_t WS_WIN = 1 * MiB;
constexpr size_t WS_WOUT = 13 * MiB;
constexpr size_t WS_WGU = 17 * MiB;
constexpr size_t WS_WD = 145 * MiB;
constexpr size_t WS_WR = 209 * MiB;
constexpr size_t WS_TB = WS_WR + 512 * 1024;
constexpr size_t WS_UG = WS_TB + 8192;
constexpr size_t WS_ROUTE = 210 * MiB;
constexpr size_t WS_GSLOT = 211 * MiB;
constexpr size_t WS_BBASE = WS_GSLOT + 512 * 1024;
constexpr size_t WS_TILEE = WS_BBASE + 64 * 1024;
constexpr size_t WS_RS1 = WS_TILEE + 4096 + 131072;
constexpr size_t WS_RS = WS_TILEE + 4096;
constexpr size_t WS_XN = 212 * MiB;
constexpr size_t WS_HB = WS_XN;
constexpr size_t SO_XN = 0;
constexpr size_t WS_R1 = 276 * MiB;
constexpr size_t R1_Z = WS_R1, R1_XBC = WS_R1 + 32 * MiB, R1_Q = WS_R1 + 80 * MiB, R1_K = WS_R1 + 112 * MiB, R1_V = WS_R1 + 144 * MiB, R1_YMIX = WS_R1 + 176 * MiB, R1_DT = WS_R1 + 240 * MiB;
constexpr size_t R1_XG = WS_R1, R1_HMID = WS_R1 + 144 * MiB;
constexpr size_t SS_XT = 0;
constexpr size_t SS_BT = 32 * MiB;
constexpr size_t SS_BC = 40 * MiB;
constexpr size_t SS_SSQ = WS_R1 + 242 * MiB;
constexpr size_t SS_DEC = WS_R1 + 244 * MiB;
constexpr size_t SS_S = 64 * MiB;
constexpr size_t WS_RSSLOT = WS_R1 + 241 * MiB;
constexpr size_t WS_END = WS_R1 + 245 * MiB;
static_assert((size_t)PMAX * 2048 <= 144 * MiB && (size_t)PMAX * 1024 <= 72 * MiB && R1_HMID + 72 * MiB <= WS_END, "R1 map");
constexpr int CW_BAR = 4096;
constexpr int CW_CNT = 8192;
constexpr int CW_KSUM = 65536;
static_assert((CW_KSUM + 2 * 65536) * 4 <= (int)CTL_ZERO_BYTES && CW_CNT + 64 * 64 <= CW_KSUM, "CTL map");

constexpr int RING_BYTES = 131072, MISC_OFF = RING_BYTES + 320, LDS_BYTES = 147456;

#define GAS __attribute__((address_space(1)))
#define LAS __attribute__((address_space(3)))
typedef unsigned short bf16;
typedef unsigned v4u __attribute__((ext_vector_type(4)));
typedef unsigned v2u __attribute__((ext_vector_type(2)));
typedef float f32x4 __attribute__((ext_vector_type(4)));
typedef GAS unsigned gu32;
#define RLX_AGENT __ATOMIC_RELAXED, __HIP_MEMORY_SCOPE_AGENT
#define LDS_WAIT() asm volatile("s_waitcnt lgkmcnt(0)" ::: "memory")
__device__ __forceinline__ unsigned f2bf(float f) { unsigned u = __builtin_bit_cast(unsigned, f); return (u + 0x7fffu + ((u >> 16) & 1u)) >> 16; }
__device__ __forceinline__ unsigned pk2(float lo, float hi) { return f2bf(lo) | (f2bf(hi) << 16); }
__device__ __forceinline__ float bflo(unsigned w) { return __builtin_bit_cast(float, w << 16); }
__device__ __forceinline__ float bfhi(unsigned w) { return __builtin_bit_cast(float, w & 0xffff0000u); }
__device__ __forceinline__ float bf1(bf16 b) { return __builtin_bit_cast(float, (unsigned)b << 16); }
__device__ __forceinline__ unsigned ald(const unsigned* p) { return __hip_atomic_load(p, __ATOMIC_RELAXED, __HIP_MEMORY_SCOPE_AGENT); }

#define XB_TMO      128
#define XB_XCNT(j)  (256  + 64 * (j))
#define XB_XSUB(j)  (1280 + 64 * (j))
#define XB_XGEN(j)  (2304 + 64 * (j))
#define XB_TOP      3328
#define XB_TOPGEN   3392
#define XCD_BAR_WORDS 3456
#define XB_SPIN_CAP (1u << 18)

__device__ __forceinline__ unsigned xb_ld(unsigned* p)              { return __hip_atomic_load(p, __ATOMIC_RELAXED, __HIP_MEMORY_SCOPE_AGENT); }
__device__ __forceinline__ unsigned xb_add(unsigned* p, unsigned v) { return __hip_atomic_fetch_add(p, v, __ATOMIC_RELAXED, __HIP_MEMORY_SCOPE_AGENT); }
__device__ __forceinline__ unsigned xb_xcc_id() { return (unsigned)__builtin_amdgcn_s_getreg((3 << 11) | 20) & 0xFu; }
#define XB_SPIN(cond, bar) do { unsigned _sp = 0; while (cond) { __builtin_amdgcn_s_sleep(1); \
    if ((++_sp & 255u) == 0u) { if (xb_ld(&(bar)[XB_TMO])) break; if (_sp > XB_SPIN_CAP) { atomicAdd(&(bar)[XB_TMO], 1u); break; } } } } while (0)

struct XcdBarrier {
    unsigned* bar; unsigned x;
    volatile LAS unsigned* st;
};

__device__ __forceinline__ XcdBarrier xcd_barrier_post(unsigned* bar, volatile LAS unsigned* st) {
    XcdBarrier b; b.bar = bar; b.x = xb_xcc_id(); b.st = st;
    if (threadIdx.x == 0) (void)xb_add(&bar[XB_XCNT(b.x)], 1u);
    return b;
}
__device__ __forceinline__ void xcd_barrier_complete(unsigned* bar, unsigned x, unsigned& nloc, unsigned& nx) {
    const unsigned G = gridDim.x * gridDim.y * gridDim.z;
    unsigned sum, cnt, mine, sp = 0u;
    for (;;) {
        sum = 0u; cnt = 0u; mine = 0u;
#pragma unroll
        for (unsigned j = 0; j < 16; ++j) { const unsigned c = xb_ld(&bar[XB_XCNT(j)]); sum += c; cnt += (c > 0u) ? 1u : 0u; mine = (j == x) ? c : mine; }
        if (sum == G) break;
        __builtin_amdgcn_s_sleep(1);
        if ((++sp & 255u) == 0u) { if (xb_ld(&bar[XB_TMO])) break; if (sp > XB_SPIN_CAP) { atomicAdd(&bar[XB_TMO], 1u); break; } }
    }
    nloc = mine > 0u ? mine : 1u; nx = cnt > 0u ? cnt : 1u;
}

__device__ __forceinline__ void xcd_barrier(const XcdBarrier& b) {
    asm volatile("s_waitcnt vmcnt(0)" ::: "memory");
    __syncthreads();
    if (threadIdx.x == 0) {
        unsigned* bar = b.bar;
        __builtin_amdgcn_s_waitcnt(0);
        unsigned nloc = b.st[0], nx = b.st[1];
        if (nloc == 0u) { xcd_barrier_complete(bar, b.x, nloc, nx); b.st[0] = nloc; b.st[1] = nx; }
        const unsigned old = xb_add(&bar[XB_XSUB(b.x)], 1u);
        const unsigned gen = old / nloc;
        if (old + 1u == (gen + 1u) * nloc) {
            __builtin_amdgcn_fence(__ATOMIC_RELEASE, "agent");
            asm volatile("s_waitcnt vmcnt(0)" ::: "memory");
            const unsigned og = xb_add(&bar[XB_TOP], 1u);
            const unsigned tg = og / nx;
            if (og + 1u == (tg + 1u) * nx) xb_add(&bar[XB_TOPGEN], 1u);
            else XB_SPIN(xb_ld(&bar[XB_TOPGEN]) == tg, bar);
            __builtin_amdgcn_fence(__ATOMIC_ACQUIRE, "agent");
            xb_add(&bar[XB_XGEN(b.x)], 1u);
            asm volatile("s_waitcnt vmcnt(0)" ::: "memory");
        } else {
            XB_SPIN(xb_ld(&bar[XB_XGEN(b.x)]) == gen, bar);
            __builtin_amdgcn_fence(__ATOMIC_ACQUIRE, "agent");
            asm volatile("s_waitcnt vmcnt(0)" ::: "memory");
        }
    }
    __syncthreads();
}
namespace attn_body {
using bf16=__hip_bfloat16;
using bf16x8=__attribute__((ext_vector_type(8)))short;
using s16x4=__attribute__((ext_vector_type(4)))short;
using f32x16=__attribute__((ext_vector_type(16)))float;
using u32x4=__attribute__((ext_vector_type(4)))unsigned;
constexpr int BATCH=8,NHEAD=8,SEQ=4096,D=64,DM=NHEAD*D,OPITCH=1024,OCOL0=512;
constexpr int NW=8,QBLK=32,QB=QBLK*NW,KVBLK=64,NQB=SEQ/QB;
constexpr float MBIG=256.f;
constexpr int ATTN_PITCH=DM, ATTN_UNIT_ROWS=QB;
__device__ __forceinline__ int crow(int r,int hi){return (r&3)+8*(r>>2)+4*hi;}
#define SBAR() __builtin_amdgcn_sched_barrier(0)
typedef __attribute__((address_space(3))) const float* lds_fptr;
__device__ __forceinline__ void biasadd(f32x16&p0,f32x16&p1,lds_fptr ub){
  #pragma unroll
  for(int r=0;r<16;++r){const int o=(r&3)+8*(r>>2); p0[r]+=ub[o]; p1[r]+=ub[o+32];}
}

constexpr int NSLOT=3, SLOTB=8192;
constexpr int LDS_K=0, LDS_V=NSLOT*SLOTB, LDS_WS=2*NSLOT*SLOTB, LDS_OST=LDS_WS+NW*64*4, LDS_U=LDS_OST+NW*4096, LDS_KS=LDS_U+768*4, LDS_SM=LDS_KS+16*64*4, LDS_BYTES=LDS_SM+NW*64*4;
constexpr float C2=0.125f*1.4426950408889634f;
__device__ __forceinline__ void glds16(const void*gsrc,unsigned lds_dst){unsigned keep;
  asm volatile("s_mov_b32 %0, m0\n\ts_mov_b32 m0, %2\n\ts_nop 0\n\tglobal_load_lds_dwordx4 %1, off\n\ts_mov_b32 m0, %0":"=&s"(keep):"v"(gsrc),"s"(lds_dst):"memory");}
__device__ __forceinline__ float max3f(float a,float b,float c){float r;asm("v_max3_f32 %0, %1, %2, %3":"=v"(r):"v"(a),"v"(b),"v"(c));return r;}
__device__ __forceinline__ float max2f(float a,float b){float r;asm("v_max_f32_e32 %0, %1, %2":"=v"(r):"v"(a),"v"(b));return r;}
__device__ __forceinline__ float fadd_s(float a,float b){float r;asm("v_add_f32_e32 %0, %1, %2":"=v"(r):"v"(a),"v"(b));return r;}
__device__ __forceinline__ float fsub_s(float a,float b){float r;asm("v_sub_f32_e32 %0, %1, %2":"=v"(r):"v"(a),"v"(b));return r;}
typedef float f32x2_t __attribute__((ext_vector_type(2))); typedef __bf16 bf16x2_t __attribute__((ext_vector_type(2)));
__device__ __forceinline__ unsigned cvtpk_s(float lo,float hi){f32x2_t v={lo,hi};bf16x2_t b=__builtin_convertvector(v,bf16x2_t);return __builtin_bit_cast(unsigned,b);}
#define WAIT_BAR(N) asm volatile("s_waitcnt vmcnt(" #N ") lgkmcnt(0)\n\ts_barrier":::"memory")

__device__ __forceinline__ void qkt(f32x16&p0,f32x16&p1,const char*Kslot,const bf16x8*qr,const f32x16&negm,int r32,int hi){
  const char*kb=Kslot+hi*1024+r32*16;
  #pragma unroll
  for(int d0=0;d0<4;++d0){
    const bf16x8 b0=*reinterpret_cast<const bf16x8*>(kb+d0*2048);
    const bf16x8 b1=*reinterpret_cast<const bf16x8*>(kb+d0*2048+512);
    if(d0==0){p0=__builtin_amdgcn_mfma_f32_32x32x16_bf16(b0,qr[0],negm,0,0,0);p1=__builtin_amdgcn_mfma_f32_32x32x16_bf16(b1,qr[0],negm,0,0,0);}
    else{p0=__builtin_amdgcn_mfma_f32_32x32x16_bf16(b0,qr[d0],p0,0,0,0);p1=__builtin_amdgcn_mfma_f32_32x32x16_bf16(b1,qr[d0],p1,0,0,0);}}
}
typedef __attribute__((address_space(3))) const char* lds_cptr;
typedef short v4i16_t __attribute__((ext_vector_type(4)));
__device__ __forceinline__ void kload8(bf16x8*kf,lds_cptr kp){
  kf[0]=*(const __attribute__((address_space(3))) bf16x8*)(kp);      kf[1]=*(const __attribute__((address_space(3))) bf16x8*)(kp+512);
  kf[2]=*(const __attribute__((address_space(3))) bf16x8*)(kp+2048); kf[3]=*(const __attribute__((address_space(3))) bf16x8*)(kp+2560);
  kf[4]=*(const __attribute__((address_space(3))) bf16x8*)(kp+4096); kf[5]=*(const __attribute__((address_space(3))) bf16x8*)(kp+4608);
  kf[6]=*(const __attribute__((address_space(3))) bf16x8*)(kp+6144); kf[7]=*(const __attribute__((address_space(3))) bf16x8*)(kp+6656);
}
__device__ __forceinline__ void kload2(bf16x8*kf,lds_cptr kp,int j){ kf[2*j]=*(const __attribute__((address_space(3))) bf16x8*)(kp+j*2048); kf[2*j+1]=*(const __attribute__((address_space(3))) bf16x8*)(kp+j*2048+512); }
__device__ __forceinline__ s16x4 vtr(lds_cptr p){ return __builtin_bit_cast(s16x4,__builtin_amdgcn_ds_read_tr16_b64_v4i16((__attribute__((address_space(3))) v4i16_t*)p)); }
__device__ __forceinline__ float rowmax(const f32x16&p0,const f32x16&p1){
  float a=max3f(p0[0],p0[1],p1[0]),b=max3f(p0[2],p0[3],p1[1]);a=max3f(a,p1[2],p1[3]);
  #pragma unroll
  for(int r=4;r<16;r+=4){a=max3f(a,p0[r],p0[r+1]);b=max3f(b,p0[r+2],p0[r+3]);a=max3f(a,p1[r],p1[r+1]);b=max3f(b,p1[r+2],p1[r+3]);}
  const float m=max2f(a,b);
  auto rr=__builtin_amdgcn_permlane32_swap(__float_as_uint(m),__float_as_uint(m),false,false);
  return max2f(__uint_as_float(rr[0]),__uint_as_float(rr[1]));
}
__device__ __forceinline__ void pv(f32x16*o,int vb,bf16x8 pa0,bf16x8 pa1,bf16x8 pa2,bf16x8 pa3){
  #pragma unroll
  for(int d0=0;d0<2;++d0){s16x4 lo[4],hi[4];
    #pragma unroll
    for(int ks=0;ks<4;++ks){
      asm volatile("ds_read_b64_tr_b16 %0,%1 offset:%c2":"=&v"(lo[ks]):"v"(vb),"i"(d0*4096+ks*1024):"memory");
      asm volatile("ds_read_b64_tr_b16 %0,%1 offset:%c2":"=&v"(hi[ks]):"v"(vb),"i"(d0*4096+ks*1024+512):"memory");}
    asm volatile("s_waitcnt lgkmcnt(0)":::"memory");SBAR();
    #define PK(k) (bf16x8){lo[k][0],lo[k][1],lo[k][2],lo[k][3],hi[k][0],hi[k][1],hi[k][2],hi[k][3]}
    o[d0]=__builtin_amdgcn_mfma_f32_32x32x16_bf16(pa0,PK(0),o[d0],0,0,0);
    o[d0]=__builtin_amdgcn_mfma_f32_32x32x16_bf16(pa1,PK(1),o[d0],0,0,0);
    o[d0]=__builtin_amdgcn_mfma_f32_32x32x16_bf16(pa2,PK(2),o[d0],0,0,0);
    o[d0]=__builtin_amdgcn_mfma_f32_32x32x16_bf16(pa3,PK(3),o[d0],0,0,0);
    #undef PK
  }
}

#ifndef ATTN_STORE16
#define ATTN_STORE16(p,v) (*(u32x4*)(p)=(v))
#endif
template<int THRL> __device__ __forceinline__ void attn_unit(int b,int h,int qb,const bf16*Q,const bf16*K,const bf16*V,bf16*O,const float*UG,const float*KSUM,char*shm){
  const int tid=threadIdx.x,lane=tid&63,r32=lane&31,hi=lane>>5; const int wid=__builtin_amdgcn_readfirstlane(tid>>6);
  const long rowbase=(long)b*SEQ; const int q0=qb*QB;
  const bf16*Qw=Q+(rowbase+q0+wid*QBLK)*DM+h*D;
  const bf16*Kh=K+rowbase*DM+h*D,*Vh=V+rowbase*DM+h*D;
  const unsigned lds0=(unsigned)(uintptr_t)shm;
  float*wsf=(float*)(shm+LDS_WS)+wid*64;
  const bf16*ksrc=Kh+(long)lane*DM+wid*8;
  const bf16*vsrc=Vh+(long)(16*(wid&3)+(lane>>2))*DM+(wid>>2)*32+(lane&3)*8;
  const unsigned kdst=lds0+LDS_K+wid*1024, vdst=lds0+LDS_V+wid*1024;
  #define DMA_K(t,slot) glds16(ksrc+(long)(t)*KVBLK*DM,(unsigned)__builtin_amdgcn_readfirstlane(kdst+(slot)))
  #define DMA_V(t,slot) glds16(vsrc+(long)(t)*KVBLK*DM,(unsigned)__builtin_amdgcn_readfirstlane(vdst+(slot)))
  const int vb0=(int)(lds0+LDS_V)+((lane>>4)&1)*32+(lane&3)*8+(4*hi+((lane&15)>>2))*64;
  const char*Kbase=shm+LDS_K; bf16x8 kf[8];
  const lds_cptr shm3=(lds_cptr)shm; const lds_cptr kp0=shm3+LDS_K+hi*1024+r32*16; const lds_cptr vp0=shm3+LDS_V+((lane>>4)&1)*32+(lane&3)*8+(4*hi+((lane&15)>>2))*64;
  const int NT=(q0+QB)/KVBLK;
  const float*ugp=UG+(long)h*768; const float*ksp=KSUM+((long)b*NHEAD+h)*1024;
  const float tu0=ugp[tid], tu1=(tid<256)?ugp[512+tid]:0.f, tk0=ksp[tid], tk1=ksp[512+tid];
  DMA_K(0,0);DMA_V(0,0);DMA_K(1,SLOTB);
  bf16x8 qr[4];
  #pragma unroll
  for(int d0=0;d0<4;++d0)qr[d0]=*reinterpret_cast<const bf16x8*>(&Qw[(long)r32*DM+d0*16+hi*8]);
  float mhat=0.f,l_reg=0.f;f32x16 o[2];o[0]=f32x16{};o[1]=f32x16{};f32x16 negm=f32x16{};
  const int qrel=wid*QBLK+r32;
  { float*Ul=(float*)(shm+LDS_U),*KSl=(float*)(shm+LDS_KS); Ul[tid]=tu0; if(tid<256)Ul[512+tid]=tu1; KSl[tid]=tk0; KSl[512+tid]=tk1; }
  typedef __attribute__((address_space(3))) unsigned* lds_uptr;
  #define LANEID() ((int)__builtin_amdgcn_mbcnt_hi(~0u,__builtin_amdgcn_mbcnt_lo(~0u,0u)))
  #define SMP() ((lds_uptr)((lds_cptr)shm+LDS_SM+wid*256)+LANEID())
  #define CMASK(P0,P1,t) do{int jb_=(t)-(NT-8); if(jb_>=0){ const int l_=LANEID(); biasadd(P0,P1,(lds_fptr)((lds_cptr)shm+LDS_U)+(4*(l_>>5)-(wid*QBLK+(l_&31))+255+64*jb_)); } }while(0)
  #define SETBLK(n_) do{ const int n__=(n_); float cb_=((*SMP()>>n__)&1u)?0.f:-MBIG; if(n__<qb-1)cb_+=*(lds_fptr)((lds_cptr)shm+LDS_U); cb_-=mhat; _Pragma("unroll") for(int r=0;r<16;++r)negm[r]=cb_; asm volatile("":"+v"(negm)); }while(0)
  bool resc=false;
  #define START(P0,P1) do{ const float rm=rowmax(P0,P1); resc=false; \
    { const float dl=rm; mhat=fadd_s(mhat,dl); \
      _Pragma("unroll") for(int r=0;r<16;++r){P0[r]=fsub_s(P0[r],dl);P1[r]=fsub_s(P1[r],dl);} \
      _Pragma("unroll") for(int r=0;r<16;++r)negm[r]-=dl; asm volatile("":"+v"(negm)); } \
    _Pragma("unroll") for(int r=0;r<16;++r)P0[r]=__builtin_amdgcn_exp2f(P0[r]); }while(0)
  #define RESC() do{ if(resc){ asm volatile("s_waitcnt lgkmcnt(0)":::"memory"); \
      _Pragma("unroll") for(int d_=0;d_<2;++d_) _Pragma("unroll") for(int r=0;r<16;++r)o[d_][r]*=wsf[crow(r,hi)]; } }while(0)
  f32x16 pA0,pA1,pB0,pB1;
  int sl_prev=0,sl_cur=0,sl_next=SLOTB;
  #define ROT() do{sl_prev=sl_cur;sl_cur=sl_next;sl_next=(sl_next==(NSLOT-1)*SLOTB)?0:sl_next+SLOTB;}while(0)
  DMA_K(2,2*SLOTB);
  WAIT_BAR(3);
  { unsigned selmask; if(qb<=3) selmask=(1u<<qb)-1u; else {
      float qv[32];
      _Pragma("unroll") for(int d0=0;d0<4;++d0) _Pragma("unroll") for(int j=0;j<8;++j) qv[8*d0+j]=__uint_as_float(((unsigned)(unsigned short)qr[d0][j])<<16);
      float v1=-INFINITY,v2=-INFINITY,v3=-INFINITY; int i1=0,i2=0,i3=0;
      const lds_fptr ksl=(lds_fptr)((lds_cptr)shm+LDS_KS)+8*hi;
      for(int n=0;n<qb;++n){ float a=0.f;
        _Pragma("unroll") for(int d0=0;d0<4;++d0) _Pragma("unroll") for(int j=0;j<8;++j) a+=qv[8*d0+j]*ksl[n*64+16*d0+j];
        { auto rr=__builtin_amdgcn_permlane32_swap(__float_as_uint(a),__float_as_uint(a),false,false); a=__uint_as_float(rr[0])+__uint_as_float(rr[1]); }
        if(a>v1){v3=v2;i3=i2;v2=v1;i2=i1;v1=a;i1=n;} else if(a>v2){v3=v2;i3=i2;v2=a;i2=n;} else if(a>v3){v3=a;i3=n;} }
      selmask=(1u<<i1)|(1u<<i2)|(1u<<i3); }
    selmask|=1u<<qb; *SMP()=selmask; }
  SETBLK(0);
  qkt(pA0,pA1,Kbase,qr,negm,r32,hi);asm volatile("s_nop 15\n\ts_nop 7":"+v"(pA0),"+v"(pA1));CMASK(pA0,pA1,0);
  START(pA0,pA1);
  _Pragma("unroll") for(int r=0;r<16;++r)pA1[r]=__builtin_amdgcn_exp2f(pA1[r]);
  WAIT_BAR(0);
  DMA_K(3,0);DMA_V(1,SLOTB);
  ROT();
  kload8(kf,kp0+sl_cur);
  WAIT_BAR(2);
  s16x4 vlo[8],vhi[8]; u32x4 pw0,pw1,pw2,pw3;
  #define PKW(P,B) cvtpk_s(P[B],P[B+1])
  #define PAF(k) __builtin_bit_cast(bf16x8,pw##k)
  #define VFR(i) (bf16x8){vlo[i][0],vlo[i][1],vlo[i][2],vlo[i][3],vhi[i][0],vhi[i][1],vhi[i][2],vhi[i][3]}
  #define PIN(x) asm volatile("":"+v"(x))
  #define MX3(a,b,c) __builtin_fmaxf(__builtin_fmaxf((a),(b)),(c))
  #define GAPA(MF,A0,A1,A2,A3,W0,W1,PW) do{ MF; sacc+=A0; sacc+=A1; sacc+=A2; sacc+=A3; PIN(sacc); W0; W1; PIN(PW); SBAR(); }while(0)
  #define EX(v) __builtin_amdgcn_exp2f(v)
  #define GAPB(MF,X,B) do{ MF; X[B]=EX(X[B]); X[B+1]=EX(X[B+1]); X[B+2]=EX(X[B+2]); X[B+3]=EX(X[B+3]); PIN(X); SBAR(); }while(0)
  #define VRD(i) do{ vlo[i]=vtr(vp_+(((i)>>2)*4096+((i)&3)*1024)); vhi[i]=vtr(vp_+(((i)>>2)*4096+((i)&3)*1024+512)); }while(0)
  #define KRD(G,j) do{ if(G){ kload2(kf,kp0+sl_next,j); SBAR(); } }while(0)
  #define STEP(C0,C1,P0,P1,t,GK,GV,GL) do{ if((((t))&3)==0){SETBLK((t)>>2);} SBAR(); \
    const lds_cptr vp_=vp0+sl_prev; \
    VRD(0); SBAR(); float sacc=(P0[0]+P0[1]); \
    GAPA(C0=__builtin_amdgcn_mfma_f32_32x32x16_bf16(kf[0],qr[0],negm,0,0,0), P0[2],P0[3],P0[4],P0[5],     pw0[0]=PKW(P0,0), pw0[1]=PKW(P0,2), pw0); \
    VRD(4); SBAR(); GAPA(C1=__builtin_amdgcn_mfma_f32_32x32x16_bf16(kf[1],qr[0],negm,0,0,0), P0[6],P0[7],P0[8],P0[9],     pw0[2]=PKW(P0,4), pw0[3]=PKW(P0,6), pw0); \
    VRD(1); SBAR(); GAPA(C0=__builtin_amdgcn_mfma_f32_32x32x16_bf16(kf[2],qr[1],C0,0,0,0),   P0[10],P0[11],P0[12],P0[13], pw1[0]=PKW(P0,8), pw1[1]=PKW(P0,10), pw1); \
    VRD(5); SBAR(); GAPA(C1=__builtin_amdgcn_mfma_f32_32x32x16_bf16(kf[3],qr[1],C1,0,0,0),   P0[14],P0[15],P1[0],P1[1],   pw1[2]=PKW(P0,12),pw1[3]=PKW(P0,14), pw1); \
    VRD(2); SBAR(); GAPA(C0=__builtin_amdgcn_mfma_f32_32x32x16_bf16(kf[4],qr[2],C0,0,0,0),   P1[2],P1[3],P1[4],P1[5],     pw2[0]=PKW(P1,0), pw2[1]=PKW(P1,2), pw2); \
    VRD(6); SBAR(); GAPA(C1=__builtin_amdgcn_mfma_f32_32x32x16_bf16(kf[5],qr[2],C1,0,0,0),   P1[6],P1[7],P1[8],P1[9],     pw2[2]=PKW(P1,4), pw2[3]=PKW(P1,6), pw2); \
    VRD(3); SBAR(); GAPA(C0=__builtin_amdgcn_mfma_f32_32x32x16_bf16(kf[6],qr[3],C0,0,0,0),   P1[10],P1[11],P1[12],P1[13], pw3[0]=PKW(P1,8), pw3[1]=PKW(P1,10), pw3); \
    VRD(7); SBAR(); GAPA(C1=__builtin_amdgcn_mfma_f32_32x32x16_bf16(kf[7],qr[3],C1,0,0,0),   P1[14],P1[15],0.f,0.f,       pw3[2]=PKW(P1,12),pw3[3]=PKW(P1,14), pw3); \
    l_reg+=sacc; \
    if(GK){DMA_K((t)+3,sl_cur);} if(GV){DMA_V((t)+1,sl_next);} \
    CMASK(C0,C1,t); \
    { float a=MX3(C0[0],C0[1],C1[0]),b=MX3(C0[2],C0[3],C1[1]); a=MX3(a,C1[2],C1[3]); \
      _Pragma("unroll") for(int r=4;r<16;r+=4){a=MX3(a,C0[r],C0[r+1]);b=MX3(b,C0[r+2],C0[r+3]);a=MX3(a,C1[r],C1[r+1]);b=MX3(b,C1[r+2],C1[r+3]);} \
      float rm=__builtin_fmaxf(a,b); { auto rr=__builtin_amdgcn_permlane32_swap(__float_as_uint(rm),__float_as_uint(rm),false,false); rm=__builtin_fmaxf(__uint_as_float(rr[0]),__uint_as_float(rr[1])); } \
      resc=false; \
      if(__builtin_expect(__any(rm>(float)THRL),0)){ const float dl=__builtin_fmaxf(rm,0.f); mhat+=dl; \
        _Pragma("unroll") for(int r=0;r<16;++r){C0[r]-=dl;C1[r]-=dl;} \
        _Pragma("unroll") for(int r=0;r<16;++r)negm[r]-=dl; asm volatile("":"+v"(negm)); \
        const float f=__builtin_amdgcn_exp2f(-dl); l_reg*=f; if(hi==0)wsf[r32]=f; resc=true; } } \
    SBAR(); \
    GAPB(o[0]=__builtin_amdgcn_mfma_f32_32x32x16_bf16(PAF(0),VFR(0),o[0],0,0,0), C0,0); \
    GAPB(o[1]=__builtin_amdgcn_mfma_f32_32x32x16_bf16(PAF(0),VFR(4),o[1],0,0,0), C0,4); \
    KRD(GL,0); GAPB(o[0]=__builtin_amdgcn_mfma_f32_32x32x16_bf16(PAF(1),VFR(1),o[0],0,0,0), C0,8); \
    KRD(GL,1); GAPB(o[1]=__builtin_amdgcn_mfma_f32_32x32x16_bf16(PAF(1),VFR(5),o[1],0,0,0), C0,12); \
    KRD(GL,2); GAPB(o[0]=__builtin_amdgcn_mfma_f32_32x32x16_bf16(PAF(2),VFR(2),o[0],0,0,0), C1,0); \
    KRD(GL,3); GAPB(o[1]=__builtin_amdgcn_mfma_f32_32x32x16_bf16(PAF(2),VFR(6),o[1],0,0,0), C1,4); \
    GAPB(o[0]=__builtin_amdgcn_mfma_f32_32x32x16_bf16(PAF(3),VFR(3),o[0],0,0,0), C1,8); \
    GAPB(o[1]=__builtin_amdgcn_mfma_f32_32x32x16_bf16(PAF(3),VFR(7),o[1],0,0,0), C1,12); \
    }while(0)
  int t=1;
  for(;t+5<NT;t+=2){
    STEP(pB0,pB1,pA0,pA1,t,true,true,true);     WAIT_BAR(2); RESC(); ROT();
    STEP(pA0,pA1,pB0,pB1,t+1,true,true,true);   WAIT_BAR(2); RESC(); ROT();
  }
  #define ENDW(tt) do{ if((tt)+3<NT){WAIT_BAR(2);} else if((tt)+2<NT){WAIT_BAR(1);} else {WAIT_BAR(0);} }while(0)
  for(;t+1<NT;t+=2){
    STEP(pB0,pB1,pA0,pA1,t,(t+3<NT),(t+1<NT),(t+1<NT));       ENDW(t);   RESC(); ROT();
    STEP(pA0,pA1,pB0,pB1,t+1,(t+4<NT),(t+2<NT),(t+2<NT));     ENDW(t+1); RESC(); ROT();
  }
  STEP(pB0,pB1,pA0,pA1,NT-1,false,false,false); RESC();
  { float sacc=pB0[0]+pB0[1]; _Pragma("unroll") for(int r=2;r<16;++r)sacc+=pB0[r]; _Pragma("unroll") for(int r=0;r<16;++r)sacc+=pB1[r]; l_reg+=sacc;
    pw0=(u32x4){PKW(pB0,0),PKW(pB0,2),PKW(pB0,4),PKW(pB0,6)};pw1=(u32x4){PKW(pB0,8),PKW(pB0,10),PKW(pB0,12),PKW(pB0,14)};pw2=(u32x4){PKW(pB1,0),PKW(pB1,2),PKW(pB1,4),PKW(pB1,6)};pw3=(u32x4){PKW(pB1,8),PKW(pB1,10),PKW(pB1,12),PKW(pB1,14)};
    SBAR(); pv(o,vb0+sl_cur,PAF(0),PAF(1),PAF(2),PAF(3)); }
  #undef PKW
  #undef PAF
  #undef VFR
  #undef PIN
  #undef MX3
  #undef GAPA
  #undef GAPB
  #undef EX
  #undef VRD
  #undef KRD
  #undef STEP
  #undef ENDW
  {auto rr=__builtin_amdgcn_permlane32_swap(__float_as_uint(l_reg),__float_as_uint(l_reg),false,false);l_reg=__uint_as_float(rr[0])+__uint_as_float(rr[1]);}
  if(hi==0)wsf[32+r32]=l_reg;asm volatile("s_waitcnt lgkmcnt(0)":::"memory");
  float rli[16];
  #pragma unroll
  for(int r=0;r<16;++r)rli[r]=__builtin_amdgcn_rcpf(wsf[32+crow(r,hi)]);
  bf16*Ow=O+(rowbase+q0+wid*QBLK)*OPITCH+OCOL0+h*D;
  { bf16*stg=(bf16*)(shm+LDS_OST)+wid*2048;
    #pragma unroll
    for(int r=0;r<16;++r){const int orow=crow(r,hi);
      #pragma unroll
      for(int d0=0;d0<2;++d0)stg[orow*64+d0*32+r32]=__float2bfloat16(o[d0][r]*rli[r]);}
    asm volatile("s_waitcnt lgkmcnt(0)":::"memory");
    #pragma unroll
    for(int i=0;i<4;++i){const int row=i*8+(lane>>3),ch=lane&7; const u32x4 v=*(const u32x4*)(stg+row*64+ch*8); ATTN_STORE16(Ow+(long)row*OPITCH+ch*8,v);} }
  asm volatile("s_waitcnt lgkmcnt(0)\n\ts_barrier":::"memory");
  #undef DMA_K
  #undef DMA_V
  #undef CMASK
  #undef SETBLK
  #undef SMP
  #undef LANEID
  #undef START
  #undef RESC
  #undef ROT
}
constexpr int ATTN_LDS_BYTES=LDS_BYTES;
struct AttnTensors { const bf16* Q; const bf16* K; const bf16* V; bf16* O; const float* UG; const float* KSUM; };
struct AttnUnit { int bh; int qb; };
struct StaticOrder {
  int vcu;
  __device__ __forceinline__ explicit StaticOrder(int grid,int block):vcu((block%8)*(grid/8)+block/8){}
  __device__ __forceinline__ bool next(int i,AttnUnit&u)const{ if(i>=4)return false; const int s=vcu&3; u.bh=vcu>>2; u.qb=(i==0)?15-s:(i==1)?s:(i==2)?11-s:4+s; return true; }
  __device__ __forceinline__ void a_ready(const AttnUnit&)const{}
  __device__ __forceinline__ void done(const AttnUnit&)const{}
};
template<class Sched,int THRL=8> __device__ __forceinline__ void attn_phase(char*lds,const AttnTensors&T,const Sched&S){
  AttnUnit u;
  for(int i=0;S.next(i,u);++i){ S.a_ready(u); attn_unit<THRL>(u.bh/NHEAD,u.bh%NHEAD,u.qb,T.Q,T.K,T.V,T.O,T.UG,T.KSUM,lds); S.done(u); }
}
#undef SBAR
#undef WAIT_BAR
}
struct Frame {
    LAS unsigned char* lds; volatile LAS unsigned* MISC; unsigned* ctl; unsigned char* ws;
    int tid, lane, wave, G, blk;
    const float* const* in; float* out;
};
#ifndef REP_MASK
#define REP_MASK 0u
#endif
#define REPS(j) for (int rep_ = 0; rep_ < (((REP_MASK >> (j)) & 1u) ? 2 : 1); ++rep_)
#ifndef SSD_NAIVE
#define SSD_NAIVE 0
#endif
#ifndef ATTN_NAIVE
#define ATTN_NAIVE 0
#endif
#ifndef ATTN_PROBE
#define ATTN_PROBE 0
#endif
constexpr int CW_SCAN = 2304;
constexpr int CW_RARR = 2560;
constexpr int CW_WQ = 2048;
__device__ __forceinline__ unsigned char* wsp(const Frame& F) { return F.ws; }

__device__ __forceinline__ float wave_sum(float v) {
#pragma unroll
    for (int o = 1; o < 64; o <<= 1) v += __shfl_xor(v, o);
    return v;
}
__device__ __forceinline__ float wave_max(float v) {
#pragma unroll
    for (int o = 1; o < 64; o <<= 1) v = fmaxf(v, __shfl_xor(v, o));
    return v;
}

__device__ __forceinline__ void tr_item64(const float* W, int ldn, int k0, int c0, int nvalid, bf16* WT, int ldk, int dbase, int dstep32, const float* kscale, LAS unsigned short* tl, int lane) {
    const int n4 = (lane & 15) * 4, kq = lane >> 4;
    f32x4 v[16];
#pragma unroll
    for (int i = 0; i < 16; ++i) v[i] = (n4 < nvalid) ? *(const f32x4*)(W + (size_t)(k0 + 4 * i + kq) * ldn + c0 + n4) : (f32x4){0.f, 0.f, 0.f, 0.f};
#pragma unroll
    for (int i = 0; i < 16; ++i) { const int kk = 4 * i + kq; const float s = kscale ? kscale[k0 + kk] : 1.0f; v2u p; p.x = pk2(v[i].x * s, v[i].y * s); p.y = pk2(v[i].z * s, v[i].w * s); *(LAS v2u*)(tl + kk * 68 + n4) = p; }
    LDS_WAIT(); asm volatile("" ::: "memory");
    const int c = lane & 7;
#pragma unroll
    for (int j = 0; j < 8; ++j) { const int n = (lane >> 3) + 8 * j; const LAS unsigned short* s = tl + (8 * c) * 68 + n;
        v4u o; o.x = (unsigned)s[0] | ((unsigned)s[68] << 16); o.y = (unsigned)s[136] | ((unsigned)s[204] << 16); o.z = (unsigned)s[272] | ((unsigned)s[340] << 16); o.w = (unsigned)s[408] | ((unsigned)s[476] << 16);
        if (n < nvalid) *(v4u*)(WT + (size_t)(dbase + (n >> 5) * dstep32 + (n & 31)) * ldk + k0 + 8 * c) = o; }
    LDS_WAIT(); asm volatile("" ::: "memory");
}
constexpr int IT_IN = 16 * 45, IT_OUT = 256, IT_G = 4096, IT_LAYER = IT_IN + IT_OUT + 3 * IT_G;
__device__ __forceinline__ void prologue_item(Frame& F, int it, LAS unsigned short* tl, int lane) {
    unsigned char* const W_ = wsp(F);
    const int l = it / IT_LAYER; int r = it % IT_LAYER;
    bf16* Win_t = (bf16*)(W_ + WS_WIN) + (size_t)l * NIN * 1024; bf16* Wout_t = (bf16*)(W_ + WS_WOUT) + (size_t)l * 1024 * 1024;
    bf16* Wgu_t = (bf16*)(W_ + WS_WGU) + (size_t)l * 32 * 1024 * 1024; bf16* Wd_t = (bf16*)(W_ + WS_WD) + (size_t)l * 32 * 1024 * 512;
    if (r < IT_IN) { const int kb = r / 45, cb = r % 45; int c0, nv = 64, dbase, dstep = 32;
        if (cb < 8) { c0 = 64 * cb; dbase = c0; }
        else if (cb < 20) { c0 = 512 + 64 * (cb - 8); dbase = c0; }
        else if (cb == 20) { c0 = 1280; nv = 8; dbase = 2816; }
        else if (cb < 29) { const int hd = cb - 21; c0 = 1288 + 64 * hd; dbase = 256 * (5 + (hd >> 2)) + 32 * (hd & 3); dstep = 128; }
        else if (cb < 37) { const int hd = cb - 29; c0 = 1800 + 64 * hd; dbase = 256 * (7 + (hd >> 2)) + 32 * (hd & 3); dstep = 128; }
        else { const int j = cb - 37; c0 = 2312 + 64 * j; dbase = 2304 + 64 * j; }
        tr_item64(F.in[3] + (size_t)l * 1024 * INCOLS, INCOLS, 64 * kb, c0, nv, Win_t, 1024, dbase, dstep, F.in[2] + l * D, tl, lane); return; }
    r -= IT_IN;
    if (r < IT_OUT) { const int kb = r >> 4, nb = r & 15;
        tr_item64(F.in[12] + (size_t)l * 1024 * 1024, 1024, 64 * kb, 64 * nb, 64, Wout_t, 1024, 64 * nb, 32, (kb < 8) ? F.in[9] + l * 512 : nullptr, tl, lane); return; }
    r -= IT_OUT;
    if (r < 2 * IT_G) { const int up = r >= IT_G; if (up) r -= IT_G; const int e = r >> 7, q = r & 127, kb = q >> 3, nb = q & 7;
        tr_item64(F.in[up ? 19 : 18] + (size_t)(l * 32 + e) * 1024 * 512, 512, 64 * kb, 64 * nb, 64, Wgu_t + (size_t)e * 1024 * 1024, 1024, 256 * (nb >> 1) + 128 * up + 64 * (nb & 1), 32, nullptr, tl, lane); return; }
    r -= 2 * IT_G;
    { const int e = r >> 7, q = r & 127, kb = q >> 4, nb = q & 15;
        tr_item64(F.in[20] + (size_t)(l * 32 + e) * 512 * 1024, 1024, 64 * kb, 64 * nb, 64, Wd_t + (size_t)e * 1024 * 512, 512, 64 * nb, 32, nullptr, tl, lane); }
}
__device__ __forceinline__ void moe_convert_all(Frame& F, int l) {
    int ln = F.lane; asm volatile("" : "+v"(ln));
    LAS unsigned short* scr = (LAS unsigned short*)(F.lds + F.wave * 16384);
    const int gw = F.blk * NWAVES + F.wave;
#pragma unroll 1
    for (int j = 0; j < 6; ++j) prologue_item(F, l * IT_LAYER + IT_IN + IT_OUT + j * (GRID * NWAVES) + gw, scr, ln);
    __syncthreads();
}
__device__ __forceinline__ void rms_row_store(const f32x4 (&v)[4], const float* g, bf16* orow, int lane) {
    float s = 0.f;
#pragma unroll
    for (int j = 0; j < 4; ++j) s += (v[j].x * v[j].x + v[j].y * v[j].y) + (v[j].z * v[j].z + v[j].w * v[j].w);
    const float rs = 1.0f / sqrtf(wave_sum(s) * (1.0f / D) + EPS);
#pragma unroll
    for (int j = 0; j < 4; ++j) { const f32x4 gj = *((const f32x4*)g + lane + 64 * j); const f32x4 o = v[j] * rs * gj;
        v2u w; w.x = pk2(o.x, o.y); w.y = pk2(o.z, o.w); *((v2u*)orow + lane + 64 * j) = w; }
}
__device__ __forceinline__ void phase_prologue(Frame& F) {
    unsigned char* const W_ = wsp(F);
    LAS unsigned short* scr = (LAS unsigned short*)(F.lds + F.wave * 16384);
    const int gw = F.blk * NWAVES + F.wave, NGW = F.G * NWAVES;
    constexpr int IT_ESS = IT_IN + IT_OUT;
    for (int it = gw; it < DEPTH * IT_ESS; it += NGW) prologue_item(F, (it / IT_ESS) * IT_LAYER + (it % IT_ESS), scr, F.lane);
    for (int r = gw; r < DEPTH * 248; r += NGW) { const int l = r / 248, rr = r % 248; v4u* p = (v4u*)((bf16*)(W_ + WS_WIN) + ((size_t)l * NIN + 2824 + rr) * 1024);
        p[F.lane] = (v4u){0u, 0u, 0u, 0u}; p[64 + F.lane] = (v4u){0u, 0u, 0u, 0u}; }
    { bf16* wrh = (bf16*)(W_ + WS_WR); bf16* wrl = wrh + DEPTH * 64 * 1024;
      for (int i = F.blk * NTHREADS + F.tid; i < DEPTH * 64 * 1024; i += F.G * NTHREADS) { const int l = i >> 16, c = (i >> 10) & 63, k = i & 1023; float v = 0.f;
          if (c < 36) v = F.in[13][l * D + k] * ((c < 4) ? F.in[14][((size_t)l * 1024 + k) * 4 + c] : F.in[16][((size_t)l * 1024 + k) * 32 + (c - 4)]);
          const unsigned h = f2bf(v); const float r = v - __builtin_bit_cast(float, h << 16); wrh[i] = (bf16)h; wrl[i] = (bf16)f2bf(r); } }
    float* tb = (float*)(W_ + WS_TB);
    { const int i = F.blk * NTHREADS + F.tid;
      if (i < 1024) { const int h = i >> 7, d = i & 127; int bk = d; if (d >= 16) { bk = 16 + (int)(log2f((float)d * (1.0f / 16.0f)) * (16.0f / 3.0f)); bk = bk > 31 ? 31 : bk; } tb[i] = F.in[1][bk * 8 + h] * LOG2E; }
      else if (i < 1032) tb[i] = F.in[1][31 * 8 + (i - 1024)] * LOG2E; }
    { float* ug = (float*)(W_ + WS_UG);
      for (int i = F.blk * NTHREADS + F.tid; i < 8 * 768; i += F.G * NTHREADS) { const int h = i / 768, d = 511 - (i % 768); float v;
          if (d < 0) v = -1e30f; else { int bk = d; if (d >= 16) { bk = 16 + (int)(log2f((float)d * (1.0f / 16.0f)) * (16.0f / 3.0f)); bk = bk > 31 ? 31 : bk; } v = F.in[1][bk * 8 + h] * LOG2E; }
          ug[i] = v; } }
    bf16* hb = (bf16*)(W_ + WS_HB); float* rs1 = (float*)(W_ + WS_RS1);
    for (int t = gw; t < T; t += NGW) { const f32x4* xr = (const f32x4*)(F.in[0] + (size_t)t * D) + F.lane; float s = 0.f;
#pragma unroll
        for (int j = 0; j < 4; ++j) { const f32x4 v = xr[64 * j]; v2u w; w.x = pk2(v.x, v.y); w.y = pk2(v.z, v.w); *((v2u*)(hb + (size_t)t * D) + F.lane + 64 * j) = w;
            const float a0 = bflo(w.x), a1 = bfhi(w.x), a2 = bflo(w.y), a3 = bfhi(w.y); s += (a0 * a0 + a1 * a1) + (a2 * a2 + a3 * a3); }
        s = wave_sum(s); if (F.lane == 0) rs1[t] = 1.0f / sqrtf(s * (1.0f / D) + EPS); }
}
template <bool DUMMY = false> __device__ __forceinline__ void phase_combine(Frame& F, int lnext) {
    unsigned char* const W_ = wsp(F);
    const int gw = F.blk * NWAVES + F.wave; const int t0 = gw * 16;
    const unsigned* route = (const unsigned*)(W_ + WS_ROUTE); const bf16* y = (const bf16*)(W_ + R1_XG); bf16* hb = (bf16*)(W_ + WS_HB);
    float* rs1 = (float*)(W_ + (DUMMY ? R1_HMID : WS_RS1));
    const v4u rw = *(const v4u*)(route + (size_t)(t0 + (F.lane & 15)) * 8 + 4);
#pragma unroll 1
    for (int i4 = 0; i4 < 16; i4 += 4) {
        v2u hv[4][4], ya[4][4], yb[4][4]; float g0[4], g1[4];
#pragma unroll
        for (int q = 0; q < 4; ++q) { const unsigned s0 = (unsigned)__shfl((int)rw.z, i4 + q), s1 = (unsigned)__shfl((int)rw.w, i4 + q); g0[q] = __builtin_bit_cast(float, __shfl((int)rw.x, i4 + q)); g1[q] = __builtin_bit_cast(float, __shfl((int)rw.y, i4 + q));
            const v2u* hr = (const v2u*)(hb + (size_t)(t0 + i4 + q) * D) + F.lane; const v2u* y0 = (const v2u*)(y + (size_t)s0 * D) + F.lane; const v2u* y1 = (const v2u*)(y + (size_t)s1 * D) + F.lane;
#pragma unroll
            for (int j = 0; j < 4; ++j) { hv[q][j] = hr[64 * j]; ya[q][j] = y0[64 * j]; yb[q][j] = y1[64 * j]; } }
#pragma unroll
        for (int q = 0; q < 4; ++q) { const int t = t0 + i4 + q; f32x4 v[4];
#pragma unroll
            for (int j = 0; j < 4; ++j) { const v2u h2 = hv[q][j], a = ya[q][j], b = yb[q][j];
                v[j].x = bflo(h2.x) + (g0[q] * bflo(a.x) + g1[q] * bflo(b.x)); v[j].y = bfhi(h2.x) + (g0[q] * bfhi(a.x) + g1[q] * bfhi(b.x)); v[j].z = bflo(h2.y) + (g0[q] * bflo(a.y) + g1[q] * bflo(b.y)); v[j].w = bfhi(h2.y) + (g0[q] * bfhi(a.y) + g1[q] * bfhi(b.y)); }
            if (lnext < DEPTH) { v2u* hw = DUMMY ? (v2u*)((unsigned char*)F.out + 64 * MiB + (size_t)t * D * 2) + F.lane : (v2u*)(hb + (size_t)t * D) + F.lane;
                float ss = 0.f;
#pragma unroll
                for (int j = 0; j < 4; ++j) { v2u w; w.x = pk2(v[j].x, v[j].y); w.y = pk2(v[j].z, v[j].w); hw[64 * j] = w; const float a0 = bflo(w.x), a1 = bfhi(w.x), a2 = bflo(w.y), a3 = bfhi(w.y); ss += (a0 * a0 + a1 * a1) + (a2 * a2 + a3 * a3); }
                ss = wave_sum(ss); if (F.lane == 0) rs1[t] = 1.0f / sqrtf(ss * (1.0f / D) + EPS);
            } else {
#pragma unroll
                for (int j = 0; j < 4; ++j) *((f32x4*)(F.out + (size_t)t * D) + F.lane + 64 * j) = v[j];
            } }
    }
}
__device__ __forceinline__ void phase_conv(Frame& F, int l) {
    unsigned char* const W_ = wsp(F);
    const bf16* xbc = (const bf16*)(W_ + R1_XBC); bf16* xact = (bf16*)(W_ + WS_XN);
    const float* cw = F.in[4] + (size_t)l * 4 * CCH; const float* cb = F.in[5] + (size_t)l * CCH;
    for (int i = F.blk * NTHREADS + F.tid; i < T * 96; i += F.G * NTHREADS) { const int t = i / 96, c0 = (i % 96) * 8, s = t % SEQ;
        float a[8];
#pragma unroll
        for (int q = 0; q < 8; ++q) a[q] = cb[c0 + q];
#pragma unroll
        for (int j = 0; j < 4; ++j) { if (s - 3 + j >= 0) { const v4u w = *(const v4u*)(xbc + (size_t)(t - 3 + j) * CCH + c0); const float* wj = cw + j * CCH + c0;
            a[0] += wj[0] * bflo(w.x); a[1] += wj[1] * bfhi(w.x); a[2] += wj[2] * bflo(w.y); a[3] += wj[3] * bfhi(w.y); a[4] += wj[4] * bflo(w.z); a[5] += wj[5] * bfhi(w.z); a[6] += wj[6] * bflo(w.w); a[7] += wj[7] * bfhi(w.w); } }
#pragma unroll
        for (int q = 0; q < 8; ++q) a[q] = a[q] / (1.0f + __expf(-a[q]));
        v4u o; o.x = pk2(a[0], a[1]); o.y = pk2(a[2], a[3]); o.z = pk2(a[4], a[5]); o.w = pk2(a[6], a[7]);
        *(v4u*)(xact + (size_t)t * CCH + c0) = o; }
}
__device__ __forceinline__ void ssd_naive_item(Frame& F, int l, int item) {
    unsigned char* const W_ = wsp(F);
    const bf16* xact = (const bf16*)(W_ + WS_XN); const float* dtb = (const float*)(W_ + R1_DT); const bf16* zb = (const bf16*)(W_ + R1_Z); bf16* ymix = (bf16*)(W_ + R1_YMIX);
    const int lane = F.lane, pi = lane >> 4, ng = lane & 15;
    const int b = item >> 7, head = (item >> 4) & 7, pq = item & 15, p = 4 * pq + pi, g = head >> 2;
    const float A = -__expf(F.in[7][l * 8 + head]), dtbias = F.in[6][l * 8 + head], Dk = F.in[8][l * 8 + head];
    float h0 = 0.f, h1 = 0.f, h2 = 0.f, h3 = 0.f;
    const size_t r0 = (size_t)b * SEQ;
#pragma unroll 4
    for (int t = 0; t < SEQ; ++t) { const size_t row = r0 + t;
        const float dr = dtb[row * 8 + head] + dtbias; const float dtv = fmaxf(dr, 0.f) + log1pf(__expf(-fabsf(dr))); const float dA = __expf(dtv * A);
        const float x = bf1(xact[row * CCH + head * 64 + p]);
        const v2u bw = *(const v2u*)(xact + row * CCH + 512 + g * 64 + 4 * ng), cw = *(const v2u*)(xact + row * CCH + 640 + g * 64 + 4 * ng);
        const float xdt = x * dtv;
        h0 = h0 * dA + xdt * bflo(bw.x); h1 = h1 * dA + xdt * bfhi(bw.x); h2 = h2 * dA + xdt * bflo(bw.y); h3 = h3 * dA + xdt * bfhi(bw.y);
        float part = (h0 * bflo(cw.x) + h1 * bfhi(cw.x)) + (h2 * bflo(cw.y) + h3 * bfhi(cw.y));
        part += __shfl_xor(part, 1); part += __shfl_xor(part, 2); part += __shfl_xor(part, 4); part += __shfl_xor(part, 8);
        const float yv = part + Dk * x; const float zt = bf1(zb[row * DI + head * 64 + p]); const float yg = yv * zt / (1.0f + __expf(-zt));
        if (ng == 0) ymix[row * 1024 + head * 64 + p] = (bf16)f2bf(yg);
    }
}
__device__ __forceinline__ void attn_naive_query(Frame& F, int b, int h, int s, const float* ksum) {
    unsigned char* const W_ = wsp(F);
    const bf16* qbuf = (const bf16*)(W_ + R1_Q); const bf16* kbuf = (const bf16*)(W_ + R1_K); const bf16* vbuf = (const bf16*)(W_ + R1_V); bf16* ymix = (bf16*)(W_ + R1_YMIX);
    const float* tb = (const float*)(W_ + WS_TB);
    const int lane = F.lane, qb = s >> 8; const size_t rowq = (size_t)b * SEQ + s;
    float qf[64];
    { const v4u* qp = (const v4u*)(qbuf + rowq * 512 + h * 64);
#pragma unroll
      for (int i = 0; i < 8; ++i) { const v4u w = qp[i]; qf[8 * i] = bflo(w.x); qf[8 * i + 1] = bfhi(w.x); qf[8 * i + 2] = bflo(w.y); qf[8 * i + 3] = bfhi(w.y); qf[8 * i + 4] = bflo(w.z); qf[8 * i + 5] = bfhi(w.z); qf[8 * i + 6] = bflo(w.w); qf[8 * i + 7] = bfhi(w.w); } }
    float gv = -INFINITY;
    if (lane < qb) { const f32x4* kp = (const f32x4*)(ksum + (((size_t)b * 8 + h) * 16 + lane) * 64); float a = 0.f;
#pragma unroll
        for (int i = 0; i < 16; ++i) { const f32x4 kv = kp[i]; a += (qf[4 * i] * kv.x + qf[4 * i + 1] * kv.y) + (qf[4 * i + 2] * kv.z + qf[4 * i + 3] * kv.w); }
        gv = a; }
    unsigned selmask = 0u;
    for (int r = 0; r < 3; ++r) { float best = gv; int bi = lane;
#pragma unroll
        for (int o = 1; o < 64; o <<= 1) { const float ob = __shfl_xor(best, o); const int oi = __shfl_xor(bi, o); if (ob > best || (ob == best && oi < bi)) { best = ob; bi = oi; } }
        if (best > -INFINITY) selmask |= 1u << bi;
        if (lane == bi) gv = -INFINITY; }
    selmask = (unsigned)__builtin_amdgcn_readfirstlane((int)selmask) | (1u << qb);
    float m = -INFINITY, lsum = 0.f, o = 0.f;
    for (int bi2 = 0; bi2 <= qb; ++bi2) { const int n = qb - bi2;
        if (!((selmask >> n) & 1u)) continue;
        for (int tt = 0; tt < 4; ++tt) { const int key0 = n * 256 + tt * 64; if (key0 > s) break; const int key = key0 + lane;
            const v4u* kp = (const v4u*)(kbuf + ((size_t)b * SEQ + key) * 512 + h * 64); float sc = 0.f;
#pragma unroll
            for (int i = 0; i < 8; ++i) { const v4u w = kp[i]; sc += (qf[8 * i] * bflo(w.x) + qf[8 * i + 1] * bfhi(w.x)) + (qf[8 * i + 2] * bflo(w.y) + qf[8 * i + 3] * bfhi(w.y)) + (qf[8 * i + 4] * bflo(w.z) + qf[8 * i + 5] * bfhi(w.z)) + (qf[8 * i + 6] * bflo(w.w) + qf[8 * i + 7] * bfhi(w.w)); }
            const int dist = s - key; const float bias = (dist < 128) ? tb[h * 128 + (dist < 0 ? 0 : dist)] : tb[1024 + h];
            sc = (dist < 0) ? -INFINITY : sc + bias;
            const float mn = fmaxf(m, wave_max(sc)); const float f = __builtin_amdgcn_exp2f(m - mn), p = __builtin_amdgcn_exp2f(sc - mn); m = mn;
            lsum = lsum * f + wave_sum(p); o *= f;
            const bf16* vp = vbuf + ((size_t)b * SEQ + key0) * 512 + h * 64 + lane;
#pragma unroll 16
            for (int j = 0; j < 64; ++j) { const float pj = __builtin_bit_cast(float, __builtin_amdgcn_readlane(__builtin_bit_cast(int, p), j)); o += pj * bf1(vp[(size_t)j * 512]); }
        } }
#if ATTN_PROBE
    { const size_t ix = rowq * 1024 + 512 + h * 64 + lane; const float fast = bf1(ymix[ix]); ymix[ix] = (bf16)f2bf(fast + (float)ATTN_PROBE * (fast - o / lsum)); }
#else
    ymix[rowq * 1024 + 512 + h * 64 + lane] = (bf16)f2bf(o / lsum);
#endif
}
namespace ssd {
typedef short bf16x8 __attribute__((ext_vector_type(8)));
typedef short bf16x4 __attribute__((ext_vector_type(4)));
typedef float f32x16 __attribute__((ext_vector_type(16)));
typedef float f32x2_t __attribute__((ext_vector_type(2))); typedef __bf16 bf16x2_t __attribute__((ext_vector_type(2)));
__device__ __forceinline__ unsigned cvtpk(float lo, float hi) { f32x2_t v = {lo, hi}; bf16x2_t b = __builtin_convertvector(v, bf16x2_t); return __builtin_bit_cast(unsigned, b); }
__device__ __forceinline__ int crow(int r, int hi) { return (r & 3) + 8 * (r >> 2) + 4 * hi; }
__device__ __forceinline__ float softplus_f(float x) { return fmaxf(x, 0.f) + log1pf(__expf(-fabsf(x))); }
__device__ __forceinline__ void chunk_scalars(const float* dtraw, int t0, int head, float dtbias, float A, int lane, float& dt0, float& dt1, float& cs0, float& cs1) {
    dt0 = softplus_f(dtraw[(size_t)(t0 + lane) * 8 + head] + dtbias); dt1 = softplus_f(dtraw[(size_t)(t0 + 64 + lane) * 8 + head] + dtbias);
    float v0 = dt0 * A, v1 = dt1 * A;
#pragma unroll
    for (int o = 1; o < 64; o <<= 1) { const float a = __shfl_up(v0, o), b = __shfl_up(v1, o); if (lane >= o) { v0 += a; v1 += b; } }
    cs0 = v0; cs1 = v1 + __shfl(v0, 63);
}
}

__device__ __forceinline__ void phase_ssd_prep(Frame& F, int l) {
    unsigned char* const W_ = wsp(F);
    const bf16* xbc = (const bf16*)(W_ + R1_XBC); bf16* XT = (bf16*)((unsigned char*)F.out + SS_XT); bf16* BT = (bf16*)((unsigned char*)F.out + SS_BT); bf16* BC = (bf16*)((unsigned char*)F.out + SS_BC);
    const float* cw = F.in[4] + (size_t)l * 4 * CCH; const float* cb = F.in[5] + (size_t)l * CCH;
    for (int i = F.tid; i < 16 * 96; i += NTHREADS) { const int tgl = i & 7, cgl = (i >> 3) & 7, wv_ = i >> 6, cgo = wv_ % 12, tgo = wv_ / 12, b = F.blk >> 5; const int cg = cgo * 8 + cgl, tg = (F.blk & 31) * 16 + tgo * 8 + tgl; const int c0 = cg * 8, s0 = tg * 8; const size_t r0 = (size_t)b * SEQ + s0;
        float w[4][8], bias[8];
#pragma unroll
        for (int j = 0; j < 4; ++j) { const f32x4 a = *(const f32x4*)(cw + j * CCH + c0), b2 = *(const f32x4*)(cw + j * CCH + c0 + 4); w[j][0] = a.x; w[j][1] = a.y; w[j][2] = a.z; w[j][3] = a.w; w[j][4] = b2.x; w[j][5] = b2.y; w[j][6] = b2.z; w[j][7] = b2.w; }
        { const f32x4 a = *(const f32x4*)(cb + c0), b2 = *(const f32x4*)(cb + c0 + 4); bias[0] = a.x; bias[1] = a.y; bias[2] = a.z; bias[3] = a.w; bias[4] = b2.x; bias[5] = b2.y; bias[6] = b2.z; bias[7] = b2.w; }
        v4u xin[11];
#pragma unroll
        for (int j = 0; j < 11; ++j) xin[j] = (s0 - 3 + j >= 0) ? *(const v4u*)(xbc + (r0 + j - 3) * CCH + c0) : (v4u){0u, 0u, 0u, 0u};
        unsigned o[8][8];
#pragma unroll
        for (int t = 0; t < 8; ++t) {
            float a[8];
#pragma unroll
            for (int q = 0; q < 8; ++q) a[q] = bias[q];
#pragma unroll
            for (int j = 0; j < 4; ++j) { const v4u x = xin[t + j];
                a[0] += w[j][0] * bflo(x.x); a[1] += w[j][1] * bfhi(x.x); a[2] += w[j][2] * bflo(x.y); a[3] += w[j][3] * bfhi(x.y); a[4] += w[j][4] * bflo(x.z); a[5] += w[j][5] * bfhi(x.z); a[6] += w[j][6] * bflo(x.w); a[7] += w[j][7] * bfhi(x.w); }
#pragma unroll
            for (int q = 0; q < 8; ++q) o[t][q] = f2bf(a[q] * __builtin_amdgcn_rcpf(1.0f + __builtin_amdgcn_exp2f(-LOG2E * a[q])));
        }
        if (c0 >= 512) {
#pragma unroll
            for (int t = 0; t < 8; ++t) { v4u pk; pk.x = o[t][0] | (o[t][1] << 16); pk.y = o[t][2] | (o[t][3] << 16); pk.z = o[t][4] | (o[t][5] << 16); pk.w = o[t][6] | (o[t][7] << 16); *(v4u*)(BC + (r0 + t) * 256 + (c0 - 512)) = pk; } }
        if (c0 < 640) {
#pragma unroll
            for (int q = 0; q < 8; ++q) { v4u pk; pk.x = o[0][q] | (o[1][q] << 16); pk.y = o[2][q] | (o[3][q] << 16); pk.z = o[4][q] | (o[5][q] << 16); pk.w = o[6][q] | (o[7][q] << 16); const int c = c0 + q;
                bf16* dst = (c0 < 512) ? XT + ((size_t)(b * 8 + (c >> 6)) * 64 + (c & 63)) * SEQ + s0 : BT + ((size_t)(b * 2 + ((c - 512) >> 6)) * 64 + ((c - 512) & 63)) * SEQ + s0;
                *(v4u*)dst = pk; } }
    }
}
__device__ __forceinline__ void ssd_states_item(Frame& F, int l, int wgi) {
    unsigned char* const W_ = wsp(F);
    const int lane = F.lane, r32 = lane & 31, hi = lane >> 5;
    const int b = wgi >> 6, c = (wgi >> 1) & 31, g = wgi & 1, head = g * 4 + (F.wave >> 1), ph = F.wave & 1;
    const int t0 = b * SEQ + c * 128; const int item = ((b * 8 + head) * 2 + ph) * 32 + c;
    LAS float* SC = (LAS float*)(F.lds + F.wave * 8192);
    const bf16* bt = (const bf16*)((unsigned char*)F.out + SS_BT) + ((size_t)(b * 2 + g) * 64 + r32) * SEQ + c * 128 + 8 * hi;
    const bf16* xt = (const bf16*)((unsigned char*)F.out + SS_XT) + ((size_t)(b * 8 + head) * 64 + ph * 32 + r32) * SEQ + c * 128 + 8 * hi;
    ssd::bf16x8 fa0[8], fa1[8]; v4u fx[8];
#pragma unroll
    for (int k = 0; k < 8; ++k) { fa0[k] = *(const ssd::bf16x8*)(bt + 16 * k); fa1[k] = *(const ssd::bf16x8*)(bt + (size_t)32 * SEQ + 16 * k); fx[k] = *(const v4u*)(xt + 16 * k); }
    float dt0, dt1, cs0, cs1; ssd::chunk_scalars((const float*)(W_ + R1_DT), t0, head, F.in[6][l * 8 + head], -__expf(F.in[7][l * 8 + head]), lane, dt0, dt1, cs0, cs1);
    const float cend = __shfl(cs1, 63);
    SC[lane] = dt0 * __expf(cend - cs0); SC[64 + lane] = dt1 * __expf(cend - cs1);
    LDS_WAIT(); asm volatile("" ::: "memory");
    ssd::f32x16 acc0 = {}, acc1 = {};
#pragma unroll
    for (int k = 0; k < 8; ++k) {
        const v4u xw = fx[k];
        const f32x4 s0 = *(const LAS f32x4*)(SC + 16 * k + 8 * hi), s1 = *(const LAS f32x4*)(SC + 16 * k + 8 * hi + 4);
        v4u xs; xs.x = ssd::cvtpk(bflo(xw.x) * s0.x, bfhi(xw.x) * s0.y); xs.y = ssd::cvtpk(bflo(xw.y) * s0.z, bfhi(xw.y) * s0.w); xs.z = ssd::cvtpk(bflo(xw.z) * s1.x, bfhi(xw.z) * s1.y); xs.w = ssd::cvtpk(bflo(xw.w) * s1.z, bfhi(xw.w) * s1.w);
        const ssd::bf16x8 xb = __builtin_bit_cast(ssd::bf16x8, xs);
        acc0 = __builtin_amdgcn_mfma_f32_32x32x16_bf16(fa0[k], xb, acc0, 0, 0, 0); acc1 = __builtin_amdgcn_mfma_f32_32x32x16_bf16(fa1[k], xb, acc1, 0, 0, 0);
    }
    float* S = (float*)((unsigned char*)F.out + SS_S) + (size_t)item * 2048 + lane;
#pragma unroll
    for (int r = 0; r < 16; ++r) { S[r * 64] = acc0[r]; S[(16 + r) * 64] = acc1[r]; }
    if (lane == 0) ((float*)(W_ + SS_DEC))[item] = __expf(cend);
    LDS_WAIT(); asm volatile("" ::: "memory");
}
__device__ __forceinline__ void phase_ssd_scan(Frame& F, unsigned* ctr) {
    unsigned char* const W_ = wsp(F);
    const f32x4* S4 = (const f32x4*)((unsigned char*)F.out + SS_S); const float* dec = (const float*)(W_ + SS_DEC);
    const __amdgpu_buffer_rsrc_t rs = __builtin_amdgcn_make_buffer_rsrc((void*)((unsigned char*)F.out + SS_S), 0, 32 * 1024 * 1024, 0x00020000);
    for (int i = F.blk * NTHREADS + F.tid; i < 128 * 512; i += F.G * NTHREADS) { const int bhp = i >> 9, e4 = i & 511; f32x4 hs = {0.f, 0.f, 0.f, 0.f};
#pragma unroll
        for (int half = 0; half < 2; ++half) { f32x4 sv[16]; float dv[16];
#pragma unroll
            for (int c = 0; c < 16; ++c) { sv[c] = S4[(size_t)(bhp * 32 + half * 16 + c) * 512 + e4]; dv[c] = dec[bhp * 32 + half * 16 + c]; }
#pragma unroll
            for (int c = 0; c < 16; ++c) { __builtin_amdgcn_raw_buffer_store_b128(__builtin_bit_cast(v4u, hs), rs, (int)(((size_t)(bhp * 32 + half * 16 + c) * 512 + e4) * 16), 0, 16); hs = hs * dv[c] + sv[c]; } } }
    asm volatile("s_waitcnt vmcnt(0)" ::: "memory");
    __syncthreads();
    if (F.tid == 0) __hip_atomic_fetch_add(ctr, 1u, RLX_AGENT);
}
__device__ __forceinline__ void ssd_scan_wait(Frame& F, unsigned* ctr) {
    if (F.tid == 0) { unsigned sp = 0;
        while (ald(ctr) < (unsigned)F.G) { __builtin_amdgcn_s_sleep(2); if (++sp > (1u << 22)) { __hip_atomic_store(F.ctl + 1, 0x5CA0u, RLX_AGENT); break; } }
        __builtin_amdgcn_fence(__ATOMIC_ACQUIRE, "agent");
        asm volatile("s_waitcnt vmcnt(0)" ::: "memory"); }
    __syncthreads();
}
__device__ __forceinline__ void ssd_output_item(Frame& F, int l, int wgi) {
    unsigned char* const W_ = wsp(F);
    const int lane = F.lane, r32 = lane & 31, hi = lane >> 5;
    const int b = wgi >> 6, c = (wgi >> 1) & 31, g = wgi & 1, head = g * 4 + (F.wave >> 1), ph = F.wave & 1;
    const int t0 = b * SEQ + c * 128; const int item = ((b * 8 + head) * 2 + ph) * 32 + c;
    LAS float* ACS = (LAS float*)(F.lds + F.wave * 8192); LAS float* DTV = ACS + 128; LAS float* WV = ACS + 256; LAS float* EC = ACS + 384; LAS float* ST = ACS + 512;
    const float Dk = F.in[8][l * 8 + head];
    LAS unsigned char* BL = F.lds + 65536; LAS unsigned char* CL = BL + 128 * 144;
    v4u sb[2], sc2[2];
    { const bf16* src = (const bf16*)((unsigned char*)F.out + SS_BC) + (size_t)t0 * 256 + g * 64;
#pragma unroll
      for (int i = 0; i < 2; ++i) { const int pc = F.tid + 512 * i, row = pc >> 3, ch = pc & 7; sb[i] = *(const v4u*)(src + (size_t)row * 256 + ch * 8); sc2[i] = *(const v4u*)(src + (size_t)row * 256 + 128 + ch * 8); } }
    const bf16* xt = (const bf16*)((unsigned char*)F.out + SS_XT) + ((size_t)(b * 8 + head) * 64 + ph * 32 + r32) * SEQ + c * 128 + 4 * hi;
    ssd::bf16x8 xfa[4][2];
#pragma unroll
    for (int st = 0; st < 4; ++st)
#pragma unroll
        for (int k2 = 0; k2 < 2; ++k2) { const v2u lo = *(const v2u*)(xt + 32 * st + 16 * k2), hi2 = *(const v2u*)(xt + 32 * st + 16 * k2 + 8); v4u w; w.x = lo.x; w.y = lo.y; w.z = hi2.x; w.w = hi2.y; xfa[st][k2] = __builtin_bit_cast(ssd::bf16x8, w); }
    float hv[2][2][8];
    { const float* Hp = (const float*)((unsigned char*)F.out + SS_S) + (size_t)item * 2048 + lane;
#pragma unroll
      for (int nt = 0; nt < 2; ++nt)
#pragma unroll
          for (int k2 = 0; k2 < 2; ++k2)
#pragma unroll
              for (int j = 0; j < 8; ++j) hv[nt][k2][j] = Hp[(nt * 16 + 8 * k2 + j) * 64]; }
    { float dt0, dt1, cs0, cs1; ssd::chunk_scalars((const float*)(W_ + R1_DT), t0, head, F.in[6][l * 8 + head], -__expf(F.in[7][l * 8 + head]), lane, dt0, dt1, cs0, cs1);
      ACS[lane] = cs0; ACS[64 + lane] = cs1; DTV[lane] = dt0; DTV[64 + lane] = dt1; EC[lane] = __expf(cs0); EC[64 + lane] = __expf(cs1);
      const float e0 = __shfl(cs0, lane | 31), e1 = __shfl(cs1, lane | 31);
      WV[lane] = dt0 * __expf(e0 - cs0); WV[64 + lane] = dt1 * __expf(e1 - cs1); }
#pragma unroll
    for (int i = 0; i < 2; ++i) { const int pc = F.tid + 512 * i, row = pc >> 3, ch = pc & 7; *(LAS v4u*)(BL + row * 144 + ch * 16) = sb[i]; *(LAS v4u*)(CL + row * 144 + ch * 16) = sc2[i]; }
    __syncthreads();
    v4u hb[2][2];
#pragma unroll
    for (int nt = 0; nt < 2; ++nt)
#pragma unroll
        for (int k2 = 0; k2 < 2; ++k2) { hb[nt][k2].x = ssd::cvtpk(hv[nt][k2][0], hv[nt][k2][1]); hb[nt][k2].y = ssd::cvtpk(hv[nt][k2][2], hv[nt][k2][3]); hb[nt][k2].z = ssd::cvtpk(hv[nt][k2][4], hv[nt][k2][5]); hb[nt][k2].w = ssd::cvtpk(hv[nt][k2][6], hv[nt][k2][7]); }
    const bf16* zb = (const bf16*)(W_ + R1_Z); bf16* ymix = (bf16*)(W_ + R1_YMIX); float* ssq = (float*)(W_ + SS_SSQ);
#define SSD_LOAD_S(st_) \
        ssd::bf16x8 bf[4]; \
        _Pragma("unroll") for (int k = 0; k < 4; ++k) bf[k] = *(const LAS ssd::bf16x8*)(BL + (32 * (st_) + r32) * 144 + 32 * k + 16 * hi);
#define SSD_APPLY(XF0, XF1) do { \
        v4u p0, p1; p0.x = ssd::cvtpk(Tt[0], Tt[1]); p0.y = ssd::cvtpk(Tt[2], Tt[3]); p0.z = ssd::cvtpk(Tt[4], Tt[5]); p0.w = ssd::cvtpk(Tt[6], Tt[7]); \
        p1.x = ssd::cvtpk(Tt[8], Tt[9]); p1.y = ssd::cvtpk(Tt[10], Tt[11]); p1.z = ssd::cvtpk(Tt[12], Tt[13]); p1.w = ssd::cvtpk(Tt[14], Tt[15]); \
        Yt = __builtin_amdgcn_mfma_f32_32x32x16_bf16(__builtin_bit_cast(ssd::bf16x8, p0), XF0, Yt, 0, 0, 0); \
        Yt = __builtin_amdgcn_mfma_f32_32x32x16_bf16(__builtin_bit_cast(ssd::bf16x8, p1), XF1, Yt, 0, 0, 0); } while (0)
#pragma unroll 1
    for (int lt = 0; lt < 4; ++lt) {
        const int lr = lane >> 1, c0 = (lane & 1) * 16; const size_t row = (size_t)t0 + 32 * lt + lr;
        const v4u z0 = *(const v4u*)(zb + row * DI + head * 64 + ph * 32 + c0), z1 = *(const v4u*)(zb + row * DI + head * 64 + ph * 32 + c0 + 8);
        ssd::f32x16 Yt = {};
        ssd::bf16x8 cf[4];
#pragma unroll
        for (int k = 0; k < 4; ++k) cf[k] = *(const LAS ssd::bf16x8*)(CL + (32 * lt + r32) * 144 + 32 * k + 16 * hi);
        const float al = ACS[32 * lt + r32];
#pragma unroll 1
        for (int st = 0; st < lt; ++st) {
            SSD_LOAD_S(st)
            ssd::f32x16 Tt = {};
#pragma unroll
            for (int k = 0; k < 4; ++k) Tt = __builtin_amdgcn_mfma_f32_32x32x16_bf16(bf[k], cf[k], Tt, 0, 0, 0);
            const float sc = __expf(al - ACS[32 * st + 31]);
#pragma unroll
            for (int q = 0; q < 4; ++q) { const f32x4 a = *(const LAS f32x4*)(WV + 32 * st + 4 * hi + 8 * q); Tt[4 * q] *= sc * a.x; Tt[4 * q + 1] *= sc * a.y; Tt[4 * q + 2] *= sc * a.z; Tt[4 * q + 3] *= sc * a.w; }
            const ssd::bf16x8 x0 = (st == 0) ? xfa[0][0] : (st == 1) ? xfa[1][0] : xfa[2][0], x1 = (st == 0) ? xfa[0][1] : (st == 1) ? xfa[1][1] : xfa[2][1];
            SSD_APPLY(x0, x1);
        }
        {
            SSD_LOAD_S(lt)
            ssd::f32x16 Tt = {};
#pragma unroll
            for (int k = 0; k < 4; ++k) Tt = __builtin_amdgcn_mfma_f32_32x32x16_bf16(bf[k], cf[k], Tt, 0, 0, 0);
#pragma unroll
            for (int q = 0; q < 4; ++q) { const f32x4 as4 = *(const LAS f32x4*)(ACS + 32 * lt + 4 * hi + 8 * q), d4 = *(const LAS f32x4*)(DTV + 32 * lt + 4 * hi + 8 * q);
#pragma unroll
                for (int i = 0; i < 4; ++i) { const int r = 4 * q + i, sl = 4 * hi + 8 * q + i; const float f = (sl <= r32) ? __expf(al - as4[i]) * d4[i] : 0.f; Tt[r] = Tt[r] * f + ((sl == r32) ? Dk : 0.f); } }
            const ssd::bf16x8 x0 = (lt == 0) ? xfa[0][0] : (lt == 1) ? xfa[1][0] : (lt == 2) ? xfa[2][0] : xfa[3][0], x1 = (lt == 0) ? xfa[0][1] : (lt == 1) ? xfa[1][1] : (lt == 2) ? xfa[2][1] : xfa[3][1];
            SSD_APPLY(x0, x1);
        }
        { ssd::f32x16 Yo = {};
#pragma unroll
          for (int nt = 0; nt < 2; ++nt)
#pragma unroll
              for (int k2 = 0; k2 < 2; ++k2) { LAS unsigned char* cp = CL + (32 * lt + r32) * 144 + 64 * nt + 32 * k2 + 8 * hi;
                  const v2u lo = *(const LAS v2u*)cp, hi2 = *(const LAS v2u*)(cp + 16); v4u w; w.x = lo.x; w.y = lo.y; w.z = hi2.x; w.w = hi2.y;
                  Yo = __builtin_amdgcn_mfma_f32_32x32x16_bf16(__builtin_bit_cast(ssd::bf16x8, w), __builtin_bit_cast(ssd::bf16x8, hb[nt][k2]), Yo, 0, 0, 0); }
#pragma unroll
          for (int q = 0; q < 4; ++q) { const f32x4 e = *(const LAS f32x4*)(EC + 32 * lt + 4 * hi + 8 * q); Yt[4 * q] += e.x * Yo[4 * q]; Yt[4 * q + 1] += e.y * Yo[4 * q + 1]; Yt[4 * q + 2] += e.z * Yo[4 * q + 2]; Yt[4 * q + 3] += e.w * Yo[4 * q + 3]; } }
#pragma unroll
        for (int r = 0; r < 16; ++r) ST[ssd::crow(r, hi) * 36 + r32] = Yt[r];
        LDS_WAIT(); asm volatile("" ::: "memory");
        float yv[16];
#pragma unroll
        for (int q = 0; q < 4; ++q) { const f32x4 a = *(const LAS f32x4*)(ST + lr * 36 + c0 + 4 * q); yv[4 * q] = a.x; yv[4 * q + 1] = a.y; yv[4 * q + 2] = a.z; yv[4 * q + 3] = a.w; }
        const float zf[16] = {bflo(z0.x), bfhi(z0.x), bflo(z0.y), bfhi(z0.y), bflo(z0.z), bfhi(z0.z), bflo(z0.w), bfhi(z0.w), bflo(z1.x), bfhi(z1.x), bflo(z1.y), bfhi(z1.y), bflo(z1.z), bfhi(z1.z), bflo(z1.w), bfhi(z1.w)};
        float sq = 0.f;
#pragma unroll
        for (int j = 0; j < 16; ++j) { yv[j] = yv[j] * zf[j] * __builtin_amdgcn_rcpf(1.0f + __builtin_amdgcn_exp2f(-LOG2E * zf[j])); sq += yv[j] * yv[j]; }
        sq += __shfl_xor(sq, 1);
        if ((lane & 1) == 0) ssq[row * 16 + head * 2 + ph] = sq;
        v4u o0, o1; o0.x = pk2(yv[0], yv[1]); o0.y = pk2(yv[2], yv[3]); o0.z = pk2(yv[4], yv[5]); o0.w = pk2(yv[6], yv[7]); o1.x = pk2(yv[8], yv[9]); o1.y = pk2(yv[10], yv[11]); o1.z = pk2(yv[12], yv[13]); o1.w = pk2(yv[14], yv[15]);
        bf16* op = ymix + row * 1024 + head * 64 + ph * 32 + c0; *(v4u*)op = o0; *(v4u*)(op + 8) = o1;
        LDS_WAIT(); asm volatile("" ::: "memory");
    }
#undef SSD_LOAD_S
#undef SSD_APPLY
    __syncthreads();
}
__device__ __forceinline__ void phase_ssd_states(Frame& F, int l) {
    asm volatile("s_waitcnt vmcnt(0)" ::: "memory"); __syncthreads();
    ssd_states_item(F, l, 2 * F.blk); ssd_states_item(F, l, 2 * F.blk + 1); }
__device__ __forceinline__ void phase_ssd_output(Frame& F, int l) { for (int w = F.blk; w < 512; w += F.G) ssd_output_item(F, l, w); }
__device__ __forceinline__ void phase_mixer_naive(Frame& F, int l, const XcdBarrier& bar) {
    unsigned char* const W_ = wsp(F);
    const int gw = F.blk * NWAVES + F.wave;
#if SSD_NAIVE
    if ((gw & 1) == 0 && (gw >> 1) < 1024) ssd_naive_item(F, l, gw >> 1);
#else
    unsigned* sctr = F.ctl + CW_SCAN + 64 * l;
    phase_ssd_scan(F, sctr);
#endif
    const float* ksum = (const float*)(F.ctl + CW_KSUM) + (size_t)l * 65536;
#if ATTN_NAIVE
    unsigned* wq = F.ctl + CW_WQ + 64 * l;
    for (;;) { unsigned c = 0u; if (F.lane == 0) c = __hip_atomic_fetch_add(wq, 1u, RLX_AGENT); c = (unsigned)__builtin_amdgcn_readfirstlane((int)c);
        if (c >= 8192u) break;
        const int bh = (int)(c >> 7), s0 = (int)(c & 127u) * 32;
        for (int i = 0; i < 32; ++i) attn_naive_query(F, bh >> 3, bh & 7, s0 + i, ksum); }
#else
    __syncthreads();
    const attn_body::AttnTensors AT{(const attn_body::bf16*)(W_ + R1_Q), (const attn_body::bf16*)(W_ + R1_K), (const attn_body::bf16*)(W_ + R1_V), (attn_body::bf16*)(W_ + R1_YMIX), (const float*)(W_ + WS_UG), ksum};
    const attn_body::StaticOrder S(F.G, F.blk);
    if (F.blk & 1) { REPS(14) moe_convert_all(F, l); }
    REPS(3) attn_body::attn_phase<attn_body::StaticOrder>((char*)F.lds, AT, S);
    if (!(F.blk & 1)) { REPS(14) moe_convert_all(F, l); }
    ssd_scan_wait(F, sctr);
    phase_ssd_output(F, l);
#if ATTN_PROBE
    xcd_barrier(bar);
    { unsigned* wq = F.ctl + CW_WQ + 64 * l;
      for (;;) { unsigned c = 0u; if (F.lane == 0) c = __hip_atomic_fetch_add(wq, 1u, RLX_AGENT); c = (unsigned)__builtin_amdgcn_readfirstlane((int)c);
        if (c >= 8192u) break;
        const int bh = (int)(c >> 7), s0 = (int)(c & 127u) * 32;
        for (int i = 0; i < 32; ++i) attn_naive_query(F, bh >> 3, bh & 7, s0 + i, ksum); } }
#endif
#endif
}
__device__ __forceinline__ void phase_ssdnorm(Frame& F) {
    unsigned char* const W_ = wsp(F);
    const int gw = F.blk * NWAVES + F.wave, NGW = F.G * NWAVES; bf16* ymix = (bf16*)(W_ + R1_YMIX);
    for (int t = gw; t < T; t += NGW) { v4u* p = (v4u*)(ymix + (size_t)t * 1024) + F.lane; const v4u w = *p;
        float a[8] = {bflo(w.x), bfhi(w.x), bflo(w.y), bfhi(w.y), bflo(w.z), bfhi(w.z), bflo(w.w), bfhi(w.w)};
#if SSD_NAIVE
        float s = 0.f;
#pragma unroll
        for (int q = 0; q < 8; ++q) s += a[q] * a[q];
        s = wave_sum(s);
#else
        const f32x4* sp = (const f32x4*)((const float*)(W_ + SS_SSQ) + (size_t)t * 16); const f32x4 s0 = sp[0], s1 = sp[1], s2 = sp[2], s3 = sp[3];
        const float s = ((s0.x + s0.y) + (s0.z + s0.w)) + ((s1.x + s1.y) + (s1.z + s1.w)) + (((s2.x + s2.y) + (s2.z + s2.w)) + ((s3.x + s3.y) + (s3.z + s3.w)));
#endif
        const float rs = 1.0f / sqrtf(s * (1.0f / DI) + EPS);
        v4u o; o.x = pk2(a[0] * rs, a[1] * rs); o.y = pk2(a[2] * rs, a[3] * rs); o.z = pk2(a[4] * rs, a[5] * rs); o.w = pk2(a[6] * rs, a[7] * rs); *p = o; }
}
__device__ __forceinline__ void phase_router(Frame& F, int l, int cl) {
    unsigned char* const W_ = wsp(F);
    typedef short bf16x8 __attribute__((ext_vector_type(8)));
    LAS unsigned* lcnt = (LAS unsigned*)F.lds;
    if (F.tid < 32) lcnt[F.tid] = 0u;
    __syncthreads();
    const bf16* wrh = (const bf16*)(W_ + WS_WR) + (size_t)l * 64 * 1024; const bf16* wrl = wrh + DEPTH * 64 * 1024;
    const float* b1 = F.in[15] + l * 4; const float* b2 = F.in[17] + l * 32;
    unsigned* route = (unsigned*)(W_ + WS_ROUTE); float* rsb = (float*)(W_ + WS_RS);
    const int lane = F.lane, i16 = lane & 15, kq = lane >> 4;
    const int t = F.blk * 128 + F.wave * 16 + i16;
    const bf16* hrow = (const bf16*)(W_ + WS_HB) + (size_t)t * D + 8 * kq;
    constexpr int WROW = 528, WBUF = 2 * 48 * WROW;
    LAS unsigned char* wl0 = F.lds + 2048;
    v4u stg[6];
#define RT_LOAD(ch) do { _Pragma("unroll") for (int i_ = 0; i_ < 6; ++i_) { const int pc = F.tid + 512 * i_, part = pc / 1536, rr = (pc % 1536) >> 5, cc = pc & 31; \
        stg[i_] = *(const v4u*)((part ? wrl : wrh) + (size_t)rr * 1024 + (ch) * 256 + cc * 8); } } while (0)
#define RT_STORE(buf) do { _Pragma("unroll") for (int i_ = 0; i_ < 6; ++i_) { const int pc = F.tid + 512 * i_, part = pc / 1536, rr = (pc % 1536) >> 5, cc = pc & 31; \
        *(LAS v4u*)(wl0 + (buf) * WBUF + (part * 48 + rr) * WROW + cc * 16) = stg[i_]; } } while (0)
    f32x4 acc[3] = {{0.f, 0.f, 0.f, 0.f}, {0.f, 0.f, 0.f, 0.f}, {0.f, 0.f, 0.f, 0.f}}; float ss = 0.f;
    RT_LOAD(0); RT_STORE(0);
    __syncthreads();
#pragma unroll 1
    for (int ch = 0; ch < 4; ++ch) {
        v4u xw[8];
#pragma unroll
        for (int k8 = 0; k8 < 8; ++k8) xw[k8] = *(const v4u*)(hrow + ch * 256 + 32 * k8);
        if (ch < 3) RT_LOAD(ch + 1);
        const LAS unsigned char* wb = wl0 + (ch & 1) * WBUF + i16 * WROW + 16 * kq;
#pragma unroll
        for (int k8 = 0; k8 < 8; ++k8) {
            { const v4u x = xw[k8]; const float a0 = bflo(x.x), a1 = bfhi(x.x), a2 = bflo(x.y), a3 = bfhi(x.y), a4 = bflo(x.z), a5 = bfhi(x.z), a6 = bflo(x.w), a7 = bfhi(x.w); ss += ((a0 * a0 + a1 * a1) + (a2 * a2 + a3 * a3)) + ((a4 * a4 + a5 * a5) + (a6 * a6 + a7 * a7)); }
            const bf16x8 xhv = __builtin_bit_cast(bf16x8, xw[k8]);
#pragma unroll
            for (int nt = 0; nt < 3; ++nt) { const bf16x8 wh = *(const LAS bf16x8*)(wb + nt * 16 * WROW + 64 * k8), wl = *(const LAS bf16x8*)(wb + (48 + nt * 16) * WROW + 64 * k8);
                acc[nt] = __builtin_amdgcn_mfma_f32_16x16x32_bf16(wh, xhv, acc[nt], 0, 0, 0); acc[nt] = __builtin_amdgcn_mfma_f32_16x16x32_bf16(wl, xhv, acc[nt], 0, 0, 0); }
        }
        if (ch < 3) { RT_STORE((ch + 1) & 1); }
        __syncthreads();
    }
#undef RT_LOAD
#undef RT_STORE
    ss += __shfl_xor(ss, 16); ss += __shfl_xor(ss, 32);
    const float rs = 1.0f / sqrtf(ss * (1.0f / D) + EPS);
    float lg[36];
#pragma unroll
    for (int nt = 0; nt < 3; ++nt)
#pragma unroll
        for (int r = 0; r < 4; ++r) {
#pragma unroll
            for (int q = 0; q < 4; ++q) { const int c = 16 * nt + 4 * q + r; if (c < 36) { const float v = __shfl(acc[nt][r], i16 + 16 * q); lg[c] = v * rs + ((c < 4) ? b1[c & 3] : b2[(c - 4) & 31]); } } }
    const float m1 = fmaxf(fmaxf(lg[0], lg[1]), fmaxf(lg[2], lg[3]));
    const int gi = (lg[0] == m1) ? 0 : (lg[1] == m1) ? 1 : (lg[2] == m1) ? 2 : 3;
    const float se = (__expf(lg[0] - m1) + __expf(lg[1] - m1)) + (__expf(lg[2] - m1) + __expf(lg[3] - m1));
    const float gval = 1.0f / se;
    float f[8];
#pragma unroll
    for (int j = 0; j < 8; ++j) f[j] = (gi == 0) ? lg[4 + j] : (gi == 1) ? lg[12 + j] : (gi == 2) ? lg[20 + j] : lg[28 + j];
    int i0 = 0; float v0 = f[0];
#pragma unroll
    for (int j = 1; j < 8; ++j) if (f[j] > v0) { v0 = f[j]; i0 = j; }
    int i1 = 0; float v1 = -INFINITY;
#pragma unroll
    for (int j = 0; j < 8; ++j) if (j != i0 && f[j] > v1) { v1 = f[j]; i1 = j; }
    const float a1 = __expf(v1 - v0); const float g0 = gval / (1.0f + a1), g1 = gval * a1 / (1.0f + a1);
    if (kq == 0) { const unsigned e0 = (unsigned)(gi * 8 + i0), e1 = (unsigned)(gi * 8 + i1);
        const unsigned p0 = __hip_atomic_fetch_add(lcnt + e0, 1u, __ATOMIC_RELAXED, __HIP_MEMORY_SCOPE_WORKGROUP), p1 = __hip_atomic_fetch_add(lcnt + e1, 1u, __ATOMIC_RELAXED, __HIP_MEMORY_SCOPE_WORKGROUP);
        v4u r0; r0.x = e0; r0.y = e1; r0.z = p0; r0.w = p1; *(v4u*)(route + (size_t)t * 8) = r0;
        v2u r1; r1.x = __builtin_bit_cast(unsigned, g0); r1.y = __builtin_bit_cast(unsigned, g1); *(v2u*)(route + (size_t)t * 8 + 4) = r1;
        rsb[t] = rs; }
    __syncthreads();
    if (F.tid < 32) { const unsigned c = lcnt[F.tid]; const unsigned bb = __hip_atomic_fetch_add(F.ctl + CW_CNT + (cl * 32 + F.tid) * 64, c, RLX_AGENT);
        ((unsigned*)(W_ + WS_BBASE))[F.blk * 32 + F.tid] = bb; }
    __syncthreads();
    if (F.tid == 0) __hip_atomic_fetch_add(F.ctl + CW_RARR + 64 * cl, 1u, RLX_AGENT);
}
__device__ __forceinline__ void phase_gather(Frame& F, int l) {
    unsigned char* const W_ = wsp(F);
    LAS unsigned* base = (LAS unsigned*)F.lds;
    unsigned* tile_e = (unsigned*)(W_ + WS_TILEE);
    if (F.tid == 0) { unsigned sp = 0; while (ald(F.ctl + CW_RARR + 64 * l) < (unsigned)F.G) { __builtin_amdgcn_s_sleep(2); if (++sp > (1u << 22)) { __hip_atomic_store(F.ctl + 1, 0x6A70u, RLX_AGENT); break; } } }
    __syncthreads();
    if (F.tid < 32) base[96 + F.tid] = ald(F.ctl + CW_CNT + (l * 32 + F.tid) * 64);
    LDS_WAIT(); asm volatile("" ::: "memory");
    if (F.tid == 0) { unsigned acc = 0u; for (int e = 0; e < 32; ++e) { const unsigned c = base[96 + e]; base[e] = acc; acc += (c + 255u) & ~255u; } base[32] = acc >> 8; }
    __syncthreads();
    if (F.blk == 0 && F.tid < 32) { const unsigned c = base[96 + F.tid]; const unsigned nt = (c + 255u) >> 8, t0 = base[F.tid] >> 8;
        for (unsigned r = 0; r < nt; ++r) tile_e[t0 + r] = (unsigned)F.tid;
        if (F.tid == 0) tile_e[511] = base[32]; }
    unsigned* route = (unsigned*)(W_ + WS_ROUTE); const unsigned* bbase = (const unsigned*)(W_ + WS_BBASE) + F.blk * 32;
    if (F.tid >= 64 && F.tid < 96) base[64 + (F.tid - 64)] = base[F.tid - 64] + ald(bbase + (F.tid - 64));
    __syncthreads();
    bf16* xg = (bf16*)(W_ + R1_XG); const float* rsb = (const float*)(W_ + WS_RS); const bf16* hb = (const bf16*)(W_ + WS_HB); const float* g2 = F.in[13] + (size_t)l * D;
    f32x4 gv[4];
#pragma unroll
    for (int j = 0; j < 4; ++j) gv[j] = *((const f32x4*)g2 + F.lane + 64 * j);
    const int t0 = F.blk * 128 + F.wave * 16; const int tl = t0 + (F.lane & 15);
    const v4u rw = *(const v4u*)(route + (size_t)tl * 8);
    const unsigned sl0 = base[64 + rw.x] + rw.z, sl1 = base[64 + rw.y] + rw.w; const float rsl = rsb[tl];
    if (F.lane < 16) { v2u sw; sw.x = sl0; sw.y = sl1; *(v2u*)(route + (size_t)tl * 8 + 6) = sw; }
#pragma unroll 4
    for (int ti = 0; ti < 16; ++ti) { const int t = t0 + ti;
        const unsigned s0 = (unsigned)__shfl((int)sl0, ti), s1 = (unsigned)__shfl((int)sl1, ti); const float rs = __shfl(rsl, ti);
        const v2u* hr = (const v2u*)(hb + (size_t)t * D) + F.lane; v2u* d0 = (v2u*)(xg + (size_t)s0 * D) + F.lane; v2u* d1 = (v2u*)(xg + (size_t)s1 * D) + F.lane;
#pragma unroll
        for (int j = 0; j < 4; ++j) { const v2u hv = hr[64 * j]; v2u w; w.x = pk2(bflo(hv.x) * rs * gv[j].x, bfhi(hv.x) * rs * gv[j].y); w.y = pk2(bflo(hv.y) * rs * gv[j].z, bfhi(hv.y) * rs * gv[j].w); d0[64 * j] = w; d1[64 * j] = w; } }
    __syncthreads();
}
#ifndef MK_MULTI
#define MK_MULTI 0
#endif
#ifndef IN_SP2
#define IN_SP2 true
#endif
#ifndef IN_ALIGN
#define IN_ALIGN true
#endif
#ifndef GU_ALIGN
#define GU_ALIGN true
#endif
#ifndef DN_ALIGN
#define DN_ALIGN false
#endif
constexpr int PPL = 12;
constexpr int NPHASE = 1 + PPL * DEPTH;
struct Args { const float* in[21]; float* out; unsigned char* ws; int ph_lo, ph_hi; };
static_assert(sizeof(Args) == 23 * 8 + 8, "Args has no padding");

#ifndef PH_MASK
#define PH_MASK 0xffffffffu
#endif
#define PHM(j) ((PH_MASK >> (j)) & 1u)
#define IN(k) (lo <= (k) && (k) < hi)
#ifndef BAR_TWICE
#define BAR_TWICE 0
#endif
#define SEAM(k) do { if (IN(k) && IN((k) + 1)) { xcd_barrier(bar); if (BAR_TWICE) xcd_barrier(bar); } } while (0)
constexpr int CW_TAIL = 16384;
constexpr int TLE_OFF = RING_BYTES + 12288;
constexpr int RS1_OFF = RING_BYTES + 8704;
constexpr int QKG_OFF = RING_BYTES + 8192;
constexpr int RS_OFF = RING_BYTES + 4096;
template <class Sched> __device__ __forceinline__ void ssd_row_scales(Frame& F, const Sched& S, const float* ssq) {
    LAS float* rl = (LAS float*)(F.lds + RS_OFF); pg8::Unit u;
    const int ui = F.tid >> 8, r = F.tid & 255;
    if (S.next(ui, u)) { const f32x4* sp = (const f32x4*)(ssq + (size_t)(u.pm * 256 + r) * 16); f32x4 s4 = sp[0]; s4 = s4 + sp[1]; s4 = s4 + sp[2]; s4 = s4 + sp[3];
        rl[ui * 256 + r] = 1.0f / sqrtf(((s4[0] + s4[1]) + (s4[2] + s4[3])) * (1.0f / 512.0f) + EPS); }
    __syncthreads();
}
__device__ __forceinline__ int moe_tile_table(Frame& F, const unsigned* tile_e) {
    LAS unsigned* tl = (LAS unsigned*)(F.lds + TLE_OFF);
    if (F.tid < 320) tl[F.tid] = ald(tile_e + F.tid);
    if (F.tid == 511) tl[511] = ald(tile_e + 511);
    __syncthreads();
    return __builtin_amdgcn_readfirstlane((int)tl[511]);
}
template <int l> __device__ __forceinline__ void layer_program(Frame& F, const XcdBarrier& bar, const int lo, const int hi) {
        const int pb = 1 + PPL * l; unsigned char* W_ = wsp(F);
#if (REP_MASK & 2u)
        if (PHM(1) && IN(pb + 0)) { {
            pg8::Gemm g{(const bf16*)(W_ + WS_HB), (const bf16*)(W_ + WS_WIN) + (size_t)l * NIN * 1024, T, NIN, D}; pg8::StaticOrder S; S.init(T, NIN, F.G, F.blk);
            if (F.tid < 128) ((LAS float*)(F.lds + QKG_OFF))[F.tid] = (F.tid < 64) ? F.in[10][l * 64 + F.tid] : F.in[11][l * 64 + F.tid - 64];
            { LAS float* rl = (LAS float*)(F.lds + RS1_OFF); const float* rs1 = (const float*)(W_ + WS_RS1);
              for (int i = F.tid; i < 6 * 256; i += NTHREADS) { pg8::Unit u; if (S.next(i >> 8, u)) rl[i] = rs1[u.pm * 256 + (i & 255)]; } }
            __syncthreads();
            pg8::EpiInProj E{(bf16*)(W_ + R1_Z), (bf16*)(W_ + R1_XBC), (bf16*)(W_ + R1_Q), (bf16*)(W_ + R1_K), (bf16*)(W_ + R1_V), (float*)(W_ + R1_DT),
                             (float*)(F.ctl + CW_KSUM) + (size_t)l * 65536, (const LAS float*)(F.lds + QKG_OFF), C2, EPS, (const LAS float*)(F.lds + RS1_OFF), 0};
            pg8::gemm_phase<pg8::EpiInProj, pg8::StaticOrder, IN_ALIGN, IN_SP2>(F.lds, g, S, E);
        }        }
#endif
        if (PHM(1) && IN(pb + 0)) { {
            pg8::Gemm g{(const bf16*)(W_ + WS_HB), (const bf16*)(W_ + WS_WIN) + (size_t)l * NIN * 1024, T, NIN, D}; pg8::StaticOrder S; S.init(T, NIN, F.G, F.blk);
            if (F.tid < 128) ((LAS float*)(F.lds + QKG_OFF))[F.tid] = (F.tid < 64) ? F.in[10][l * 64 + F.tid] : F.in[11][l * 64 + F.tid - 64];
            { LAS float* rl = (LAS float*)(F.lds + RS1_OFF); const float* rs1 = (const float*)(W_ + WS_RS1);
              for (int i = F.tid; i < 6 * 256; i += NTHREADS) { pg8::Unit u; if (S.next(i >> 8, u)) rl[i] = rs1[u.pm * 256 + (i & 255)]; } }
            __syncthreads();
            pg8::EpiInProj E{(bf16*)(W_ + R1_Z), (bf16*)(W_ + R1_XBC), (bf16*)(W_ + R1_Q), (bf16*)(W_ + R1_K), (bf16*)(W_ + R1_V), (float*)(W_ + R1_DT),
                             (float*)(F.ctl + CW_KSUM) + (size_t)l * 65536, (const LAS float*)(F.lds + QKG_OFF), C2, EPS, (const LAS float*)(F.lds + RS1_OFF), 0};
            pg8::gemm_phase<pg8::EpiInProj, pg8::StaticOrder, IN_ALIGN, IN_SP2>(F.lds, g, S, E);
        }        } SEAM(pb + 0);
#if SSD_NAIVE
        if (PHM(2) && IN(pb + 1)) { REPS(2) phase_conv(F, l); } SEAM(pb + 1);
        SEAM(pb + 2);
        if (PHM(3) && IN(pb + 3)) { phase_mixer_naive(F, l, bar); } SEAM(pb + 3);
        SEAM(pb + 4);
#else
        if (PHM(2) && IN(pb + 1)) { phase_ssd_prep(F, l); phase_ssd_states(F, l); } SEAM(pb + 1);
        if (PHM(3) && IN(pb + 3)) { phase_mixer_naive(F, l, bar); } SEAM(pb + 3);
#endif
#if SSD_NAIVE
        if (PHM(4) && IN(pb + 5)) { REPS(4) phase_ssdnorm(F); } SEAM(pb + 5);
#endif
#ifndef OUT_ALIGN
#define OUT_ALIGN true
#endif
#ifndef PROBE_MIDK
#define PROBE_MIDK 8
#endif
#ifndef PROBE_ALIGN
#define PROBE_ALIGN true
#endif
#if (REP_MASK & 0x2000u)
        if constexpr (l == 0) {
        if (PHM(5) && IN(pb + 6)) { {
            pg8::Gemm g{(const bf16*)(W_ + R1_YMIX), (const bf16*)(W_ + WS_WOUT) + (size_t)l * 1024 * 1024, T, D, D}; pg8::StaticOrder S; S.init(T, D, F.G, F.blk);
            ssd_row_scales(F, S, (const float*)(W_ + SS_SSQ));
            if constexpr (l == 0) { pg8::EpiResidT<false, PROBE_MIDK> E{F.in[0], (bf16*)(W_ + WS_HB), D, (const LAS float*)(F.lds + RS_OFF), EPS, 0}; pg8::gemm_phase<pg8::EpiResidT<false, PROBE_MIDK>, pg8::StaticOrder, PROBE_ALIGN, true>(F.lds, g, S, E); }
            else { pg8::EpiResidT<true> E{(const bf16*)(W_ + WS_HB), (bf16*)(W_ + WS_HB), D, (const LAS float*)(F.lds + RS_OFF), EPS, 0}; pg8::gemm_phase<pg8::EpiResidT<true>, pg8::StaticOrder, OUT_ALIGN, true>(F.lds, g, S, E); }
        }        }
        }
#endif
        if (PHM(5) && IN(pb + 6)) { {
            pg8::Gemm g{(const bf16*)(W_ + R1_YMIX), (const bf16*)(W_ + WS_WOUT) + (size_t)l * 1024 * 1024, T, D, D}; pg8::StaticOrder S; S.init(T, D, F.G, F.blk);
            ssd_row_scales(F, S, (const float*)(W_ + SS_SSQ));
            if constexpr (l == 0) { pg8::EpiResidT<false> E{F.in[0], (bf16*)(W_ + WS_HB), D, (const LAS float*)(F.lds + RS_OFF), EPS, 0}; pg8::gemm_phase<pg8::EpiResidT<false>, pg8::StaticOrder, OUT_ALIGN, true>(F.lds, g, S, E); }
            else { pg8::EpiResidT<true> E{(const bf16*)(W_ + WS_HB), (bf16*)(W_ + WS_HB), D, (const LAS float*)(F.lds + RS_OFF), EPS, 0}; pg8::gemm_phase<pg8::EpiResidT<true>, pg8::StaticOrder, OUT_ALIGN, true>(F.lds, g, S, E); }
        }        } SEAM(pb + 6);
        if (PHM(6) && IN(pb + 7)) {
#if (REP_MASK & 0x40u)
            phase_router(F, l, l + 2);
#endif
            phase_router(F, l, l); phase_gather(F, l); } SEAM(pb + 7);
        if (PHM(8) && IN(pb + 9)) { REPS(8) {
            moe_tile_table(F, (const unsigned*)(W_ + WS_TILEE));
            pg8::Gemm g{(const bf16*)(W_ + R1_XG), (const bf16*)(W_ + WS_WGU) + (size_t)l * 32 * 1024 * 1024, PMAX, 32 * 1024, D};
            pg8::MoeOrder S{(const LAS unsigned*)(F.lds + TLE_OFF), 1024, F.blk}; pg8::EpiSwiGLU E{(bf16*)(W_ + R1_HMID)};
            pg8::gemm_phase<pg8::EpiSwiGLU, pg8::MoeOrder, GU_ALIGN, true>(F.lds, g, S, E);
        }        } SEAM(pb + 9);
        if (PHM(9) && IN(pb + 10)) { REPS(9) {
            const int nrt = moe_tile_table(F, (const unsigned*)(W_ + WS_TILEE));
            const int nunits = 4 * nrt, nT = (nunits - 1024 + 31) >> 5;
            unsigned* tcnt = F.ctl + CW_TAIL + l * 32 * 64;
            { pg8::Gemm g{(const bf16*)(W_ + R1_XG), (const bf16*)(W_ + WS_WGU) + (size_t)l * 32 * 1024 * 1024, PMAX, 32 * 1024, D};
              pg8::MoeTailOrder S{(const LAS unsigned*)(F.lds + TLE_OFF), nunits, F.blk}; pg8::EpiSwiGLUT<true> E{(bf16*)(W_ + R1_HMID)}; pg8::Unit tu;
              if (S.next(0, tu)) {
                  pg8::gemm_phase<pg8::EpiSwiGLUT<true>, pg8::MoeTailOrder, GU_ALIGN, true>(F.lds, g, S, E);
                  if (F.lane == 0) __hip_atomic_fetch_add(tcnt + (tu.pm - 256) * 64, 1u, RLX_AGENT); } }
            pg8::Gemm g{(const bf16*)(W_ + R1_HMID), (const bf16*)(W_ + WS_WD) + (size_t)l * 32 * 1024 * 512, PMAX, 32 * 1024, HID};
            pg8::MoeDownOrder S{(const LAS unsigned*)(F.lds + TLE_OFF), nunits, F.blk, nT, tcnt, F.ctl + 1}; pg8::EpiDown E{(bf16*)(W_ + R1_XG)};
            pg8::gemm_phase<pg8::EpiDown, pg8::MoeDownOrder, DN_ALIGN, true>(F.lds, g, S, E);
        }        } SEAM(pb + 10);
        if (PHM(10) && IN(pb + 11)) {
#if (REP_MASK & 0x400u)
            if constexpr (l == 0) phase_combine<true>(F, l + 1);
#endif
            phase_combine<false>(F, l + 1); } SEAM(pb + 11);
}
__global__ void __launch_bounds__(NTHREADS, 2) hymba_fwd(Args args) {
    extern __shared__ __attribute__((aligned(16))) unsigned char lds[];
    Frame F;
    F.lds = (LAS unsigned char*)lds; F.MISC = (volatile LAS unsigned*)(F.lds + MISC_OFF);
    F.tid = threadIdx.x; F.lane = F.tid & 63; F.wave = __builtin_amdgcn_readfirstlane(F.tid >> 6); F.G = gridDim.x; F.blk = blockIdx.x;
    F.ws = args.ws; F.ctl = (unsigned*)(args.ws + WS_CTL); F.out = args.out;
    F.in = (const float* const*)__builtin_amdgcn_kernarg_segment_ptr();
    for (int u = F.tid; u < (LDS_BYTES - RING_BYTES) / 4; u += NTHREADS) ((LAS unsigned*)(F.lds + RING_BYTES))[u] = 0u;
    __syncthreads();
    const int lo = args.ph_lo, hi = args.ph_hi;
    XcdBarrier bar; bar.bar = F.ctl + CW_BAR; bar.x = 0; bar.st = nullptr;
    if (hi - lo > 1) bar = xcd_barrier_post(F.ctl + CW_BAR, F.MISC + 8);

    if (PHM(0) && IN(0)) { REPS(0) phase_prologue(F); } SEAM(0);

    layer_program<0>(F, bar, lo, hi);
    layer_program<1>(F, bar, lo, hi);
#undef IN
#undef SEAM
}

extern "C" void kernel_launch(void* const* d_in, const int* in_sizes, int n_in, void* d_out, int out_size, void* d_ws, size_t ws_size, hipStream_t stream) {
    static int ready = 0;
    if (ready == 0) {
        if (n_in != 21 || out_size != T * D || ws_size < WS_END) { fprintf(stderr, "kernel_launch: unexpected shapes (n_in %d out %d ws %zu need %zu)\n", n_in, out_size, ws_size, (size_t)WS_END); ready = -1; return; }
        if (hipFuncSetAttribute((const void*)hymba_fwd, hipFuncAttributeMaxDynamicSharedMemorySize, LDS_BYTES) != hipSuccess) { fprintf(stderr, "kernel_launch: hipFuncSetAttribute failed\n"); ready = -1; return; }
        int per_cu = 0;
        if (hipOccupancyMaxActiveBlocksPerMultiprocessor(&per_cu, (const void*)hymba_fwd, NTHREADS, LDS_BYTES) != hipSuccess || per_cu < 1) fprintf(stderr, "kernel_launch: note: occupancy query says %d\n", per_cu);
        (void)hipGetLastError();
        ready = 1;
    }
    if (ready < 0) return;
    (void)hipMemsetAsync((char*)d_ws + WS_CTL, 0, CTL_ZERO_BYTES, stream);
    Args a{};
    for (int i = 0; i < 21; ++i) a.in[i] = (const float*)d_in[i];
    a.out = (float*)d_out; a.ws = (unsigned char*)d_ws;
#if MK_MULTI
    for (int p = 0; p < NPHASE; ++p) { a.ph_lo = p; a.ph_hi = p + 1; hipLaunchKernelGGL(hymba_fwd, dim3(GRID), dim3(NTHREADS), LDS_BYTES, stream, a); }
#else
    a.ph_lo = 0; a.ph_hi = NPHASE; hipLaunchKernelGGL(hymba_fwd, dim3(GRID), dim3(NTHREADS), LDS_BYTES, stream, a);
#endif
}
```

```cpp
#include <hip/hip_runtime.h>
#include <cstdio>
#include <cstdint>
#include <hip/hip_bf16.h>
#include <cmath>
namespace pg8 {
#define PG8_LAS __attribute__((address_space(3)))
typedef unsigned short bf16_t;
typedef short bf16x8 __attribute__((ext_vector_type(8)));
typedef float f32x4 __attribute__((ext_vector_type(4)));
typedef unsigned u32x4 __attribute__((ext_vector_type(4)));
constexpr int BM = 256, BK = 64, HALF = 128, HTB = HALF * BK * 2  , STAGE_BYTES = 8 * HTB, NXCD = 8, WGM = 8;

__host__ __device__ __forceinline__ int lds_byte(int r, int c) { const int st = (r >> 4) * 2 + (c >> 5), rr = r & 15, cc = c & 31, ob = rr * 64 + cc * 2; return st * 1024 + (ob ^ (((ob >> 9) & 1) << 5)); }
__host__ __device__ __forceinline__ void stage_rc(int b, int& R, int& C) { const int st = b / 1024, sb = b % 1024, swz = sb ^ (((sb >> 9) & 1) << 5); R = (st >> 1) * 16 + swz / 64; C = (st & 1) * 32 + (swz % 64) / 2; }
__host__ __device__ __forceinline__ int perm32(int rho) { const int n = rho >> 4, i = rho & 15; return 8 * (i >> 2) + 4 * n + (i & 3); }

struct Unit { int pm, pn; };
struct Gemm { const bf16_t* A; const bf16_t* Bt; int M, N, K; };

struct StaticOrder {
    int nM, nN, nwg, G, c;
    __host__ __device__ void init(int M, int N, int G_, int c_) { nM = M / BM; nN = N / BM; nwg = nM * nN; G = G_; c = c_; }
    __host__ __device__ bool next(int i, Unit& u) const {
        const long L = (long)i * G + c; if (L >= nwg) return false;
        int wgid = (int)L; { const int q = nwg / NXCD, r = nwg % NXCD, xcd = wgid % NXCD, off = wgid / NXCD; wgid = (xcd < r ? xcd * (q + 1) : r * (q + 1) + (xcd - r) * q) + off; }
        const int nig = WGM * nN, gid = wgid / nig, fm = gid * WGM, gsz = (nM - fm) < WGM ? (nM - fm) : WGM;
        u.pm = fm + ((wgid % nig) % gsz); u.pn = (wgid % nig) / gsz; return true;
    }
    static constexpr bool GATHER = false;
    __device__ __forceinline__ int row_of(const Unit&, int) const { return 0; }
    __device__ __forceinline__ void a_ready(const Unit&) const {}
    __device__ __forceinline__ void done(const Unit&) const {}
};

__device__ __forceinline__ unsigned cvt_pk_bf16(float lo, float hi) { unsigned r; asm volatile("v_cvt_pk_bf16_f32 %0, %1, %2" : "=v"(r) : "v"(lo), "v"(hi)); return r; }
typedef float f32x2 __attribute__((ext_vector_type(2)));
#ifndef EPI_SC1
#define EPI_SC1 0
#endif
__device__ __forceinline__ float silu_f(float x) { return x * __builtin_amdgcn_rcpf(1.0f + __builtin_amdgcn_exp2f(-1.4426950408889634f * x)); }

struct EpiInProj {
    static constexpr bool PERM = true, AFTER_DRAIN = false; static constexpr int MIDK = 0, XK = 0;
    bf16_t* z; bf16_t* xbc; bf16_t* q; bf16_t* k; bf16_t* v; float* dt; float* ksum;
    const PG8_LAS float* qkg; float qscale; float eps;
    const PG8_LAS float* rsl; mutable int ucount;
    __device__ __forceinline__ void operator()(const f32x4 (&acc)[2][2][4][2], const Unit& u, int wr, int wc, int fr, int fq) const {
        const int pn = u.pn; const int row0 = u.pm * BM + wr * 64 + fr;
        const PG8_LAS float* rp = rsl + ucount * 256 + wr * 64 + fr; ++ucount;
        if (pn <= 4 || pn == 9 || pn == 10) {
            bf16_t* base; int ldc, colt;
            if (pn <= 1) { base = z; ldc = 512; colt = pn * 256; } else if (pn <= 4) { base = xbc; ldc = 768; colt = (pn - 2) * 256; } else { base = v; ldc = 512; colt = (pn - 9) * 256; }
            const int col0 = colt + wc * 32 + 8 * fq;
#pragma unroll
            for (int ai = 0; ai < 2; ++ai)
#pragma unroll
                for (int m = 0; m < 4; ++m) { bf16_t* rowp = base + (size_t)(row0 + ai * HALF + m * 16) * ldc + col0; const float rv = rp[ai * HALF + m * 16];
#pragma unroll
                    for (int bj = 0; bj < 2; ++bj) { const f32x4 v0 = acc[ai][bj][m][0] * rv, v1 = acc[ai][bj][m][1] * rv;
                        u32x4 w; w.x = cvt_pk_bf16(v0[0], v0[1]); w.y = cvt_pk_bf16(v0[2], v0[3]); w.z = cvt_pk_bf16(v1[0], v1[1]); w.w = cvt_pk_bf16(v1[2], v1[3]);
                        *(u32x4*)(rowp + bj * HALF) = w; } }
        } else if (pn <= 8) {
            const bool isk = (pn >= 7); const int hh = 4 * ((pn - 5) & 1) + wc;
            const PG8_LAS float* g = qkg + (isk ? 64 : 0) + 8 * fq; bf16_t* base = isk ? k : q; const float sc = isk ? 1.0f : qscale;
            f32x4 cs[2][2];
#pragma unroll
            for (int bj = 0; bj < 2; ++bj)
#pragma unroll
                for (int n = 0; n < 2; ++n) cs[bj][n] = (f32x4){0.f, 0.f, 0.f, 0.f};
#pragma unroll
            for (int ai = 0; ai < 2; ++ai)
#pragma unroll
                for (int m = 0; m < 4; ++m) {
                    float ss = 0.f;
#pragma unroll
                    for (int bj = 0; bj < 2; ++bj)
#pragma unroll
                        for (int n = 0; n < 2; ++n) { const f32x4 x = acc[ai][bj][m][n]; ss += (x[0] * x[0] + x[1] * x[1]) + (x[2] * x[2] + x[3] * x[3]); }
                    ss += __shfl_xor(ss, 16); ss += __shfl_xor(ss, 32);
                    const float rv = rp[ai * HALF + m * 16]; const float rs = sc * rv / sqrtf(ss * rv * rv * (1.0f / 64.0f) + eps);
                    bf16_t* rowp = base + (size_t)(row0 + ai * HALF + m * 16) * 512 + hh * 64 + 8 * fq;
#pragma unroll
                    for (int bj = 0; bj < 2; ++bj) { const f32x4 g0 = *(const PG8_LAS f32x4*)(g + 32 * bj), g1 = *(const PG8_LAS f32x4*)(g + 32 * bj + 4);
                        const f32x4 v0 = acc[ai][bj][m][0] * rs * g0, v1 = acc[ai][bj][m][1] * rs * g1;
                        if (isk) { cs[bj][0] += v0; cs[bj][1] += v1; }
                        u32x4 w; w.x = cvt_pk_bf16(v0[0], v0[1]); w.y = cvt_pk_bf16(v0[2], v0[3]); w.z = cvt_pk_bf16(v1[0], v1[1]); w.w = cvt_pk_bf16(v1[2], v1[3]);
                        *(u32x4*)(rowp + bj * 32) = w; }
                    asm volatile("" : "+v"(cs[0][0]), "+v"(cs[0][1]), "+v"(cs[1][0]), "+v"(cs[1][1]) :: "memory");
                }
            if (isk) {
                float* kb = ksum + ((size_t)(u.pm >> 4) * 8 + hh) * 16 * 64 + (size_t)(u.pm & 15) * 64;
#pragma unroll
                for (int bj = 0; bj < 2; ++bj)
#pragma unroll
                    for (int n = 0; n < 2; ++n)
#pragma unroll
                        for (int j = 0; j < 4; ++j) { float s = cs[bj][n][j];
                            s += __shfl_xor(s, 1); s += __shfl_xor(s, 2); s += __shfl_xor(s, 4); s += __shfl_xor(s, 8);
                            if (fr == 0) atomicAdd(kb + 32 * bj + 8 * fq + 4 * n + j, s); }
            }
        } else {
            if (wc == 0 && fq == 0) {
#pragma unroll
                for (int ai = 0; ai < 2; ++ai)
#pragma unroll
                    for (int m = 0; m < 4; ++m) { float* rowp = dt + (size_t)(row0 + ai * HALF + m * 16) * 8; const float rv = rp[ai * HALF + m * 16];
                        *(f32x4*)(rowp) = acc[ai][0][m][0] * rv; *(f32x4*)(rowp + 4) = acc[ai][0][m][1] * rv; }
            }
        }
    }
};

template <bool RES_BF16, int MIDK_ = 8> struct EpiResidT {
    static constexpr bool PERM = true, AFTER_DRAIN = false; static constexpr int MIDK = MIDK_, XK = 0;
    const void* resid; bf16_t* out; int ldc; const PG8_LAS float* rsl; float eps;
    mutable int ucount;
    __device__ __forceinline__ void midk(f32x4 (&acc)[2][2][4][2], const Unit& u, int wr, int wc, int fr, int fq) const {
        const PG8_LAS float* rp = rsl + (ucount & 1) * 256 + wr * 64 + fr;
#pragma unroll
        for (int ai = 0; ai < 2; ++ai)
#pragma unroll
            for (int m = 0; m < 4; ++m) { const float rs = rp[ai * HALF + m * 16];
#pragma unroll
                for (int bj = 0; bj < 2; ++bj)
#pragma unroll
                    for (int n = 0; n < 2; ++n) acc[ai][bj][m][n] = acc[ai][bj][m][n] * rs; }
        ++ucount;
    }
    __device__ __forceinline__ void operator()(const f32x4 (&acc)[2][2][4][2], const Unit& u, int wr, int wc, int fr, int fq) const {
        const int row0 = u.pm * BM + wr * 64 + fr, col0 = u.pn * BM + wc * 32 + 8 * fq;
#pragma unroll
        for (int ai = 0; ai < 2; ++ai)
#pragma unroll
            for (int m = 0; m < 4; ++m) { const size_t off = (size_t)(row0 + ai * HALF + m * 16) * ldc + col0;
#pragma unroll
                for (int bj = 0; bj < 2; ++bj) { f32x4 r0, r1;
                    if constexpr (RES_BF16) { const u32x4 w = *(const u32x4*)((const bf16_t*)resid + off + bj * HALF);
                        r0[0] = __builtin_bit_cast(float, w.x << 16); r0[1] = __builtin_bit_cast(float, w.x & 0xffff0000u); r0[2] = __builtin_bit_cast(float, w.y << 16); r0[3] = __builtin_bit_cast(float, w.y & 0xffff0000u);
                        r1[0] = __builtin_bit_cast(float, w.z << 16); r1[1] = __builtin_bit_cast(float, w.z & 0xffff0000u); r1[2] = __builtin_bit_cast(float, w.w << 16); r1[3] = __builtin_bit_cast(float, w.w & 0xffff0000u); }
                    else { r0 = *(const f32x4*)((const float*)resid + off + bj * HALF); r1 = *(const f32x4*)((const float*)resid + off + bj * HALF + 4); }
                    const f32x4 v0 = acc[ai][bj][m][0] + r0, v1 = acc[ai][bj][m][1] + r1;
                    u32x4 o; o.x = cvt_pk_bf16(v0[0], v0[1]); o.y = cvt_pk_bf16(v0[2], v0[3]); o.z = cvt_pk_bf16(v1[0], v1[1]); o.w = cvt_pk_bf16(v1[2], v1[3]); *(u32x4*)(out + off + bj * HALF) = o; } }
    }
};

template <int MIDK_ = 8> struct EpiResidX {
    static constexpr bool PERM = true, AFTER_DRAIN = false; static constexpr int MIDK = MIDK_, XK = 4;
    const bf16_t* xa; const bf16_t* xb; bf16_t* out; int ldc; const PG8_LAS float* rsl;
    mutable int ucount;
    __device__ __forceinline__ void midk(f32x4 (&acc)[2][2][4][2], const Unit& u, int wr, int wc, int fr, int fq) const {
        const PG8_LAS float* rp = rsl + (ucount & 1) * 256 + wr * 64 + fr;
#pragma unroll
        for (int ai = 0; ai < 2; ++ai)
#pragma unroll
            for (int m = 0; m < 4; ++m) { const float rs = rp[ai * HALF + m * 16];
#pragma unroll
                for (int bj = 0; bj < 2; ++bj)
#pragma unroll
                    for (int n = 0; n < 2; ++n) acc[ai][bj][m][n] = acc[ai][bj][m][n] * rs; }
        ++ucount;
    }
    __device__ __forceinline__ void operator()(const f32x4 (&acc)[2][2][4][2], const Unit& u, int wr, int wc, int fr, int fq) const {
        const int row0 = u.pm * BM + wr * 64 + fr, col0 = u.pn * BM + wc * 32 + 8 * fq;
#pragma unroll
        for (int ai = 0; ai < 2; ++ai)
#pragma unroll
            for (int m = 0; m < 4; ++m) { bf16_t* rowp = out + (size_t)(row0 + ai * HALF + m * 16) * ldc + col0;
#pragma unroll
                for (int bj = 0; bj < 2; ++bj) { const f32x4 v0 = acc[ai][bj][m][0], v1 = acc[ai][bj][m][1];
                    u32x4 o; o.x = cvt_pk_bf16(v0[0], v0[1]); o.y = cvt_pk_bf16(v0[2], v0[3]); o.z = cvt_pk_bf16(v1[0], v1[1]); o.w = cvt_pk_bf16(v1[2], v1[3]); *(u32x4*)(rowp + bj * HALF) = o; } }
    }
};

template <bool SC1> struct EpiSwiGLUT {
    static constexpr bool PERM = true, AFTER_DRAIN = false; static constexpr int MIDK = 0, XK = 0;
    bf16_t* hmid;
    __device__ __forceinline__ void operator()(const f32x4 (&acc)[2][2][4][2], const Unit& u, int wr, int wc, int fr, int fq) const {
        const int row0 = u.pm * BM + wr * 64 + fr, col0 = (u.pn & 3) * 128 + wc * 32 + 8 * fq;
#pragma unroll
        for (int ai = 0; ai < 2; ++ai)
#pragma unroll
            for (int m = 0; m < 4; ++m) { const size_t ro = (size_t)(row0 + ai * HALF + m * 16) * 512 + col0;
                const f32x4 g0 = acc[ai][0][m][0], g1 = acc[ai][0][m][1], u0 = acc[ai][1][m][0], u1 = acc[ai][1][m][1];
                float r[8];
#pragma unroll
                for (int j = 0; j < 4; ++j) { r[j] = silu_f(g0[j]) * u0[j]; r[4 + j] = silu_f(g1[j]) * u1[j]; }
                u32x4 w; w.x = cvt_pk_bf16(r[0], r[1]); w.y = cvt_pk_bf16(r[2], r[3]); w.z = cvt_pk_bf16(r[4], r[5]); w.w = cvt_pk_bf16(r[6], r[7]);
                if constexpr (SC1) __builtin_amdgcn_raw_buffer_store_b128(w, __builtin_amdgcn_make_buffer_rsrc((void*)hmid, 0, 0x7fffffff, 0x00020000), (int)(ro * 2), 0, 16);
                else *(u32x4*)(hmid + ro) = w; }
    }
};
typedef EpiSwiGLUT<false> EpiSwiGLU;

struct EpiDown {
    static constexpr bool PERM = true, AFTER_DRAIN = false; static constexpr int MIDK = 0, XK = 0;
    bf16_t* y;
    __device__ __forceinline__ void operator()(const f32x4 (&acc)[2][2][4][2], const Unit& u, int wr, int wc, int fr, int fq) const {
        const int row0 = u.pm * BM + wr * 64 + fr, col0 = (u.pn & 3) * BM + wc * 32 + 8 * fq;
#if EPI_SC1
        const __amdgpu_buffer_rsrc_t rs = __builtin_amdgcn_make_buffer_rsrc((void*)y, 0, 0x7fffffff, 0x00020000);
#endif
#pragma unroll
        for (int ai = 0; ai < 2; ++ai)
#pragma unroll
            for (int m = 0; m < 4; ++m) { const size_t ro = (size_t)(row0 + ai * HALF + m * 16) * 1024 + col0;
#pragma unroll
                for (int bj = 0; bj < 2; ++bj) { const f32x4 v0 = acc[ai][bj][m][0], v1 = acc[ai][bj][m][1];
                    u32x4 w; w.x = cvt_pk_bf16(v0[0], v0[1]); w.y = cvt_pk_bf16(v0[2], v0[3]); w.z = cvt_pk_bf16(v1[0], v1[1]); w.w = cvt_pk_bf16(v1[2], v1[3]);
#if EPI_SC1
                    __builtin_amdgcn_raw_buffer_store_b128(w, rs, (int)((ro + bj * HALF) * 2), 0, 16);
#else
                    *(u32x4*)(y + ro + bj * HALF) = w;
#endif
                } }
    }
};

struct MoeOrder {
    static constexpr bool GATHER = false;
    __device__ __forceinline__ int row_of(const Unit&, int) const { return 0; }
    const PG8_LAS unsigned* tile_e; int nunits, c;
    __device__ __forceinline__ bool next(int i, Unit& u) const {
        const int L = (i * 8 + (c & 7)) * 32 + (c >> 3); if (L >= nunits) return false;
        const int rt = L >> 2; const int e = __builtin_amdgcn_readfirstlane((int)tile_e[rt]);
        u.pm = rt; u.pn = e * 4 + (L & 3); return true;
    }
    __device__ __forceinline__ void a_ready(const Unit&) const {}
    __device__ __forceinline__ void done(const Unit&) const {}
};
struct MoeTailOrder {
    static constexpr bool GATHER = false;
    __device__ __forceinline__ int row_of(const Unit&, int) const { return 0; }
    const PG8_LAS unsigned* tile_e; int nunits, c;
    __device__ __forceinline__ bool next(int i, Unit& u) const {
        const int L = 1024 + (c & 7) * 32 + (c >> 3); if (i > 0 || L >= nunits) return false;
        const int rt = L >> 2; const int e = __builtin_amdgcn_readfirstlane((int)tile_e[rt]);
        u.pm = rt; u.pn = e * 4 + (L & 3); return true;
    }
    __device__ __forceinline__ void a_ready(const Unit&) const {}
    __device__ __forceinline__ void done(const Unit&) const {}
};
struct MoeDownOrder {
    static constexpr bool GATHER = false;
    __device__ __forceinline__ int row_of(const Unit&, int) const { return 0; }
    const PG8_LAS unsigned* tile_e; int nunits, c, nT; const unsigned* tailcnt; unsigned* tmo;
    __device__ __forceinline__ bool next(int i, Unit& u) const {
        const int x = c & 7; int chunk;
        if (x < nT) chunk = 2 * (8 - nT) + i * 8 + x;
        else chunk = (i < 2) ? i * (8 - nT) + (x - nT) : 2 * (8 - nT) + (i - 2) * 8 + x;
        const int L = chunk * 32 + (c >> 3); if (L >= nunits) return false;
        const int rt = L >> 2; const int e = __builtin_amdgcn_readfirstlane((int)tile_e[rt]);
        u.pm = rt; u.pn = e * 4 + (L & 3); return true;
    }
    __device__ __forceinline__ void a_ready(const Unit& u) const {
        if (u.pm >= 256) {
            if (threadIdx.x < 64) { const unsigned* w = tailcnt + (size_t)(u.pm - 256) * 64; unsigned sp = 0;
                while ((unsigned)__builtin_amdgcn_readfirstlane(__hip_atomic_load(w, __ATOMIC_RELAXED, __HIP_MEMORY_SCOPE_AGENT)) < 32u) {
                    __builtin_amdgcn_s_sleep(2); if (++sp > (1u << 22)) { if (threadIdx.x == 0) __hip_atomic_store(tmo, 0x7A11u, __ATOMIC_RELAXED, __HIP_MEMORY_SCOPE_AGENT); break; } }
                __builtin_amdgcn_fence(__ATOMIC_ACQUIRE, "agent");
                asm volatile("s_waitcnt vmcnt(0)" ::: "memory"); }
            asm volatile("" ::: "memory"); __builtin_amdgcn_s_barrier(); asm volatile("" ::: "memory");
        }
    }
    __device__ __forceinline__ void done(const Unit&) const {}
};
template <class Epi, class Sched, bool ALIGN_EPI = false, bool SP2 = false>
__device__ __forceinline__ void gemm_phase(PG8_LAS unsigned char* lds, const Gemm g, const Sched& S, const Epi& E) {
    const int tid = threadIdx.x, wid = __builtin_amdgcn_readfirstlane(tid >> 6), lane = tid & 63, wr = wid >> 2, wc = wid & 3, fr = lane & 15, fq = lane >> 4;
    constexpr int XK = Epi::XK;
    const int K = g.K, nt = K / BK, ntx = nt + XK;
    unsigned voffA[2], voffB[2];
#pragma unroll
    for (int i = 0; i < 2; ++i) { int R, C; stage_rc(tid * 16 + i * 8192, R, C); const int Rb = Epi::PERM ? ((R & ~31) + perm32(R & 31)) : R;
        voffA[i] = (unsigned)(R * K + C) * 2u; voffB[i] = (unsigned)(Rb * K + C) * 2u; }
    constexpr bool GATH = Sched::GATHER;
    unsigned coff[2][2], noff[2][2];
#define PG8_GOFF(dst, unit) do { _Pragma("unroll") for (int _i = 0; _i < 2; ++_i) { int R_, C_; stage_rc(tid * 16 + _i * 8192, R_, C_); \
        _Pragma("unroll") for (int _h = 0; _h < 2; ++_h) dst[_h][_i] = (unsigned)(S.row_of(unit, _h * HALF + R_) * K + C_) * 2u; } } while (0)
    const size_t kstep = (size_t)(BK * 2);
    const size_t hstep = (size_t)HALF * K * 2;
    const size_t tstep = 2 * hstep;
    const unsigned ldsw = (unsigned)wid * 1024u;
    const int aoff = lds_byte(wr * 64 + fr, fq * 8), boff = lds_byte(wc * 32 + fr, fq * 8);
#define PG8_SA(b, h) (((b) * 2 + (h)) * HTB)
#define PG8_SB(b, h) ((4 + (b) * 2 + (h)) * HTB)
#define PG8_STAGE(bufoff, gbase, voff) do { _Pragma("unroll") for (int _i = 0; _i < 2; ++_i) \
        __builtin_amdgcn_global_load_lds((const unsigned*)((const char*)(gbase) + (voff)[_i]), (PG8_LAS unsigned*)(lds + (bufoff) + ldsw + _i * 8192), 16, 0, 0); } while (0)
#define PG8_STAGE_AC(b, h, base) do { if constexpr (GATH) { PG8_STAGE(PG8_SA(b, h), base, coff[h]); } else { PG8_STAGE(PG8_SA(b, h), (base) + (h) * hstep, voffA); } } while (0)
#define PG8_STAGE_AX(b, h, base) do { if constexpr (GATH) { const unsigned so_[2] = {last ? noff[h][0] : coff[h][0], last ? noff[h][1] : coff[h][1]}; PG8_STAGE(PG8_SA(b, h), base, so_); } else { PG8_STAGE(PG8_SA(b, h), (base) + (h) * hstep, voffA); } } while (0)
#define PG8_LDA(dst, b, h) do { _Pragma("unroll") for (int m = 0; m < 4; ++m) _Pragma("unroll") for (int k = 0; k < 2; ++k) dst[m][k] = *(const PG8_LAS bf16x8*)(lds + PG8_SA(b, h) + aoff + m * 2048 + k * 1024); } while (0)
#define PG8_LDB(dst, b, h) do { _Pragma("unroll") for (int n = 0; n < 2; ++n) _Pragma("unroll") for (int k = 0; k < 2; ++k) dst[n][k] = *(const PG8_LAS bf16x8*)(lds + PG8_SB(b, h) + boff + n * 2048 + k * 1024); } while (0)
#define PG8_MMA(ai, bj, At, Bt) do { __builtin_amdgcn_s_setprio(1); _Pragma("unroll") for (int m = 0; m < 4; ++m) _Pragma("unroll") for (int n = 0; n < 2; ++n) _Pragma("unroll") for (int k = 0; k < 2; ++k) \
        acc[ai][bj][m][n] = __builtin_amdgcn_mfma_f32_16x16x32_bf16(Bt[n][k], At[m][k], acc[ai][bj][m][n], 0, 0, 0); __builtin_amdgcn_s_setprio(0); } while (0)
#define PG8_WAIT_V(n) asm volatile("s_waitcnt vmcnt(" #n ")" ::: "memory")
#define PG8_WAIT_L(n) asm volatile("s_waitcnt lgkmcnt(" #n ")" ::: "memory")
#define PG8_BAR __builtin_amdgcn_s_barrier()
#define PG8_SCHED __builtin_amdgcn_sched_barrier(0)
    Unit cur, nxt; int ui = 0;
    if (!S.next(0, cur)) return;
    f32x4 acc[2][2][4][2];
#pragma unroll
    for (int a = 0; a < 2; ++a)
#pragma unroll
        for (int b = 0; b < 2; ++b)
#pragma unroll
            for (int m = 0; m < 4; ++m)
#pragma unroll
                for (int n = 0; n < 2; ++n) acc[a][b][m][n] = (f32x4){0.f, 0.f, 0.f, 0.f};
    bf16x8 At[4][2], B0[2][2], B1[2][2];
    const char* cA = (const char*)g.A + (GATH ? (size_t)0 : (size_t)cur.pm * tstep); const char* cB = (const char*)g.Bt + (size_t)cur.pn * tstep;
    if constexpr (GATH) { PG8_GOFF(coff, cur); _Pragma("unroll") for (int _h = 0; _h < 2; ++_h) { noff[_h][0] = coff[_h][0]; noff[_h][1] = coff[_h][1]; } }
    S.a_ready(cur);
    if constexpr (SP2) {
        PG8_STAGE(PG8_SB(0, 0), cB, voffB); PG8_STAGE(PG8_SB(0, 1), cB + hstep, voffB); PG8_STAGE_AC(0, 0, cA); PG8_STAGE_AC(0, 1, cA);
        if (wr == 1) PG8_BAR;
        PG8_WAIT_V(2); PG8_BAR;
        PG8_STAGE(PG8_SB(1, 0), cB + kstep, voffB); PG8_STAGE_AC(1, 0, cA + kstep); PG8_STAGE(PG8_SB(1, 1), cB + hstep + kstep, voffB);
        PG8_WAIT_V(6); PG8_BAR;
    } else {
        PG8_STAGE(PG8_SB(0, 0), cB, voffB); PG8_STAGE_AC(0, 0, cA); PG8_STAGE(PG8_SB(0, 1), cB + hstep, voffB); PG8_STAGE_AC(0, 1, cA);
        if (wr == 1) PG8_BAR;
        PG8_WAIT_V(4); PG8_BAR;
        PG8_STAGE(PG8_SB(1, 0), cB + kstep, voffB); PG8_STAGE_AC(1, 0, cA + kstep); PG8_STAGE(PG8_SB(1, 1), cB + hstep + kstep, voffB);
        PG8_WAIT_V(6); PG8_BAR;
    }
    for (;;) {
        const bool has_next = S.next(ui + 1, nxt);
        if constexpr (GATH) { if (has_next) PG8_GOFF(noff, nxt); }
        const char* nA = (has_next && !GATH) ? (const char*)g.A + (size_t)nxt.pm * tstep : cA; const char* nB = has_next ? (const char*)g.Bt + (size_t)nxt.pn * tstep : cB;
        const char* xA = cA; const char* xB = cB;
        if constexpr (XK > 0) { xA = (const char*)E.xa + (size_t)cur.pm * tstep + (size_t)cur.pn * (BM * 2) - (size_t)nt * kstep; xB = (const char*)E.xb - (size_t)nt * kstep; }
        for (int t = 0; t < ntx; t += 2) {
            const bool last = (t == ntx - 2);
            const bool ext1 = XK > 0 && (t + 1 >= nt), ext2 = XK > 0 && (t + 2 >= nt);
            const char* a1 = (ext1 ? xA : cA) + (size_t)(t + 1) * kstep;
            const char* a2 = last ? nA : (ext2 ? xA : cA) + (size_t)(t + 2) * kstep; const char* b2 = last ? nB : (ext2 ? xB : cB) + (size_t)(t + 2) * kstep;
            const char* a3 = a2 + kstep; const char* b3 = b2 + kstep;
            if (last && has_next) S.a_ready(nxt);
            if constexpr (SP2) {
            PG8_LDB(B0, 0, 0); PG8_LDB(B1, 0, 1); PG8_SCHED; PG8_LDA(At, 0, 0); PG8_STAGE_AC(1, 1, a1);
            PG8_WAIT_V(8); PG8_WAIT_L(0); PG8_BAR; PG8_MMA(0, 0, At, B0); PG8_MMA(0, 1, At, B1); PG8_BAR; PG8_SCHED;
            PG8_LDA(At, 0, 1); PG8_STAGE(PG8_SB(0, 0), b2, voffB); PG8_STAGE(PG8_SB(0, 1), b2 + hstep, voffB); PG8_STAGE_AX(0, 0, a2);
            PG8_WAIT_V(8); PG8_WAIT_L(0); PG8_BAR; PG8_MMA(1, 0, At, B0); PG8_MMA(1, 1, At, B1); PG8_BAR; PG8_SCHED;
            PG8_LDB(B0, 1, 0); PG8_LDB(B1, 1, 1); PG8_SCHED; PG8_LDA(At, 1, 0); PG8_STAGE_AX(0, 1, a2);
            PG8_WAIT_V(8); PG8_WAIT_L(0); PG8_BAR; PG8_MMA(0, 0, At, B0); PG8_MMA(0, 1, At, B1); PG8_BAR; PG8_SCHED;
            PG8_LDA(At, 1, 1); PG8_STAGE(PG8_SB(1, 0), b3, voffB); PG8_STAGE(PG8_SB(1, 1), b3 + hstep, voffB); PG8_STAGE_AX(1, 0, a3);
            PG8_WAIT_V(8); PG8_WAIT_L(0); PG8_BAR; PG8_MMA(1, 0, At, B0); PG8_MMA(1, 1, At, B1); PG8_BAR; PG8_SCHED;
            } else {
            PG8_LDB(B0, 0, 0); PG8_SCHED; PG8_LDA(At, 0, 0); PG8_STAGE_AC(1, 1, a1);
            PG8_WAIT_L(8); PG8_BAR; PG8_WAIT_L(0); PG8_MMA(0, 0, At, B0); PG8_BAR; PG8_SCHED;
            PG8_LDB(B1, 0, 1); PG8_STAGE(PG8_SB(0, 0), b2, voffB);
            PG8_BAR; PG8_WAIT_L(0); PG8_MMA(0, 1, At, B1); PG8_BAR;
            PG8_LDA(At, 0, 1); PG8_STAGE_AX(0, 0, a2);
            PG8_BAR; PG8_WAIT_L(0); PG8_MMA(1, 0, At, B0); PG8_BAR; PG8_SCHED;
            PG8_STAGE(PG8_SB(0, 1), b2 + hstep, voffB);
            PG8_WAIT_V(6); PG8_BAR; PG8_MMA(1, 1, At, B1); PG8_BAR;
            PG8_LDB(B0, 1, 0); PG8_SCHED; PG8_LDA(At, 1, 0); PG8_STAGE_AX(0, 1, a2);
            PG8_WAIT_L(8); PG8_BAR; PG8_WAIT_L(0); PG8_MMA(0, 0, At, B0); PG8_BAR; PG8_SCHED;
            PG8_LDB(B1, 1, 1); PG8_STAGE(PG8_SB(1, 0), b3, voffB);
            PG8_BAR; PG8_WAIT_L(0); PG8_MMA(0, 1, At, B1); PG8_BAR;
            PG8_LDA(At, 1, 1); PG8_STAGE_AX(1, 0, a3);
            PG8_BAR; PG8_WAIT_L(0); PG8_MMA(1, 0, At, B0); PG8_BAR; PG8_SCHED;
            PG8_STAGE(PG8_SB(1, 1), b3 + hstep, voffB);
            PG8_WAIT_V(6); PG8_BAR; PG8_MMA(1, 1, At, B1); PG8_BAR;
            }
            if constexpr (Epi::MIDK > 0) { if (t + 2 == Epi::MIDK) E.midk(acc, cur, wr, wc, fr, fq); }
        }
        if constexpr (ALIGN_EPI) { if (wr == 0) PG8_BAR; }
        if constexpr (!Epi::AFTER_DRAIN) { E(acc, cur, wr, wc, fr, fq); S.done(cur); }
        if (!has_next) break;
#pragma unroll
        for (int a = 0; a < 2; ++a)
#pragma unroll
            for (int b = 0; b < 2; ++b)
#pragma unroll
                for (int m = 0; m < 4; ++m)
#pragma unroll
                    for (int n = 0; n < 2; ++n) acc[a][b][m][n] = (f32x4){0.f, 0.f, 0.f, 0.f};
        cur = nxt; cA = nA; cB = nB; ++ui;
        if constexpr (GATH) { _Pragma("unroll") for (int _h = 0; _h < 2; ++_h) { coff[_h][0] = noff[_h][0]; coff[_h][1] = noff[_h][1]; } }
        if constexpr (ALIGN_EPI) { if (wr == 1) PG8_BAR; }
    }
    PG8_WAIT_V(0);
    if constexpr (!ALIGN_EPI) { if (wr == 0) PG8_BAR; }
    PG8_BAR;
    if constexpr (Epi::AFTER_DRAIN) { E.fused(acc, cur, wr, wc, fr, fq, lds, wid, lane); S.done(cur); }
#undef PG8_SA
#undef PG8_SB
#undef PG8_STAGE
#undef PG8_STAGE_AC
#undef PG8_STAGE_AX
#undef PG8_GOFF
#undef PG8_LDA
#undef PG8_LDB
#undef PG8_MMA
#undef PG8_WAIT_V
#undef PG8_WAIT_L
#undef PG8_BAR
#undef PG8_SCHED
}
}
constexpr int NWAVES = 8, NTHREADS = 512;
constexpr int NB = 8, SEQ = 4096, T = NB * SEQ, D = 1024, DEPTH = 2;
constexpr int NH = 8, HD = 64, DI = 512, CCH = 768, NIN = 3072, INCOLS = 2824;
constexpr int NE = 32, HID = 512, PMAX = 2 * T + NE * 256;
constexpr int MB = 256, NMB = SEQ / MB;
constexpr float EPS = 1e-6f, LOG2E = 1.4426950408889634f, C2 = 0.125f * LOG2E;
constexpr int GRID = 256;

constexpr size_t MiB = 1u << 20;
constexpr size_t WS_CTL = 0, CTL_ZERO_BYTES = 1 * MiB;
constexpr size_t WS_WIN = 1 * MiB;
constexpr size_t WS_WOUT = 13 * MiB;
constexpr size_t WS_WGU = 17 * MiB;
constexpr size_t WS_WD = 145 * MiB;
constexpr size_t WS_WR = 209 * MiB;
constexpr size_t WS_TB = WS_WR + 512 * 1024;
constexpr size_t WS_UG = WS_TB + 8192;
constexpr size_t WS_ROUTE = 210 * MiB;
constexpr size_t WS_GSLOT = 211 * MiB;
constexpr size_t WS_BBASE = WS_GSLOT + 512 * 1024;
constexpr size_t WS_TILEE = WS_BBASE + 64 * 1024;
constexpr size_t WS_RS1 = WS_TILEE + 4096 + 131072;
constexpr size_t WS_RS = WS_TILEE + 4096;
constexpr size_t WS_XN = 212 * MiB;
constexpr size_t WS_HB = WS_XN;
constexpr size_t SO_XN = 0;
constexpr size_t WS_R1 = 276 * MiB;
constexpr size_t R1_Z = WS_R1, R1_XBC = WS_R1 + 32 * MiB, R1_Q = WS_R1 + 80 * MiB, R1_K = WS_R1 + 112 * MiB, R1_V = WS_R1 + 144 * MiB, R1_YMIX = WS_R1 + 176 * MiB, R1_DT = WS_R1 + 240 * MiB;
constexpr size_t R1_XG = WS_R1, R1_HMID = WS_R1 + 144 * MiB;
constexpr size_t SS_XT = 0;
constexpr size_t SS_BT = 32 * MiB;
constexpr size_t SS_BC = 40 * MiB;
constexpr size_t SS_SSQ = WS_R1 + 242 * MiB;
constexpr size_t SS_DEC = WS_R1 + 244 * MiB;
constexpr size_t SS_S = 64 * MiB;
constexpr size_t WS_IDN = WS_R1 + 244 * MiB + 64 * 1024;
constexpr size_t WS_RSSLOT = WS_R1 + 241 * MiB;
constexpr size_t WS_END = WS_R1 + 245 * MiB;
static_assert((size_t)PMAX * 2048 <= 144 * MiB && (size_t)PMAX * 1024 <= 72 * MiB && R1_HMID + 72 * MiB <= WS_END, "R1 map");
constexpr int CW_BAR = 4096;
constexpr int CW_CNT = 8192;
constexpr int CW_KSUM = 65536;
static_assert((CW_KSUM + 2 * 65536) * 4 <= (int)CTL_ZERO_BYTES && CW_CNT + 64 * 64 <= CW_KSUM, "CTL map");

constexpr int RING_BYTES = 131072, MISC_OFF = RING_BYTES + 320, LDS_BYTES = 147456;

#define GAS __attribute__((address_space(1)))
#define LAS __attribute__((address_space(3)))
typedef unsigned short bf16;
typedef unsigned v4u __attribute__((ext_vector_type(4)));
typedef unsigned v2u __attribute__((ext_vector_type(2)));
typedef float f32x4 __attribute__((ext_vector_type(4)));
typedef GAS unsigned gu32;
#define RLX_AGENT __ATOMIC_RELAXED, __HIP_MEMORY_SCOPE_AGENT
#define LDS_WAIT() asm volatile("s_waitcnt lgkmcnt(0)" ::: "memory")
__device__ __forceinline__ unsigned f2bf(float f) { unsigned u = __builtin_bit_cast(unsigned, f); return (u + 0x7fffu + ((u >> 16) & 1u)) >> 16; }
__device__ __forceinline__ unsigned pk2(float lo, float hi) { return f2bf(lo) | (f2bf(hi) << 16); }
__device__ __forceinline__ float bflo(unsigned w) { return __builtin_bit_cast(float, w << 16); }
__device__ __forceinline__ float bfhi(unsigned w) { return __builtin_bit_cast(float, w & 0xffff0000u); }
__device__ __forceinline__ float bf1(bf16 b) { return __builtin_bit_cast(float, (unsigned)b << 16); }
__device__ __forceinline__ unsigned ald(const unsigned* p) { return __hip_atomic_load(p, __ATOMIC_RELAXED, __HIP_MEMORY_SCOPE_AGENT); }

#define XB_TMO      128
#define XB_XCNT(j)  (256  + 64 * (j))
#define XB_XSUB(j)  (1280 + 64 * (j))
#define XB_XGEN(j)  (2304 + 64 * (j))
#define XB_TOP      3328
#define XB_TOPGEN   3392
#define XCD_BAR_WORDS 3456
#define XB_SPIN_CAP (1u << 18)

__device__ __forceinline__ unsigned xb_ld(unsigned* p)              { return __hip_atomic_load(p, __ATOMIC_RELAXED, __HIP_MEMORY_SCOPE_AGENT); }
__device__ __forceinline__ unsigned xb_add(unsigned* p, unsigned v) { return __hip_atomic_fetch_add(p, v, __ATOMIC_RELAXED, __HIP_MEMORY_SCOPE_AGENT); }
__device__ __forceinline__ unsigned xb_xcc_id() { return (unsigned)__builtin_amdgcn_s_getreg((3 << 11) | 20) & 0xFu; }
#define XB_SPIN(cond, bar) do { unsigned _sp = 0; while (cond) { __builtin_amdgcn_s_sleep(1); \
    if ((++_sp & 255u) == 0u) { if (xb_ld(&(bar)[XB_TMO])) break; if (_sp > XB_SPIN_CAP) { atomicAdd(&(bar)[XB_TMO], 1u); break; } } } } while (0)

struct XcdBarrier {
    unsigned* bar; unsigned x;
    volatile LAS unsigned* st;
};

__device__ __forceinline__ XcdBarrier xcd_barrier_post(unsigned* bar, volatile LAS unsigned* st) {
    XcdBarrier b; b.bar = bar; b.x = xb_xcc_id(); b.st = st;
    if (threadIdx.x == 0) (void)xb_add(&bar[XB_XCNT(b.x)], 1u);
    return b;
}
__device__ __forceinline__ void xcd_barrier_complete(unsigned* bar, unsigned x, unsigned& nloc, unsigned& nx) {
    const unsigned G = gridDim.x * gridDim.y * gridDim.z;
    unsigned sum, cnt, mine, sp = 0u;
    for (;;) {
        sum = 0u; cnt = 0u; mine = 0u;
#pragma unroll
        for (unsigned j = 0; j < 16; ++j) { const unsigned c = xb_ld(&bar[XB_XCNT(j)]); sum += c; cnt += (c > 0u) ? 1u : 0u; mine = (j == x) ? c : mine; }
        if (sum == G) break;
        __builtin_amdgcn_s_sleep(1);
        if ((++sp & 255u) == 0u) { if (xb_ld(&bar[XB_TMO])) break; if (sp > XB_SPIN_CAP) { atomicAdd(&bar[XB_TMO], 1u); break; } }
    }
    nloc = mine > 0u ? mine : 1u; nx = cnt > 0u ? cnt : 1u;
}

__device__ __forceinline__ void xcd_barrier(const XcdBarrier& b) {
    asm volatile("s_waitcnt vmcnt(0)" ::: "memory");
    __syncthreads();
    if (threadIdx.x == 0) {
        unsigned* bar = b.bar;
        __builtin_amdgcn_s_waitcnt(0);
        unsigned nloc = b.st[0], nx = b.st[1];
        if (nloc == 0u) { xcd_barrier_complete(bar, b.x, nloc, nx); b.st[0] = nloc; b.st[1] = nx; }
        const unsigned old = xb_add(&bar[XB_XSUB(b.x)], 1u);
        const unsigned gen = old / nloc;
        if (old + 1u == (gen + 1u) * nloc) {
            __builtin_amdgcn_fence(__ATOMIC_RELEASE, "agent");
            asm volatile("s_waitcnt vmcnt(0)" ::: "memory");
            const unsigned og = xb_add(&bar[XB_TOP], 1u);
            const unsigned tg = og / nx;
            if (og + 1u == (tg + 1u) * nx) xb_add(&bar[XB_TOPGEN], 1u);
            else XB_SPIN(xb_ld(&bar[XB_TOPGEN]) == tg, bar);
            __builtin_amdgcn_fence(__ATOMIC_ACQUIRE, "agent");
            xb_add(&bar[XB_XGEN(b.x)], 1u);
            asm volatile("s_waitcnt vmcnt(0)" ::: "memory");
        } else {
            XB_SPIN(xb_ld(&bar[XB_XGEN(b.x)]) == gen, bar);
            __builtin_amdgcn_fence(__ATOMIC_ACQUIRE, "agent");
            asm volatile("s_waitcnt vmcnt(0)" ::: "memory");
        }
    }
    __syncthreads();
}
namespace attn_body {
using bf16=__hip_bfloat16;
using bf16x8=__attribute__((ext_vector_type(8)))short;
using s16x4=__attribute__((ext_vector_type(4)))short;
using f32x16=__attribute__((ext_vector_type(16)))float;
using u32x4=__attribute__((ext_vector_type(4)))unsigned;
constexpr int BATCH=8,NHEAD=8,SEQ=4096,D=64,DM=NHEAD*D,OPITCH=1024,OCOL0=512;
constexpr int NW=8,QBLK=32,QB=QBLK*NW,KVBLK=64,NQB=SEQ/QB;
constexpr float MBIG=256.f;
constexpr int ATTN_PITCH=DM, ATTN_UNIT_ROWS=QB;
__device__ __forceinline__ int crow(int r,int hi){return (r&3)+8*(r>>2)+4*hi;}
#define SBAR() __builtin_amdgcn_sched_barrier(0)
typedef __attribute__((address_space(3))) const float* lds_fptr;
__device__ __forceinline__ void biasadd(f32x16&p0,f32x16&p1,lds_fptr ub){
  #pragma unroll
  for(int r=0;r<16;++r){const int o=(r&3)+8*(r>>2); p0[r]+=ub[o]; p1[r]+=ub[o+32];}
}

constexpr int NSLOT=3, SLOTB=8192;
constexpr int LDS_K=0, LDS_V=NSLOT*SLOTB, LDS_WS=2*NSLOT*SLOTB, LDS_OST=LDS_WS+NW*64*4, LDS_U=LDS_OST+NW*4096, LDS_KS=LDS_U+768*4, LDS_SM=LDS_KS+16*64*4, LDS_BYTES=LDS_SM+NW*64*4;
constexpr float C2=0.125f*1.4426950408889634f;
__device__ __forceinline__ void glds16(const void*gsrc,unsigned lds_dst){unsigned keep;
  asm volatile("s_mov_b32 %0, m0\n\ts_mov_b32 m0, %2\n\ts_nop 0\n\tglobal_load_lds_dwordx4 %1, off\n\ts_mov_b32 m0, %0":"=&s"(keep):"v"(gsrc),"s"(lds_dst):"memory");}
__device__ __forceinline__ float max3f(float a,float b,float c){float r;asm("v_max3_f32 %0, %1, %2, %3":"=v"(r):"v"(a),"v"(b),"v"(c));return r;}
__device__ __forceinline__ float max2f(float a,float b){float r;asm("v_max_f32_e32 %0, %1, %2":"=v"(r):"v"(a),"v"(b));return r;}
__device__ __forceinline__ float fadd_s(float a,float b){float r;asm("v_add_f32_e32 %0, %1, %2":"=v"(r):"v"(a),"v"(b));return r;}
__device__ __forceinline__ float fsub_s(float a,float b){float r;asm("v_sub_f32_e32 %0, %1, %2":"=v"(r):"v"(a),"v"(b));return r;}
typedef float f32x2_t __attribute__((ext_vector_type(2))); typedef __bf16 bf16x2_t __attribute__((ext_vector_type(2)));
__device__ __forceinline__ unsigned cvtpk_s(float lo,float hi){f32x2_t v={lo,hi};bf16x2_t b=__builtin_convertvector(v,bf16x2_t);return __builtin_bit_cast(unsigned,b);}
#define WAIT_BAR(N) asm volatile("s_waitcnt vmcnt(" #N ") lgkmcnt(0)\n\ts_barrier":::"memory")

__device__ __forceinline__ void qkt(f32x16&p0,f32x16&p1,const char*Kslot,const bf16x8*qr,const f32x16&negm,int r32,int hi){
  const char*kb=Kslot+hi*1024+r32*16;
  #pragma unroll
  for(int d0=0;d0<4;++d0){
    const bf16x8 b0=*reinterpret_cast<const bf16x8*>(kb+d0*2048);
    const bf16x8 b1=*reinterpret_cast<const bf16x8*>(kb+d0*2048+512);
    if(d0==0){p0=__builtin_amdgcn_mfma_f32_32x32x16_bf16(b0,qr[0],negm,0,0,0);p1=__builtin_amdgcn_mfma_f32_32x32x16_bf16(b1,qr[0],negm,0,0,0);}
    else{p0=__builtin_amdgcn_mfma_f32_32x32x16_bf16(b0,qr[d0],p0,0,0,0);p1=__builtin_amdgcn_mfma_f32_32x32x16_bf16(b1,qr[d0],p1,0,0,0);}}
}
typedef __attribute__((address_space(3))) const char* lds_cptr;
typedef short v4i16_t __attribute__((ext_vector_type(4)));
__device__ __forceinline__ void kload8(bf16x8*kf,lds_cptr kp){
  kf[0]=*(const __attribute__((address_space(3))) bf16x8*)(kp);      kf[1]=*(const __attribute__((address_space(3))) bf16x8*)(kp+512);
  kf[2]=*(const __attribute__((address_space(3))) bf16x8*)(kp+2048); kf[3]=*(const __attribute__((address_space(3))) bf16x8*)(kp+2560);
  kf[4]=*(const __attribute__((address_space(3))) bf16x8*)(kp+4096); kf[5]=*(const __attribute__((address_space(3))) bf16x8*)(kp+4608);
  kf[6]=*(const __attribute__((address_space(3))) bf16x8*)(kp+6144); kf[7]=*(const __attribute__((address_space(3))) bf16x8*)(kp+6656);
}
__device__ __forceinline__ void kload2(bf16x8*kf,lds_cptr kp,int j){ kf[2*j]=*(const __attribute__((address_space(3))) bf16x8*)(kp+j*2048); kf[2*j+1]=*(const __attribute__((address_space(3))) bf16x8*)(kp+j*2048+512); }
__device__ __forceinline__ s16x4 vtr(lds_cptr p){ return __builtin_bit_cast(s16x4,__builtin_amdgcn_ds_read_tr16_b64_v4i16((__attribute__((address_space(3))) v4i16_t*)p)); }
__device__ __forceinline__ float rowmax(const f32x16&p0,const f32x16&p1){
  float a=max3f(p0[0],p0[1],p1[0]),b=max3f(p0[2],p0[3],p1[1]);a=max3f(a,p1[2],p1[3]);
  #pragma unroll
  for(int r=4;r<16;r+=4){a=max3f(a,p0[r],p0[r+1]);b=max3f(b,p0[r+2],p0[r+3]);a=max3f(a,p1[r],p1[r+1]);b=max3f(b,p1[r+2],p1[r+3]);}
  const float m=max2f(a,b);
  auto rr=__builtin_amdgcn_permlane32_swap(__float_as_uint(m),__float_as_uint(m),false,false);
  return max2f(__uint_as_float(rr[0]),__uint_as_float(rr[1]));
}
__device__ __forceinline__ void pv(f32x16*o,int vb,bf16x8 pa0,bf16x8 pa1,bf16x8 pa2,bf16x8 pa3){
  #pragma unroll
  for(int d0=0;d0<2;++d0){s16x4 lo[4],hi[4];
    #pragma unroll
    for(int ks=0;ks<4;++ks){
      asm volatile("ds_read_b64_tr_b16 %0,%1 offset:%c2":"=&v"(lo[ks]):"v"(vb),"i"(d0*4096+ks*1024):"memory");
      asm volatile("ds_read_b64_tr_b16 %0,%1 offset:%c2":"=&v"(hi[ks]):"v"(vb),"i"(d0*4096+ks*1024+512):"memory");}
    asm volatile("s_waitcnt lgkmcnt(0)":::"memory");SBAR();
    #define PK(k) (bf16x8){lo[k][0],lo[k][1],lo[k][2],lo[k][3],hi[k][0],hi[k][1],hi[k][2],hi[k][3]}
    o[d0]=__builtin_amdgcn_mfma_f32_32x32x16_bf16(pa0,PK(0),o[d0],0,0,0);
    o[d0]=__builtin_amdgcn_mfma_f32_32x32x16_bf16(pa1,PK(1),o[d0],0,0,0);
    o[d0]=__builtin_amdgcn_mfma_f32_32x32x16_bf16(pa2,PK(2),o[d0],0,0,0);
    o[d0]=__builtin_amdgcn_mfma_f32_32x32x16_bf16(pa3,PK(3),o[d0],0,0,0);
    #undef PK
  }
}

#ifndef ATTN_STORE16
#define ATTN_STORE16(p,v) (*(u32x4*)(p)=(v))
#endif
template<int THRL> __device__ __forceinline__ void attn_unit(int b,int h,int qb,const bf16*Q,const bf16*K,const bf16*V,bf16*O,const float*UG,const float*KSUM,char*shm){
  const int tid=threadIdx.x,lane=tid&63,r32=lane&31,hi=lane>>5; const int wid=__builtin_amdgcn_readfirstlane(tid>>6);
  const long rowbase=(long)b*SEQ; const int q0=qb*QB;
  const bf16*Qw=Q+(rowbase+q0+wid*QBLK)*DM+h*D;
  const bf16*Kh=K+rowbase*DM+h*D,*Vh=V+rowbase*DM+h*D;
  const unsigned lds0=(unsigned)(uintptr_t)shm;
  float*wsf=(float*)(shm+LDS_WS)+wid*64;
  const bf16*ksrc=Kh+(long)lane*DM+wid*8;
  const bf16*vsrc=Vh+(long)(16*(wid&3)+(lane>>2))*DM+(wid>>2)*32+(lane&3)*8;
  const unsigned kdst=lds0+LDS_K+wid*1024, vdst=lds0+LDS_V+wid*1024;
  #define DMA_K(t,slot) glds16(ksrc+(long)(t)*KVBLK*DM,(unsigned)__builtin_amdgcn_readfirstlane(kdst+(slot)))
  #define DMA_V(t,slot) glds16(vsrc+(long)(t)*KVBLK*DM,(unsigned)__builtin_amdgcn_readfirstlane(vdst+(slot)))
  const int vb0=(int)(lds0+LDS_V)+((lane>>4)&1)*32+(lane&3)*8+(4*hi+((lane&15)>>2))*64;
  const char*Kbase=shm+LDS_K; bf16x8 kf[8];
  const lds_cptr shm3=(lds_cptr)shm; const lds_cptr kp0=shm3+LDS_K+hi*1024+r32*16; const lds_cptr vp0=shm3+LDS_V+((lane>>4)&1)*32+(lane&3)*8+(4*hi+((lane&15)>>2))*64;
  const int NT=(q0+QB)/KVBLK;
  const float*ugp=UG+(long)h*768; const float*ksp=KSUM+((long)b*NHEAD+h)*1024;
  const float tu0=ugp[tid], tu1=(tid<256)?ugp[512+tid]:0.f, tk0=ksp[tid], tk1=ksp[512+tid];
  DMA_K(0,0);DMA_V(0,0);DMA_K(1,SLOTB);
  bf16x8 qr[4];
  #pragma unroll
  for(int d0=0;d0<4;++d0)qr[d0]=*reinterpret_cast<const bf16x8*>(&Qw[(long)r32*DM+d0*16+hi*8]);
  float mhat=0.f,l_reg=0.f;f32x16 o[2];o[0]=f32x16{};o[1]=f32x16{};f32x16 negm=f32x16{};
  const int qrel=wid*QBLK+r32;
  { float*Ul=(float*)(shm+LDS_U),*KSl=(float*)(shm+LDS_KS); Ul[tid]=tu0; if(tid<256)Ul[512+tid]=tu1; KSl[tid]=tk0; KSl[512+tid]=tk1; }
  typedef __attribute__((address_space(3))) unsigned* lds_uptr;
  #define LANEID() ((int)__builtin_amdgcn_mbcnt_hi(~0u,__builtin_amdgcn_mbcnt_lo(~0u,0u)))
  #define SMP() ((lds_uptr)((lds_cptr)shm+LDS_SM+wid*256)+LANEID())
  #define CMASK(P0,P1,t) do{int jb_=(t)-(NT-8); if(jb_>=0){ const int l_=LANEID(); biasadd(P0,P1,(lds_fptr)((lds_cptr)shm+LDS_U)+(4*(l_>>5)-(wid*QBLK+(l_&31))+255+64*jb_)); } }while(0)
  #define SETBLK(n_) do{ const int n__=(n_); float cb_=((*SMP()>>n__)&1u)?0.f:-MBIG; if(n__<qb-1)cb_+=*(lds_fptr)((lds_cptr)shm+LDS_U); cb_-=mhat; _Pragma("unroll") for(int r=0;r<16;++r)negm[r]=cb_; asm volatile("":"+v"(negm)); }while(0)
  bool resc=false;
  #define START(P0,P1) do{ const float rm=rowmax(P0,P1); resc=false; \
    { const float dl=rm; mhat=fadd_s(mhat,dl); \
      _Pragma("unroll") for(int r=0;r<16;++r){P0[r]=fsub_s(P0[r],dl);P1[r]=fsub_s(P1[r],dl);} \
      _Pragma("unroll") for(int r=0;r<16;++r)negm[r]-=dl; asm volatile("":"+v"(negm)); } \
    _Pragma("unroll") for(int r=0;r<16;++r)P0[r]=__builtin_amdgcn_exp2f(P0[r]); }while(0)
  #define RESC() do{ if(resc){ asm volatile("s_waitcnt lgkmcnt(0)":::"memory"); \
      _Pragma("unroll") for(int d_=0;d_<2;++d_) _Pragma("unroll") for(int r=0;r<16;++r)o[d_][r]*=wsf[crow(r,hi)]; } }while(0)
  f32x16 pA0,pA1,pB0,pB1;
  int sl_prev=0,sl_cur=0,sl_next=SLOTB;
  #define ROT() do{sl_prev=sl_cur;sl_cur=sl_next;sl_next=(sl_next==(NSLOT-1)*SLOTB)?0:sl_next+SLOTB;}while(0)
  DMA_K(2,2*SLOTB);
  WAIT_BAR(3);
  { unsigned selmask; if(qb<=3) selmask=(1u<<qb)-1u; else {
      float qv[32];
      _Pragma("unroll") for(int d0=0;d0<4;++d0) _Pragma("unroll") for(int j=0;j<8;++j) qv[8*d0+j]=__uint_as_float(((unsigned)(unsigned short)qr[d0][j])<<16);
      float v1=-INFINITY,v2=-INFINITY,v3=-INFINITY; int i1=0,i2=0,i3=0;
      const lds_fptr ksl=(lds_fptr)((lds_cptr)shm+LDS_KS)+8*hi;
      for(int n=0;n<qb;++n){ float a=0.f;
        _Pragma("unroll") for(int d0=0;d0<4;++d0) _Pragma("unroll") for(int j=0;j<8;++j) a+=qv[8*d0+j]*ksl[n*64+16*d0+j];
        { auto rr=__builtin_amdgcn_permlane32_swap(__float_as_uint(a),__float_as_uint(a),false,false); a=__uint_as_float(rr[0])+__uint_as_float(rr[1]); }
        if(a>v1){v3=v2;i3=i2;v2=v1;i2=i1;v1=a;i1=n;} else if(a>v2){v3=v2;i3=i2;v2=a;i2=n;} else if(a>v3){v3=a;i3=n;} }
      selmask=(1u<<i1)|(1u<<i2)|(1u<<i3); }
    selmask|=1u<<qb; *SMP()=selmask; }
  SETBLK(0);
  qkt(pA0,pA1,Kbase,qr,negm,r32,hi);asm volatile("s_nop 15\n\ts_nop 7":"+v"(pA0),"+v"(pA1));CMASK(pA0,pA1,0);
  START(pA0,pA1);
  _Pragma("unroll") for(int r=0;r<16;++r)pA1[r]=__builtin_amdgcn_exp2f(pA1[r]);
  WAIT_BAR(0);
  DMA_K(3,0);DMA_V(1,SLOTB);
  ROT();
  kload8(kf,kp0+sl_cur);
  WAIT_BAR(2);
  s16x4 vlo[8],vhi[8]; u32x4 pw0,pw1,pw2,pw3;
  #define PKW(P,B) cvtpk_s(P[B],P[B+1])
  #define PAF(k) __builtin_bit_cast(bf16x8,pw##k)
  #define VFR(i) (bf16x8){vlo[i][0],vlo[i][1],vlo[i][2],vlo[i][3],vhi[i][0],vhi[i][1],vhi[i][2],vhi[i][3]}
  #define PIN(x) asm volatile("":"+v"(x))
  #define MX3(a,b,c) __builtin_fmaxf(__builtin_fmaxf((a),(b)),(c))
  #define GAPA(MF,A0,A1,A2,A3,W0,W1,PW) do{ MF; sacc+=A0; sacc+=A1; sacc+=A2; sacc+=A3; PIN(sacc); W0; W1; PIN(PW); SBAR(); }while(0)
  #define EX(v) __builtin_amdgcn_exp2f(v)
  #define GAPB(MF,X,B) do{ MF; X[B]=EX(X[B]); X[B+1]=EX(X[B+1]); X[B+2]=EX(X[B+2]); X[B+3]=EX(X[B+3]); PIN(X); SBAR(); }while(0)
  #define VRD(i) do{ vlo[i]=vtr(vp_+(((i)>>2)*4096+((i)&3)*1024)); vhi[i]=vtr(vp_+(((i)>>2)*4096+((i)&3)*1024+512)); }while(0)
  #define KRD(G,j) do{ if(G){ kload2(kf,kp0+sl_next,j); SBAR(); } }while(0)
  #define STEP(C0,C1,P0,P1,t,GK,GV,GL) do{ if((((t))&3)==0){SETBLK((t)>>2);} SBAR(); \
    const lds_cptr vp_=vp0+sl_prev; \
    VRD(0); SBAR(); float sacc=(P0[0]+P0[1]); \
    GAPA(C0=__builtin_amdgcn_mfma_f32_32x32x16_bf16(kf[0],qr[0],negm,0,0,0), P0[2],P0[3],P0[4],P0[5],     pw0[0]=PKW(P0,0), pw0[1]=PKW(P0,2), pw0); \
    VRD(4); SBAR(); GAPA(C1=__builtin_amdgcn_mfma_f32_32x32x16_bf16(kf[1],qr[0],negm,0,0,0), P0[6],P0[7],P0[8],P0[9],     pw0[2]=PKW(P0,4), pw0[3]=PKW(P0,6), pw0); \
    VRD(1); SBAR(); GAPA(C0=__builtin_amdgcn_mfma_f32_32x32x16_bf16(kf[2],qr[1],C0,0,0,0),   P0[10],P0[11],P0[12],P0[13], pw1[0]=PKW(P0,8), pw1[1]=PKW(P0,10), pw1); \
    VRD(5); SBAR(); GAPA(C1=__builtin_amdgcn_mfma_f32_32x32x16_bf16(kf[3],qr[1],C1,0,0,0),   P0[14],P0[15],P1[0],P1[1],   pw1[2]=PKW(P0,12),pw1[3]=PKW(P0,14), pw1); \
    VRD(2); SBAR(); GAPA(C0=__builtin_amdgcn_mfma_f32_32x32x16_bf16(kf[4],qr[2],C0,0,0,0),   P1[2],P1[3],P1[4],P1[5],     pw2[0]=PKW(P1,0), pw2[1]=PKW(P1,2), pw2); \
    VRD(6); SBAR(); GAPA(C1=__builtin_amdgcn_mfma_f32_32x32x16_bf16(kf[5],qr[2],C1,0,0,0),   P1[6],P1[7],P1[8],P1[9],     pw2[2]=PKW(P1,4), pw2[3]=PKW(P1,6), pw2); \
    VRD(3); SBAR(); GAPA(C0=__builtin_amdgcn_mfma_f32_32x32x16_bf16(kf[6],qr[3],C0,0,0,0),   P1[10],P1[11],P1[12],P1[13], pw3[0]=PKW(P1,8), pw3[1]=PKW(P1,10), pw3); \
    VRD(7); SBAR(); GAPA(C1=__builtin_amdgcn_mfma_f32_32x32x16_bf16(kf[7],qr[3],C1,0,0,0),   P1[14],P1[15],0.f,0.f,       pw3[2]=PKW(P1,12),pw3[3]=PKW(P1,14), pw3); \
    l_reg+=sacc; \
    if(GK){DMA_K((t)+3,sl_cur);} if(GV){DMA_V((t)+1,sl_next);} \
    CMASK(C0,C1,t); \
    { float a=MX3(C0[0],C0[1],C1[0]),b=MX3(C0[2],C0[3],C1[1]); a=MX3(a,C1[2],C1[3]); \
      _Pragma("unroll") for(int r=4;r<16;r+=4){a=MX3(a,C0[r],C0[r+1]);b=MX3(b,C0[r+2],C0[r+3]);a=MX3(a,C1[r],C1[r+1]);b=MX3(b,C1[r+2],C1[r+3]);} \
      float rm=__builtin_fmaxf(a,b); { auto rr=__builtin_amdgcn_permlane32_swap(__float_as_uint(rm),__float_as_uint(rm),false,false); rm=__builtin_fmaxf(__uint_as_float(rr[0]),__uint_as_float(rr[1])); } \
      resc=false; \
      if(__builtin_expect(__any(rm>(float)THRL),0)){ const float dl=__builtin_fmaxf(rm,0.f); mhat+=dl; \
        _Pragma("unroll") for(int r=0;r<16;++r){C0[r]-=dl;C1[r]-=dl;} \
        _Pragma("unroll") for(int r=0;r<16;++r)negm[r]-=dl; asm volatile("":"+v"(negm)); \
        const float f=__builtin_amdgcn_exp2f(-dl); l_reg*=f; if(hi==0)wsf[r32]=f; resc=true; } } \
    SBAR(); \
    GAPB(o[0]=__builtin_amdgcn_mfma_f32_32x32x16_bf16(PAF(0),VFR(0),o[0],0,0,0), C0,0); \
    GAPB(o[1]=__builtin_amdgcn_mfma_f32_32x32x16_bf16(PAF(0),VFR(4),o[1],0,0,0), C0,4); \
    KRD(GL,0); GAPB(o[0]=__builtin_amdgcn_mfma_f32_32x32x16_bf16(PAF(1),VFR(1),o[0],0,0,0), C0,8); \
    KRD(GL,1); GAPB(o[1]=__builtin_amdgcn_mfma_f32_32x32x16_bf16(PAF(1),VFR(5),o[1],0,0,0), C0,12); \
    KRD(GL,2); GAPB(o[0]=__builtin_amdgcn_mfma_f32_32x32x16_bf16(PAF(2),VFR(2),o[0],0,0,0), C1,0); \
    KRD(GL,3); GAPB(o[1]=__builtin_amdgcn_mfma_f32_32x32x16_bf16(PAF(2),VFR(6),o[1],0,0,0), C1,4); \
    GAPB(o[0]=__builtin_amdgcn_mfma_f32_32x32x16_bf16(PAF(3),VFR(3),o[0],0,0,0), C1,8); \
    GAPB(o[1]=__builtin_amdgcn_mfma_f32_32x32x16_bf16(PAF(3),VFR(7),o[1],0,0,0), C1,12); \
    }while(0)
  int t=1;
  for(;t+5<NT;t+=2){
    STEP(pB0,pB1,pA0,pA1,t,true,true,true);     WAIT_BAR(2); RESC(); ROT();
    STEP(pA0,pA1,pB0,pB1,t+1,true,true,true);   WAIT_BAR(2); RESC(); ROT();
  }
  #define ENDW(tt) do{ if((tt)+3<NT){WAIT_BAR(2);} else if((tt)+2<NT){WAIT_BAR(1);} else {WAIT_BAR(0);} }while(0)
  for(;t+1<NT;t+=2){
    STEP(pB0,pB1,pA0,pA1,t,(t+3<NT),(t+1<NT),(t+1<NT));       ENDW(t);   RESC(); ROT();
    STEP(pA0,pA1,pB0,pB1,t+1,(t+4<NT),(t+2<NT),(t+2<NT));     ENDW(t+1); RESC(); ROT();
  }
  STEP(pB0,pB1,pA0,pA1,NT-1,false,false,false); RESC();
  { float sacc=pB0[0]+pB0[1]; _Pragma("unroll") for(int r=2;r<16;++r)sacc+=pB0[r]; _Pragma("unroll") for(int r=0;r<16;++r)sacc+=pB1[r]; l_reg+=sacc;
    pw0=(u32x4){PKW(pB0,0),PKW(pB0,2),PKW(pB0,4),PKW(pB0,6)};pw1=(u32x4){PKW(pB0,8),PKW(pB0,10),PKW(pB0,12),PKW(pB0,14)};pw2=(u32x4){PKW(pB1,0),PKW(pB1,2),PKW(pB1,4),PKW(pB1,6)};pw3=(u32x4){PKW(pB1,8),PKW(pB1,10),PKW(pB1,12),PKW(pB1,14)};
    SBAR(); pv(o,vb0+sl_cur,PAF(0),PAF(1),PAF(2),PAF(3)); }
  #undef PKW
  #undef PAF
  #undef VFR
  #undef PIN
  #undef MX3
  #undef GAPA
  #undef GAPB
  #undef EX
  #undef VRD
  #undef KRD
  #undef STEP
  #undef ENDW
  {auto rr=__builtin_amdgcn_permlane32_swap(__float_as_uint(l_reg),__float_as_uint(l_reg),false,false);l_reg=__uint_as_float(rr[0])+__uint_as_float(rr[1]);}
  if(hi==0)wsf[32+r32]=l_reg;asm volatile("s_waitcnt lgkmcnt(0)":::"memory");
  float rli[16];
  #pragma unroll
  for(int r=0;r<16;++r)rli[r]=__builtin_amdgcn_rcpf(wsf[32+crow(r,hi)]);
  bf16*Ow=O+(rowbase+q0+wid*QBLK)*OPITCH+OCOL0+h*D;
  { bf16*stg=(bf16*)(shm+LDS_OST)+wid*2048;
    #pragma unroll
    for(int r=0;r<16;++r){const int orow=crow(r,hi);
      #pragma unroll
      for(int d0=0;d0<2;++d0)stg[orow*64+d0*32+r32]=__float2bfloat16(o[d0][r]*rli[r]);}
    asm volatile("s_waitcnt lgkmcnt(0)":::"memory");
    #pragma unroll
    for(int i=0;i<4;++i){const int row=i*8+(lane>>3),ch=lane&7; const u32x4 v=*(const u32x4*)(stg+row*64+ch*8); ATTN_STORE16(Ow+(long)row*OPITCH+ch*8,v);} }
  asm volatile("s_waitcnt lgkmcnt(0)\n\ts_barrier":::"memory");
  #undef DMA_K
  #undef DMA_V
  #undef CMASK
  #undef SETBLK
  #undef SMP
  #undef LANEID
  #undef START
  #undef RESC
  #undef ROT
}
constexpr int ATTN_LDS_BYTES=LDS_BYTES;
struct AttnTensors { const bf16* Q; const bf16* K; const bf16* V; bf16* O; const float* UG; const float* KSUM; };
struct AttnUnit { int bh; int qb; };
struct StaticOrder {
  int vcu;
  __device__ __forceinline__ explicit StaticOrder(int grid,int block):vcu((block%8)*(grid/8)+block/8){}
  __device__ __forceinline__ bool next(int i,AttnUnit&u)const{ if(i>=4)return false; const int s=vcu&3; u.bh=vcu>>2; u.qb=(i==0)?15-s:(i==1)?s:(i==2)?11-s:4+s; return true; }
  __device__ __forceinline__ void a_ready(const AttnUnit&)const{}
  __device__ __forceinline__ void done(const AttnUnit&)const{}
};
template<class Sched,int THRL=8> __device__ __forceinline__ void attn_phase(char*lds,const AttnTensors&T,const Sched&S){
  AttnUnit u;
  for(int i=0;S.next(i,u);++i){ S.a_ready(u); attn_unit<THRL>(u.bh/NHEAD,u.bh%NHEAD,u.qb,T.Q,T.K,T.V,T.O,T.UG,T.KSUM,lds); S.done(u); }
}
#undef SBAR
#undef WAIT_BAR
}
struct Frame {
    LAS unsigned char* lds; volatile LAS unsigned* MISC; unsigned* ctl; unsigned char* ws;
    int tid, lane, wave, G, blk;
    const float* const* in; float* out;
};
#ifndef REP_MASK
#define REP_MASK 0u
#endif
#define REPS(j) for (int rep_ = 0; rep_ < (((REP_MASK >> (j)) & 1u) ? 2 : 1); ++rep_)
#ifndef SSD_NAIVE
#define SSD_NAIVE 0
#endif
#ifndef ATTN_NAIVE
#define ATTN_NAIVE 0
#endif
#ifndef ATTN_PROBE
#define ATTN_PROBE 0
#endif
constexpr int CW_SCAN = 2304;
constexpr int CW_RARR = 2560;
constexpr int CW_WQ = 2048;
__device__ __forceinline__ unsigned char* wsp(const Frame& F) { return F.ws; }

__device__ __forceinline__ float wave_sum(float v) {
#pragma unroll
    for (int o = 1; o < 64; o <<= 1) v += __shfl_xor(v, o);
    return v;
}
__device__ __forceinline__ float wave_max(float v) {
#pragma unroll
    for (int o = 1; o < 64; o <<= 1) v = fmaxf(v, __shfl_xor(v, o));
    return v;
}

__device__ __forceinline__ void tr_item64(const float* W, int ldn, int k0, int c0, int nvalid, bf16* WT, int ldk, int dbase, int dstep32, const float* kscale, LAS unsigned short* tl, int lane) {
    const int n4 = (lane & 15) * 4, kq = lane >> 4;
    f32x4 v[16];
#pragma unroll
    for (int i = 0; i < 16; ++i) v[i] = (n4 < nvalid) ? *(const f32x4*)(W + (size_t)(k0 + 4 * i + kq) * ldn + c0 + n4) : (f32x4){0.f, 0.f, 0.f, 0.f};
#pragma unroll
    for (int i = 0; i < 16; ++i) { const int kk = 4 * i + kq; const float s = kscale ? kscale[k0 + kk] : 1.0f; v2u p; p.x = pk2(v[i].x * s, v[i].y * s); p.y = pk2(v[i].z * s, v[i].w * s); *(LAS v2u*)(tl + kk * 68 + n4) = p; }
    LDS_WAIT(); asm volatile("" ::: "memory");
    const int c = lane & 7;
#pragma unroll
    for (int j = 0; j < 8; ++j) { const int n = (lane >> 3) + 8 * j; const LAS unsigned short* s = tl + (8 * c) * 68 + n;
        v4u o; o.x = (unsigned)s[0] | ((unsigned)s[68] << 16); o.y = (unsigned)s[136] | ((unsigned)s[204] << 16); o.z = (unsigned)s[272] | ((unsigned)s[340] << 16); o.w = (unsigned)s[408] | ((unsigned)s[476] << 16);
        if (n < nvalid) *(v4u*)(WT + (size_t)(dbase + (n >> 5) * dstep32 + (n & 31)) * ldk + k0 + 8 * c) = o; }
    LDS_WAIT(); asm volatile("" ::: "memory");
}
constexpr int IT_IN = 16 * 45, IT_OUT = 256, IT_G = 4096, IT_LAYER = IT_IN + IT_OUT + 3 * IT_G;
__device__ __forceinline__ void prologue_item(Frame& F, int it, LAS unsigned short* tl, int lane) {
    unsigned char* const W_ = wsp(F);
    const int l = it / IT_LAYER; int r = it % IT_LAYER;
    bf16* Win_t = (bf16*)(W_ + WS_WIN) + (size_t)l * NIN * 1024; bf16* Wout_t = (bf16*)(W_ + WS_WOUT) + (size_t)l * 1024 * 1024;
    bf16* Wgu_t = (bf16*)(W_ + WS_WGU) + (size_t)l * 32 * 1024 * 1024; bf16* Wd_t = (bf16*)(W_ + WS_WD) + (size_t)l * 32 * 1024 * 512;
    if (r < IT_IN) { const int kb = r / 45, cb = r % 45; int c0, nv = 64, dbase, dstep = 32;
        if (cb < 8) { c0 = 64 * cb; dbase = c0; }
        else if (cb < 20) { c0 = 512 + 64 * (cb - 8); dbase = c0; }
        else if (cb == 20) { c0 = 1280; nv = 8; dbase = 2816; }
        else if (cb < 29) { const int hd = cb - 21; c0 = 1288 + 64 * hd; dbase = 256 * (5 + (hd >> 2)) + 32 * (hd & 3); dstep = 128; }
        else if (cb < 37) { const int hd = cb - 29; c0 = 1800 + 64 * hd; dbase = 256 * (7 + (hd >> 2)) + 32 * (hd & 3); dstep = 128; }
        else { const int j = cb - 37; c0 = 2312 + 64 * j; dbase = 2304 + 64 * j; }
        tr_item64(F.in[3] + (size_t)l * 1024 * INCOLS, INCOLS, 64 * kb, c0, nv, Win_t, 1024, dbase, dstep, F.in[2] + l * D, tl, lane); return; }
    r -= IT_IN;
    if (r < IT_OUT) { const int kb = r >> 4, nb = r & 15;
        tr_item64(F.in[12] + (size_t)l * 1024 * 1024, 1024, 64 * kb, 64 * nb, 64, Wout_t, 1024, 64 * nb, 32, (kb < 8) ? F.in[9] + l * 512 : nullptr, tl, lane); return; }
    r -= IT_OUT;
    if (r < 2 * IT_G) { const int up = r >= IT_G; if (up) r -= IT_G; const int e = r >> 7, q = r & 127, kb = q >> 3, nb = q & 7;
        tr_item64(F.in[up ? 19 : 18] + (size_t)(l * 32 + e) * 1024 * 512, 512, 64 * kb, 64 * nb, 64, Wgu_t + (size_t)e * 1024 * 1024, 1024, 256 * (nb >> 1) + 128 * up + 64 * (nb & 1), 32, nullptr, tl, lane); return; }
    r -= 2 * IT_G;
    { const int e = r >> 7, q = r & 127, kb = q >> 4, nb = q & 15;
        tr_item64(F.in[20] + (size_t)(l * 32 + e) * 512 * 1024, 1024, 64 * kb, 64 * nb, 64, Wd_t + (size_t)e * 1024 * 512, 512, 64 * nb, 32, nullptr, tl, lane); }
}
__device__ __forceinline__ void moe_convert_all(Frame& F, int l) {
    int ln = F.lane; asm volatile("" : "+v"(ln));
    LAS unsigned short* scr = (LAS unsigned short*)(F.lds + F.wave * 16384);
    const int gw = F.blk * NWAVES + F.wave;
#pragma unroll 1
    for (int j = 0; j < 6; ++j) prologue_item(F, l * IT_LAYER + IT_IN + IT_OUT + j * (GRID * NWAVES) + gw, scr, ln);
    __syncthreads();
}
__device__ __forceinline__ void rms_row_store(const f32x4 (&v)[4], const float* g, bf16* orow, int lane) {
    float s = 0.f;
#pragma unroll
    for (int j = 0; j < 4; ++j) s += (v[j].x * v[j].x + v[j].y * v[j].y) + (v[j].z * v[j].z + v[j].w * v[j].w);
    const float rs = 1.0f / sqrtf(wave_sum(s) * (1.0f / D) + EPS);
#pragma unroll
    for (int j = 0; j < 4; ++j) { const f32x4 gj = *((const f32x4*)g + lane + 64 * j); const f32x4 o = v[j] * rs * gj;
        v2u w; w.x = pk2(o.x, o.y); w.y = pk2(o.z, o.w); *((v2u*)orow + lane + 64 * j) = w; }
}
__device__ __forceinline__ void phase_prologue(Frame& F) {
    unsigned char* const W_ = wsp(F);
    LAS unsigned short* scr = (LAS unsigned short*)(F.lds + F.wave * 16384);
    const int gw = F.blk * NWAVES + F.wave, NGW = F.G * NWAVES;
    constexpr int IT_ESS = IT_IN + IT_OUT;
    for (int it = gw; it < DEPTH * IT_ESS; it += NGW) prologue_item(F, (it / IT_ESS) * IT_LAYER + (it % IT_ESS), scr, F.lane);
    for (int r = gw; r < DEPTH * 248; r += NGW) { const int l = r / 248, rr = r % 248; v4u* p = (v4u*)((bf16*)(W_ + WS_WIN) + ((size_t)l * NIN + 2824 + rr) * 1024);
        p[F.lane] = (v4u){0u, 0u, 0u, 0u}; p[64 + F.lane] = (v4u){0u, 0u, 0u, 0u}; }
    { bf16* wrh = (bf16*)(W_ + WS_WR); bf16* wrl = wrh + DEPTH * 64 * 1024;
      for (int i = F.blk * NTHREADS + F.tid; i < DEPTH * 64 * 1024; i += F.G * NTHREADS) { const int l = i >> 16, c = (i >> 10) & 63, k = i & 1023; float v = 0.f;
          if (c < 36) v = F.in[13][l * D + k] * ((c < 4) ? F.in[14][((size_t)l * 1024 + k) * 4 + c] : F.in[16][((size_t)l * 1024 + k) * 32 + (c - 4)]);
          const unsigned h = f2bf(v); const float r = v - __builtin_bit_cast(float, h << 16); wrh[i] = (bf16)h; wrl[i] = (bf16)f2bf(r); } }
    float* tb = (float*)(W_ + WS_TB);
    { const int i = F.blk * NTHREADS + F.tid;
      if (i < 1024) { const int h = i >> 7, d = i & 127; int bk = d; if (d >= 16) { bk = 16 + (int)(log2f((float)d * (1.0f / 16.0f)) * (16.0f / 3.0f)); bk = bk > 31 ? 31 : bk; } tb[i] = F.in[1][bk * 8 + h] * LOG2E; }
      else if (i < 1032) tb[i] = F.in[1][31 * 8 + (i - 1024)] * LOG2E; }
    { float* ug = (float*)(W_ + WS_UG);
      for (int i = F.blk * NTHREADS + F.tid; i < 8 * 768; i += F.G * NTHREADS) { const int h = i / 768, d = 511 - (i % 768); float v;
          if (d < 0) v = -1e30f; else { int bk = d; if (d >= 16) { bk = 16 + (int)(log2f((float)d * (1.0f / 16.0f)) * (16.0f / 3.0f)); bk = bk > 31 ? 31 : bk; } v = F.in[1][bk * 8 + h] * LOG2E; }
          ug[i] = v; } }
    { bf16* idn = (bf16*)(W_ + WS_IDN);
      for (int i = F.blk * NTHREADS + F.tid; i < 256 * 32; i += F.G * NTHREADS) { const int n = i >> 5, k8 = (i & 31) * 8, j = n - k8; v4u o = (v4u){0u, 0u, 0u, 0u};
          if (j >= 0 && j < 8) { const unsigned one = (j & 1) ? 0x3f800000u : 0x00003f80u; if ((j >> 1) == 0) o.x = one; else if ((j >> 1) == 1) o.y = one; else if ((j >> 1) == 2) o.z = one; else o.w = one; }
          *(v4u*)(idn + (size_t)n * 1024 + k8) = o; } }
    bf16* hb = (bf16*)(W_ + WS_HB); float* rs1 = (float*)(W_ + WS_RS1);
    for (int t = gw; t < T; t += NGW) { const f32x4* xr = (const f32x4*)(F.in[0] + (size_t)t * D) + F.lane; float s = 0.f;
#pragma unroll
        for (int j = 0; j < 4; ++j) { const f32x4 v = xr[64 * j]; v2u w; w.x = pk2(v.x, v.y); w.y = pk2(v.z, v.w); *((v2u*)(hb + (size_t)t * D) + F.lane + 64 * j) = w;
            const float a0 = bflo(w.x), a1 = bfhi(w.x), a2 = bflo(w.y), a3 = bfhi(w.y); s += (a0 * a0 + a1 * a1) + (a2 * a2 + a3 * a3); }
        s = wave_sum(s); if (F.lane == 0) rs1[t] = 1.0f / sqrtf(s * (1.0f / D) + EPS); }
}
template <bool DUMMY = false> __device__ __forceinline__ void phase_combine(Frame& F, int lnext) {
    unsigned char* const W_ = wsp(F);
    const int gw = F.blk * NWAVES + F.wave; const int t0 = gw * 16;
    const unsigned* route = (const unsigned*)(W_ + WS_ROUTE); const bf16* y = (const bf16*)(W_ + R1_XG); bf16* hb = (bf16*)(W_ + WS_HB);
    float* rs1 = (float*)(W_ + (DUMMY ? R1_HMID : WS_RS1));
    const v4u rw = *(const v4u*)(route + (size_t)(t0 + (F.lane & 15)) * 8 + 4);
#pragma unroll 1
    for (int i4 = 0; i4 < 16; i4 += 4) {
        v2u hv[4][4], ya[4][4], yb[4][4]; float g0[4], g1[4];
#pragma unroll
        for (int q = 0; q < 4; ++q) { const unsigned s0 = (unsigned)__shfl((int)rw.z, i4 + q), s1 = (unsigned)__shfl((int)rw.w, i4 + q); g0[q] = __builtin_bit_cast(float, __shfl((int)rw.x, i4 + q)); g1[q] = __builtin_bit_cast(float, __shfl((int)rw.y, i4 + q));
            const v2u* hr = (const v2u*)(hb + (size_t)(t0 + i4 + q) * D) + F.lane; const v2u* y0 = (const v2u*)(y + (size_t)s0 * D) + F.lane; const v2u* y1 = (const v2u*)(y + (size_t)s1 * D) + F.lane;
#pragma unroll
            for (int j = 0; j < 4; ++j) { hv[q][j] = hr[64 * j]; ya[q][j] = y0[64 * j]; yb[q][j] = y1[64 * j]; } }
#pragma unroll
        for (int q = 0; q < 4; ++q) { const int t = t0 + i4 + q; f32x4 v[4];
#pragma unroll
            for (int j = 0; j < 4; ++j) { const v2u h2 = hv[q][j], a = ya[q][j], b = yb[q][j];
                v[j].x = bflo(h2.x) + (g0[q] * bflo(a.x) + g1[q] * bflo(b.x)); v[j].y = bfhi(h2.x) + (g0[q] * bfhi(a.x) + g1[q] * bfhi(b.x)); v[j].z = bflo(h2.y) + (g0[q] * bflo(a.y) + g1[q] * bflo(b.y)); v[j].w = bfhi(h2.y) + (g0[q] * bfhi(a.y) + g1[q] * bfhi(b.y)); }
            if (lnext < DEPTH) { v2u* hw = DUMMY ? (v2u*)((unsigned char*)F.out + 64 * MiB + (size_t)t * D * 2) + F.lane : (v2u*)(hb + (size_t)t * D) + F.lane;
                float ss = 0.f;
#pragma unroll
                for (int j = 0; j < 4; ++j) { v2u w; w.x = pk2(v[j].x, v[j].y); w.y = pk2(v[j].z, v[j].w); hw[64 * j] = w; const float a0 = bflo(w.x), a1 = bfhi(w.x), a2 = bflo(w.y), a3 = bfhi(w.y); ss += (a0 * a0 + a1 * a1) + (a2 * a2 + a3 * a3); }
                ss = wave_sum(ss); if (F.lane == 0) rs1[t] = 1.0f / sqrtf(ss * (1.0f / D) + EPS);
            } else {
#pragma unroll
                for (int j = 0; j < 4; ++j) *((f32x4*)(F.out + (size_t)t * D) + F.lane + 64 * j) = v[j];
            } }
    }
}
__device__ __forceinline__ void phase_conv(Frame& F, int l) {
    unsigned char* const W_ = wsp(F);
    const bf16* xbc = (const bf16*)(W_ + R1_XBC); bf16* xact = (bf16*)(W_ + WS_XN);
    const float* cw = F.in[4] + (size_t)l * 4 * CCH; const float* cb = F.in[5] + (size_t)l * CCH;
    for (int i = F.blk * NTHREADS + F.tid; i < T * 96; i += F.G * NTHREADS) { const int t = i / 96, c0 = (i % 96) * 8, s = t % SEQ;
        float a[8];
#pragma unroll
        for (int q = 0; q < 8; ++q) a[q] = cb[c0 + q];
#pragma unroll
        for (int j = 0; j < 4; ++j) { if (s - 3 + j >= 0) { const v4u w = *(const v4u*)(xbc + (size_t)(t - 3 + j) * CCH + c0); const float* wj = cw + j * CCH + c0;
            a[0] += wj[0] * bflo(w.x); a[1] += wj[1] * bfhi(w.x); a[2] += wj[2] * bflo(w.y); a[3] += wj[3] * bfhi(w.y); a[4] += wj[4] * bflo(w.z); a[5] += wj[5] * bfhi(w.z); a[6] += wj[6] * bflo(w.w); a[7] += wj[7] * bfhi(w.w); } }
#pragma unroll
        for (int q = 0; q < 8; ++q) a[q] = a[q] / (1.0f + __expf(-a[q]));
        v4u o; o.x = pk2(a[0], a[1]); o.y = pk2(a[2], a[3]); o.z = pk2(a[4], a[5]); o.w = pk2(a[6], a[7]);
        *(v4u*)(xact + (size_t)t * CCH + c0) = o; }
}
__device__ __forceinline__ void ssd_naive_item(Frame& F, int l, int item) {
    unsigned char* const W_ = wsp(F);
    const bf16* xact = (const bf16*)(W_ + WS_XN); const float* dtb = (const float*)(W_ + R1_DT); const bf16* zb = (const bf16*)(W_ + R1_Z); bf16* ymix = (bf16*)(W_ + R1_YMIX);
    const int lane = F.lane, pi = lane >> 4, ng = lane & 15;
    const int b = item >> 7, head = (item >> 4) & 7, pq = item & 15, p = 4 * pq + pi, g = head >> 2;
    const float A = -__expf(F.in[7][l * 8 + head]), dtbias = F.in[6][l * 8 + head], Dk = F.in[8][l * 8 + head];
    float h0 = 0.f, h1 = 0.f, h2 = 0.f, h3 = 0.f;
    const size_t r0 = (size_t)b * SEQ;
#pragma unroll 4
    for (int t = 0; t < SEQ; ++t) { const size_t row = r0 + t;
        const float dr = dtb[row * 8 + head] + dtbias; const float dtv = fmaxf(dr, 0.f) + log1pf(__expf(-fabsf(dr))); const float dA = __expf(dtv * A);
        const float x = bf1(xact[row * CCH + head * 64 + p]);
        const v2u bw = *(const v2u*)(xact + row * CCH + 512 + g * 64 + 4 * ng), cw = *(const v2u*)(xact + row * CCH + 640 + g * 64 + 4 * ng);
        const float xdt = x * dtv;
        h0 = h0 * dA + xdt * bflo(bw.x); h1 = h1 * dA + xdt * bfhi(bw.x); h2 = h2 * dA + xdt * bflo(bw.y); h3 = h3 * dA + xdt * bfhi(bw.y);
        float part = (h0 * bflo(cw.x) + h1 * bfhi(cw.x)) + (h2 * bflo(cw.y) + h3 * bfhi(cw.y));
        part += __shfl_xor(part, 1); part += __shfl_xor(part, 2); part += __shfl_xor(part, 4); part += __shfl_xor(part, 8);
        const float yv = part + Dk * x; const float zt = bf1(zb[row * DI + head * 64 + p]); const float yg = yv * zt / (1.0f + __expf(-zt));
        if (ng == 0) ymix[row * 1024 + head * 64 + p] = (bf16)f2bf(yg);
    }
}
__device__ __forceinline__ void attn_naive_query(Frame& F, int b, int h, int s, const float* ksum) {
    unsigned char* const W_ = wsp(F);
    const bf16* qbuf = (const bf16*)(W_ + R1_Q); const bf16* kbuf = (const bf16*)(W_ + R1_K); const bf16* vbuf = (const bf16*)(W_ + R1_V); bf16* ymix = (bf16*)(W_ + R1_YMIX);
    const float* tb = (const float*)(W_ + WS_TB);
    const int lane = F.lane, qb = s >> 8; const size_t rowq = (size_t)b * SEQ + s;
    float qf[64];
    { const v4u* qp = (const v4u*)(qbuf + rowq * 512 + h * 64);
#pragma unroll
      for (int i = 0; i < 8; ++i) { const v4u w = qp[i]; qf[8 * i] = bflo(w.x); qf[8 * i + 1] = bfhi(w.x); qf[8 * i + 2] = bflo(w.y); qf[8 * i + 3] = bfhi(w.y); qf[8 * i + 4] = bflo(w.z); qf[8 * i + 5] = bfhi(w.z); qf[8 * i + 6] = bflo(w.w); qf[8 * i + 7] = bfhi(w.w); } }
    float gv = -INFINITY;
    if (lane < qb) { const f32x4* kp = (const f32x4*)(ksum + (((size_t)b * 8 + h) * 16 + lane) * 64); float a = 0.f;
#pragma unroll
        for (int i = 0; i < 16; ++i) { const f32x4 kv = kp[i]; a += (qf[4 * i] * kv.x + qf[4 * i + 1] * kv.y) + (qf[4 * i + 2] * kv.z + qf[4 * i + 3] * kv.w); }
        gv = a; }
    unsigned selmask = 0u;
    for (int r = 0; r < 3; ++r) { float best = gv; int bi = lane;
#pragma unroll
        for (int o = 1; o < 64; o <<= 1) { const float ob = __shfl_xor(best, o); const int oi = __shfl_xor(bi, o); if (ob > best || (ob == best && oi < bi)) { best = ob; bi = oi; } }
        if (best > -INFINITY) selmask |= 1u << bi;
        if (lane == bi) gv = -INFINITY; }
    selmask = (unsigned)__builtin_amdgcn_readfirstlane((int)selmask) | (1u << qb);
    float m = -INFINITY, lsum = 0.f, o = 0.f;
    for (int bi2 = 0; bi2 <= qb; ++bi2) { const int n = qb - bi2;
        if (!((selmask >> n) & 1u)) continue;
        for (int tt = 0; tt < 4; ++tt) { const int key0 = n * 256 + tt * 64; if (key0 > s) break; const int key = key0 + lane;
            const v4u* kp = (const v4u*)(kbuf + ((size_t)b * SEQ + key) * 512 + h * 64); float sc = 0.f;
#pragma unroll
            for (int i = 0; i < 8; ++i) { const v4u w = kp[i]; sc += (qf[8 * i] * bflo(w.x) + qf[8 * i + 1] * bfhi(w.x)) + (qf[8 * i + 2] * bflo(w.y) + qf[8 * i + 3] * bfhi(w.y)) + (qf[8 * i + 4] * bflo(w.z) + qf[8 * i + 5] * bfhi(w.z)) + (qf[8 * i + 6] * bflo(w.w) + qf[8 * i + 7] * bfhi(w.w)); }
            const int dist = s - key; const float bias = (dist < 128) ? tb[h * 128 + (dist < 0 ? 0 : dist)] : tb[1024 + h];
            sc = (dist < 0) ? -INFINITY : sc + bias;
            const float mn = fmaxf(m, wave_max(sc)); const float f = __builtin_amdgcn_exp2f(m - mn), p = __builtin_amdgcn_exp2f(sc - mn); m = mn;
            lsum = lsum * f + wave_sum(p); o *= f;
            const bf16* vp = vbuf + ((size_t)b * SEQ + key0) * 512 + h * 64 + lane;
#pragma unroll 16
            for (int j = 0; j < 64; ++j) { const float pj = __builtin_bit_cast(float, __builtin_amdgcn_readlane(__builtin_bit_cast(int, p), j)); o += pj * bf1(vp[(size_t)j * 512]); }
        } }
#if ATTN_PROBE
    { const size_t ix = rowq * 1024 + 512 + h * 64 + lane; const float fast = bf1(ymix[ix]); ymix[ix] = (bf16)f2bf(fast + (float)ATTN_PROBE * (fast - o / lsum)); }
#else
    ymix[rowq * 1024 + 512 + h * 64 + lane] = (bf16)f2bf(o / lsum);
#endif
}
namespace ssd {
typedef short bf16x8 __attribute__((ext_vector_type(8)));
typedef short bf16x4 __attribute__((ext_vector_type(4)));
typedef float f32x16 __attribute__((ext_vector_type(16)));
typedef float f32x2_t __attribute__((ext_vector_type(2))); typedef __bf16 bf16x2_t __attribute__((ext_vector_type(2)));
__device__ __forceinline__ unsigned cvtpk(float lo, float hi) { f32x2_t v = {lo, hi}; bf16x2_t b = __builtin_convertvector(v, bf16x2_t); return __builtin_bit_cast(unsigned, b); }
__device__ __forceinline__ int crow(int r, int hi) { return (r & 3) + 8 * (r >> 2) + 4 * hi; }
__device__ __forceinline__ float softplus_f(float x) { return fmaxf(x, 0.f) + log1pf(__expf(-fabsf(x))); }
__device__ __forceinline__ void chunk_scalars(const float* dtraw, int t0, int head, float dtbias, float A, int lane, float& dt0, float& dt1, float& cs0, float& cs1) {
    dt0 = softplus_f(dtraw[(size_t)(t0 + lane) * 8 + head] + dtbias); dt1 = softplus_f(dtraw[(size_t)(t0 + 64 + lane) * 8 + head] + dtbias);
    float v0 = dt0 * A, v1 = dt1 * A;
#pragma unroll
    for (int o = 1; o < 64; o <<= 1) { const float a = __shfl_up(v0, o), b = __shfl_up(v1, o); if (lane >= o) { v0 += a; v1 += b; } }
    cs0 = v0; cs1 = v1 + __shfl(v0, 63);
}
}

__device__ __forceinline__ void phase_ssd_prep(Frame& F, int l) {
    unsigned char* const W_ = wsp(F);
    const bf16* xbc = (const bf16*)(W_ + R1_XBC); bf16* XT = (bf16*)((unsigned char*)F.out + SS_XT); bf16* BT = (bf16*)((unsigned char*)F.out + SS_BT); bf16* BC = (bf16*)((unsigned char*)F.out + SS_BC);
    const float* cw = F.in[4] + (size_t)l * 4 * CCH; const float* cb = F.in[5] + (size_t)l * CCH;
    for (int i = F.tid; i < 16 * 96; i += NTHREADS) { const int tgl = i & 7, cgl = (i >> 3) & 7, wv_ = i >> 6, cgo = wv_ % 12, tgo = wv_ / 12, b = F.blk >> 5; const int cg = cgo * 8 + cgl, tg = (F.blk & 31) * 16 + tgo * 8 + tgl; const int c0 = cg * 8, s0 = tg * 8; const size_t r0 = (size_t)b * SEQ + s0;
        float w[4][8], bias[8];
#pragma unroll
        for (int j = 0; j < 4; ++j) { const f32x4 a = *(const f32x4*)(cw + j * CCH + c0), b2 = *(const f32x4*)(cw + j * CCH + c0 + 4); w[j][0] = a.x; w[j][1] = a.y; w[j][2] = a.z; w[j][3] = a.w; w[j][4] = b2.x; w[j][5] = b2.y; w[j][6] = b2.z; w[j][7] = b2.w; }
        { const f32x4 a = *(const f32x4*)(cb + c0), b2 = *(const f32x4*)(cb + c0 + 4); bias[0] = a.x; bias[1] = a.y; bias[2] = a.z; bias[3] = a.w; bias[4] = b2.x; bias[5] = b2.y; bias[6] = b2.z; bias[7] = b2.w; }
        v4u xin[11];
#pragma unroll
        for (int j = 0; j < 11; ++j) xin[j] = (s0 - 3 + j >= 0) ? *(const v4u*)(xbc + (r0 + j - 3) * CCH + c0) : (v4u){0u, 0u, 0u, 0u};
        unsigned o[8][8];
#pragma unroll
        for (int t = 0; t < 8; ++t) {
            float a[8];
#pragma unroll
            for (int q = 0; q < 8; ++q) a[q] = bias[q];
#pragma unroll
            for (int j = 0; j < 4; ++j) { const v4u x = xin[t + j];
                a[0] += w[j][0] * bflo(x.x); a[1] += w[j][1] * bfhi(x.x); a[2] += w[j][2] * bflo(x.y); a[3] += w[j][3] * bfhi(x.y); a[4] += w[j][4] * bflo(x.z); a[5] += w[j][5] * bfhi(x.z); a[6] += w[j][6] * bflo(x.w); a[7] += w[j][7] * bfhi(x.w); }
#pragma unroll
            for (int q = 0; q < 8; ++q) o[t][q] = f2bf(a[q] * __builtin_amdgcn_rcpf(1.0f + __builtin_amdgcn_exp2f(-LOG2E * a[q])));
        }
        if (c0 >= 512) {
#pragma unroll
            for (int t = 0; t < 8; ++t) { v4u pk; pk.x = o[t][0] | (o[t][1] << 16); pk.y = o[t][2] | (o[t][3] << 16); pk.z = o[t][4] | (o[t][5] << 16); pk.w = o[t][6] | (o[t][7] << 16); *(v4u*)(BC + (r0 + t) * 256 + (c0 - 512)) = pk; } }
        if (c0 < 640) {
#pragma unroll
            for (int q = 0; q < 8; ++q) { v4u pk; pk.x = o[0][q] | (o[1][q] << 16); pk.y = o[2][q] | (o[3][q] << 16); pk.z = o[4][q] | (o[5][q] << 16); pk.w = o[6][q] | (o[7][q] << 16); const int c = c0 + q;
                bf16* dst = (c0 < 512) ? XT + ((size_t)(b * 8 + (c >> 6)) * 64 + (c & 63)) * SEQ + s0 : BT + ((size_t)(b * 2 + ((c - 512) >> 6)) * 64 + ((c - 512) & 63)) * SEQ + s0;
                *(v4u*)dst = pk; } }
    }
}
__device__ __forceinline__ void ssd_states_item(Frame& F, int l, int wgi) {
    unsigned char* const W_ = wsp(F);
    const int lane = F.lane, r32 = lane & 31, hi = lane >> 5;
    const int b = wgi >> 6, c = (wgi >> 1) & 31, g = wgi & 1, head = g * 4 + (F.wave >> 1), ph = F.wave & 1;
    const int t0 = b * SEQ + c * 128; const int item = ((b * 8 + head) * 2 + ph) * 32 + c;
    LAS float* SC = (LAS float*)(F.lds + F.wave * 8192);
    const bf16* bt = (const bf16*)((unsigned char*)F.out + SS_BT) + ((size_t)(b * 2 + g) * 64 + r32) * SEQ + c * 128 + 8 * hi;
    const bf16* xt = (const bf16*)((unsigned char*)F.out + SS_XT) + ((size_t)(b * 8 + head) * 64 + ph * 32 + r32) * SEQ + c * 128 + 8 * hi;
    ssd::bf16x8 fa0[8], fa1[8]; v4u fx[8];
#pragma unroll
    for (int k = 0; k < 8; ++k) { fa0[k] = *(const ssd::bf16x8*)(bt + 16 * k); fa1[k] = *(const ssd::bf16x8*)(bt + (size_t)32 * SEQ + 16 * k); fx[k] = *(const v4u*)(xt + 16 * k); }
    float dt0, dt1, cs0, cs1; ssd::chunk_scalars((const float*)(W_ + R1_DT), t0, head, F.in[6][l * 8 + head], -__expf(F.in[7][l * 8 + head]), lane, dt0, dt1, cs0, cs1);
    const float cend = __shfl(cs1, 63);
    SC[lane] = dt0 * __expf(cend - cs0); SC[64 + lane] = dt1 * __expf(cend - cs1);
    LDS_WAIT(); asm volatile("" ::: "memory");
    ssd::f32x16 acc0 = {}, acc1 = {};
#pragma unroll
    for (int k = 0; k < 8; ++k) {
        const v4u xw = fx[k];
        const f32x4 s0 = *(const LAS f32x4*)(SC + 16 * k + 8 * hi), s1 = *(const LAS f32x4*)(SC + 16 * k + 8 * hi + 4);
        v4u xs; xs.x = ssd::cvtpk(bflo(xw.x) * s0.x, bfhi(xw.x) * s0.y); xs.y = ssd::cvtpk(bflo(xw.y) * s0.z, bfhi(xw.y) * s0.w); xs.z = ssd::cvtpk(bflo(xw.z) * s1.x, bfhi(xw.z) * s1.y); xs.w = ssd::cvtpk(bflo(xw.w) * s1.z, bfhi(xw.w) * s1.w);
        const ssd::bf16x8 xb = __builtin_bit_cast(ssd::bf16x8, xs);
        acc0 = __builtin_amdgcn_mfma_f32_32x32x16_bf16(fa0[k], xb, acc0, 0, 0, 0); acc1 = __builtin_amdgcn_mfma_f32_32x32x16_bf16(fa1[k], xb, acc1, 0, 0, 0);
    }
    float* S = (float*)((unsigned char*)F.out + SS_S) + (size_t)item * 2048 + lane;
#pragma unroll
    for (int r = 0; r < 16; ++r) { S[r * 64] = acc0[r]; S[(16 + r) * 64] = acc1[r]; }
    if (lane == 0) ((float*)(W_ + SS_DEC))[item] = __expf(cend);
    LDS_WAIT(); asm volatile("" ::: "memory");
}
__device__ __forceinline__ void phase_ssd_scan(Frame& F, unsigned* ctr) {
    unsigned char* const W_ = wsp(F);
    const f32x4* S4 = (const f32x4*)((unsigned char*)F.out + SS_S); const float* dec = (const float*)(W_ + SS_DEC);
    const __amdgpu_buffer_rsrc_t rs = __builtin_amdgcn_make_buffer_rsrc((void*)((unsigned char*)F.out + SS_S), 0, 32 * 1024 * 1024, 0x00020000);
    for (int i = F.blk * NTHREADS + F.tid; i < 128 * 512; i += F.G * NTHREADS) { const int bhp = i >> 9, e4 = i & 511; f32x4 hs = {0.f, 0.f, 0.f, 0.f};
#pragma unroll
        for (int half = 0; half < 2; ++half) { f32x4 sv[16]; float dv[16];
#pragma unroll
            for (int c = 0; c < 16; ++c) { sv[c] = S4[(size_t)(bhp * 32 + half * 16 + c) * 512 + e4]; dv[c] = dec[bhp * 32 + half * 16 + c]; }
#pragma unroll
            for (int c = 0; c < 16; ++c) { __builtin_amdgcn_raw_buffer_store_b128(__builtin_bit_cast(v4u, hs), rs, (int)(((size_t)(bhp * 32 + half * 16 + c) * 512 + e4) * 16), 0, 16); hs = hs * dv[c] + sv[c]; } } }
    asm volatile("s_waitcnt vmcnt(0)" ::: "memory");
    __syncthreads();
    if (F.tid == 0) __hip_atomic_fetch_add(ctr, 1u, RLX_AGENT);
}
__device__ __forceinline__ void ssd_scan_wait(Frame& F, unsigned* ctr) {
    if (F.tid == 0) { unsigned sp = 0;
        while (ald(ctr) < (unsigned)F.G) { __builtin_amdgcn_s_sleep(2); if (++sp > (1u << 22)) { __hip_atomic_store(F.ctl + 1, 0x5CA0u, RLX_AGENT); break; } }
        __builtin_amdgcn_fence(__ATOMIC_ACQUIRE, "agent");
        asm volatile("s_waitcnt vmcnt(0)" ::: "memory"); }
    __syncthreads();
}
__device__ __forceinline__ void ssd_output_item(Frame& F, int l, int wgi) {
    unsigned char* const W_ = wsp(F);
    const int lane = F.lane, r32 = lane & 31, hi = lane >> 5;
    const int b = wgi >> 6, c = (wgi >> 1) & 31, g = wgi & 1, head = g * 4 + (F.wave >> 1), ph = F.wave & 1;
    const int t0 = b * SEQ + c * 128; const int item = ((b * 8 + head) * 2 + ph) * 32 + c;
    LAS float* ACS = (LAS float*)(F.lds + F.wave * 8192); LAS float* DTV = ACS + 128; LAS float* WV = ACS + 256; LAS float* EC = ACS + 384; LAS float* ST = ACS + 512;
    const float Dk = F.in[8][l * 8 + head];
    LAS unsigned char* BL = F.lds + 65536; LAS unsigned char* CL = BL + 128 * 144;
    v4u sb[2], sc2[2];
    { const bf16* src = (const bf16*)((unsigned char*)F.out + SS_BC) + (size_t)t0 * 256 + g * 64;
#pragma unroll
      for (int i = 0; i < 2; ++i) { const int pc = F.tid + 512 * i, row = pc >> 3, ch = pc & 7; sb[i] = *(const v4u*)(src + (size_t)row * 256 + ch * 8); sc2[i] = *(const v4u*)(src + (size_t)row * 256 + 128 + ch * 8); } }
    const bf16* xt = (const bf16*)((unsigned char*)F.out + SS_XT) + ((size_t)(b * 8 + head) * 64 + ph * 32 + r32) * SEQ + c * 128 + 4 * hi;
    ssd::bf16x8 xfa[4][2];
#pragma unroll
    for (int st = 0; st < 4; ++st)
#pragma unroll
        for (int k2 = 0; k2 < 2; ++k2) { const v2u lo = *(const v2u*)(xt + 32 * st + 16 * k2), hi2 = *(const v2u*)(xt + 32 * st + 16 * k2 + 8); v4u w; w.x = lo.x; w.y = lo.y; w.z = hi2.x; w.w = hi2.y; xfa[st][k2] = __builtin_bit_cast(ssd::bf16x8, w); }
    float hv[2][2][8];
    { const float* Hp = (const float*)((unsigned char*)F.out + SS_S) + (size_t)item * 2048 + lane;
#pragma unroll
      for (int nt = 0; nt < 2; ++nt)
#pragma unroll
          for (int k2 = 0; k2 < 2; ++k2)
#pragma unroll
              for (int j = 0; j < 8; ++j) hv[nt][k2][j] = Hp[(nt * 16 + 8 * k2 + j) * 64]; }
    { float dt0, dt1, cs0, cs1; ssd::chunk_scalars((const float*)(W_ + R1_DT), t0, head, F.in[6][l * 8 + head], -__expf(F.in[7][l * 8 + head]), lane, dt0, dt1, cs0, cs1);
      ACS[lane] = cs0; ACS[64 + lane] = cs1; DTV[lane] = dt0; DTV[64 + lane] = dt1; EC[lane] = __expf(cs0); EC[64 + lane] = __expf(cs1);
      const float e0 = __shfl(cs0, lane | 31), e1 = __shfl(cs1, lane | 31);
      WV[lane] = dt0 * __expf(e0 - cs0); WV[64 + lane] = dt1 * __expf(e1 - cs1); }
#pragma unroll
    for (int i = 0; i < 2; ++i) { const int pc = F.tid + 512 * i, row = pc >> 3, ch = pc & 7; *(LAS v4u*)(BL + row * 144 + ch * 16) = sb[i]; *(LAS v4u*)(CL + row * 144 + ch * 16) = sc2[i]; }
    __syncthreads();
    v4u hb[2][2];
#pragma unroll
    for (int nt = 0; nt < 2; ++nt)
#pragma unroll
        for (int k2 = 0; k2 < 2; ++k2) { hb[nt][k2].x = ssd::cvtpk(hv[nt][k2][0], hv[nt][k2][1]); hb[nt][k2].y = ssd::cvtpk(hv[nt][k2][2], hv[nt][k2][3]); hb[nt][k2].z = ssd::cvtpk(hv[nt][k2][4], hv[nt][k2][5]); hb[nt][k2].w = ssd::cvtpk(hv[nt][k2][6], hv[nt][k2][7]); }
    const bf16* zb = (const bf16*)(W_ + R1_Z); bf16* ymix = (bf16*)(W_ + R1_YMIX); float* ssq = (float*)(W_ + SS_SSQ);
#define SSD_LOAD_S(st_) \
        ssd::bf16x8 bf[4]; \
        _Pragma("unroll") for (int k = 0; k < 4; ++k) bf[k] = *(const LAS ssd::bf16x8*)(BL + (32 * (st_) + r32) * 144 + 32 * k + 16 * hi);
#define SSD_APPLY(XF0, XF1) do { \
        v4u p0, p1; p0.x = ssd::cvtpk(Tt[0], Tt[1]); p0.y = ssd::cvtpk(Tt[2], Tt[3]); p0.z = ssd::cvtpk(Tt[4], Tt[5]); p0.w = ssd::cvtpk(Tt[6], Tt[7]); \
        p1.x = ssd::cvtpk(Tt[8], Tt[9]); p1.y = ssd::cvtpk(Tt[10], Tt[11]); p1.z = ssd::cvtpk(Tt[12], Tt[13]); p1.w = ssd::cvtpk(Tt[14], Tt[15]); \
        Yt = __builtin_amdgcn_mfma_f32_32x32x16_bf16(__builtin_bit_cast(ssd::bf16x8, p0), XF0, Yt, 0, 0, 0); \
        Yt = __builtin_amdgcn_mfma_f32_32x32x16_bf16(__builtin_bit_cast(ssd::bf16x8, p1), XF1, Yt, 0, 0, 0); } while (0)
#pragma unroll 1
    for (int lt = 0; lt < 4; ++lt) {
        const int lr = lane >> 1, c0 = (lane & 1) * 16; const size_t row = (size_t)t0 + 32 * lt + lr;
        const v4u z0 = *(const v4u*)(zb + row * DI + head * 64 + ph * 32 + c0), z1 = *(const v4u*)(zb + row * DI + head * 64 + ph * 32 + c0 + 8);
        ssd::f32x16 Yt = {};
        ssd::bf16x8 cf[4];
#pragma unroll
        for (int k = 0; k < 4; ++k) cf[k] = *(const LAS ssd::bf16x8*)(CL + (32 * lt + r32) * 144 + 32 * k + 16 * hi);
        const float al = ACS[32 * lt + r32];
#pragma unroll 1
        for (int st = 0; st < lt; ++st) {
            SSD_LOAD_S(st)
            ssd::f32x16 Tt = {};
#pragma unroll
            for (int k = 0; k < 4; ++k) Tt = __builtin_amdgcn_mfma_f32_32x32x16_bf16(bf[k], cf[k], Tt, 0, 0, 0);
            const float sc = __expf(al - ACS[32 * st + 31]);
#pragma unroll
            for (int q = 0; q < 4; ++q) { const f32x4 a = *(const LAS f32x4*)(WV + 32 * st + 4 * hi + 8 * q); Tt[4 * q] *= sc * a.x; Tt[4 * q + 1] *= sc * a.y; Tt[4 * q + 2] *= sc * a.z; Tt[4 * q + 3] *= sc * a.w; }
            const ssd::bf16x8 x0 = (st == 0) ? xfa[0][0] : (st == 1) ? xfa[1][0] : xfa[2][0], x1 = (st == 0) ? xfa[0][1] : (st == 1) ? xfa[1][1] : xfa[2][1];
            SSD_APPLY(x0, x1);
        }
        {
            SSD_LOAD_S(lt)
            ssd::f32x16 Tt = {};
#pragma unroll
            for (int k = 0; k < 4; ++k) Tt = __builtin_amdgcn_mfma_f32_32x32x16_bf16(bf[k], cf[k], Tt, 0, 0, 0);
#pragma unroll
            for (int q = 0; q < 4; ++q) { const f32x4 as4 = *(const LAS f32x4*)(ACS + 32 * lt + 4 * hi + 8 * q), d4 = *(const LAS f32x4*)(DTV + 32 * lt + 4 * hi + 8 * q);
#pragma unroll
                for (int i = 0; i < 4; ++i) { const int r = 4 * q + i, sl = 4 * hi + 8 * q + i; const float f = (sl <= r32) ? __expf(al - as4[i]) * d4[i] : 0.f; Tt[r] = Tt[r] * f + ((sl == r32) ? Dk : 0.f); } }
            const ssd::bf16x8 x0 = (lt == 0) ? xfa[0][0] : (lt == 1) ? xfa[1][0] : (lt == 2) ? xfa[2][0] : xfa[3][0], x1 = (lt == 0) ? xfa[0][1] : (lt == 1) ? xfa[1][1] : (lt == 2) ? xfa[2][1] : xfa[3][1];
            SSD_APPLY(x0, x1);
        }
        { ssd::f32x16 Yo = {};
#pragma unroll
          for (int nt = 0; nt < 2; ++nt)
#pragma unroll
              for (int k2 = 0; k2 < 2; ++k2) { LAS unsigned char* cp = CL + (32 * lt + r32) * 144 + 64 * nt + 32 * k2 + 8 * hi;
                  const v2u lo = *(const LAS v2u*)cp, hi2 = *(const LAS v2u*)(cp + 16); v4u w; w.x = lo.x; w.y = lo.y; w.z = hi2.x; w.w = hi2.y;
                  Yo = __builtin_amdgcn_mfma_f32_32x32x16_bf16(__builtin_bit_cast(ssd::bf16x8, w), __builtin_bit_cast(ssd::bf16x8, hb[nt][k2]), Yo, 0, 0, 0); }
#pragma unroll
          for (int q = 0; q < 4; ++q) { const f32x4 e = *(const LAS f32x4*)(EC + 32 * lt + 4 * hi + 8 * q); Yt[4 * q] += e.x * Yo[4 * q]; Yt[4 * q + 1] += e.y * Yo[4 * q + 1]; Yt[4 * q + 2] += e.z * Yo[4 * q + 2]; Yt[4 * q + 3] += e.w * Yo[4 * q + 3]; } }
#pragma unroll
        for (int r = 0; r < 16; ++r) ST[ssd::crow(r, hi) * 36 + r32] = Yt[r];
        LDS_WAIT(); asm volatile("" ::: "memory");
        float yv[16];
#pragma unroll
        for (int q = 0; q < 4; ++q) { const f32x4 a = *(const LAS f32x4*)(ST + lr * 36 + c0 + 4 * q); yv[4 * q] = a.x; yv[4 * q + 1] = a.y; yv[4 * q + 2] = a.z; yv[4 * q + 3] = a.w; }
        const float zf[16] = {bflo(z0.x), bfhi(z0.x), bflo(z0.y), bfhi(z0.y), bflo(z0.z), bfhi(z0.z), bflo(z0.w), bfhi(z0.w), bflo(z1.x), bfhi(z1.x), bflo(z1.y), bfhi(z1.y), bflo(z1.z), bfhi(z1.z), bflo(z1.w), bfhi(z1.w)};
        float sq = 0.f;
#pragma unroll
        for (int j = 0; j < 16; ++j) { yv[j] = yv[j] * zf[j] * __builtin_amdgcn_rcpf(1.0f + __builtin_amdgcn_exp2f(-LOG2E * zf[j])); sq += yv[j] * yv[j]; }
        sq += __shfl_xor(sq, 1);
        if ((lane & 1) == 0) ssq[row * 16 + head * 2 + ph] = sq;
        v4u o0, o1; o0.x = pk2(yv[0], yv[1]); o0.y = pk2(yv[2], yv[3]); o0.z = pk2(yv[4], yv[5]); o0.w = pk2(yv[6], yv[7]); o1.x = pk2(yv[8], yv[9]); o1.y = pk2(yv[10], yv[11]); o1.z = pk2(yv[12], yv[13]); o1.w = pk2(yv[14], yv[15]);
        bf16* op = ymix + row * 1024 + head * 64 + ph * 32 + c0; *(v4u*)op = o0; *(v4u*)(op + 8) = o1;
        LDS_WAIT(); asm volatile("" ::: "memory");
    }
#undef SSD_LOAD_S
#undef SSD_APPLY
    __syncthreads();
}
__device__ __forceinline__ void phase_ssd_states(Frame& F, int l) {
    asm volatile("s_waitcnt vmcnt(0)" ::: "memory"); __syncthreads();
    ssd_states_item(F, l, 2 * F.blk); ssd_states_item(F, l, 2 * F.blk + 1); }
__device__ __forceinline__ void phase_ssd_output(Frame& F, int l) { for (int w = F.blk; w < 512; w += F.G) ssd_output_item(F, l, w); }
__device__ __forceinline__ void phase_mixer_naive(Frame& F, int l, const XcdBarrier& bar) {
    unsigned char* const W_ = wsp(F);
    const int gw = F.blk * NWAVES + F.wave;
#if SSD_NAIVE
    if ((gw & 1) == 0 && (gw >> 1) < 1024) ssd_naive_item(F, l, gw >> 1);
#else
    unsigned* sctr = F.ctl + CW_SCAN + 64 * l;
    phase_ssd_scan(F, sctr);
#endif
    const float* ksum = (const float*)(F.ctl + CW_KSUM) + (size_t)l * 65536;
#if ATTN_NAIVE
    unsigned* wq = F.ctl + CW_WQ + 64 * l;
    for (;;) { unsigned c = 0u; if (F.lane == 0) c = __hip_atomic_fetch_add(wq, 1u, RLX_AGENT); c = (unsigned)__builtin_amdgcn_readfirstlane((int)c);
        if (c >= 8192u) break;
        const int bh = (int)(c >> 7), s0 = (int)(c & 127u) * 32;
        for (int i = 0; i < 32; ++i) attn_naive_query(F, bh >> 3, bh & 7, s0 + i, ksum); }
#else
    __syncthreads();
    const attn_body::AttnTensors AT{(const attn_body::bf16*)(W_ + R1_Q), (const attn_body::bf16*)(W_ + R1_K), (const attn_body::bf16*)(W_ + R1_V), (attn_body::bf16*)(W_ + R1_YMIX), (const float*)(W_ + WS_UG), ksum};
    const attn_body::StaticOrder S(F.G, F.blk);
    if (F.blk & 1) { REPS(14) moe_convert_all(F, l); }
    REPS(3) attn_body::attn_phase<attn_body::StaticOrder>((char*)F.lds, AT, S);
    if (!(F.blk & 1)) { REPS(14) moe_convert_all(F, l); }
    ssd_scan_wait(F, sctr);
    phase_ssd_output(F, l);
#if ATTN_PROBE
    xcd_barrier(bar);
    { unsigned* wq = F.ctl + CW_WQ + 64 * l;
      for (;;) { unsigned c = 0u; if (F.lane == 0) c = __hip_atomic_fetch_add(wq, 1u, RLX_AGENT); c = (unsigned)__builtin_amdgcn_readfirstlane((int)c);
        if (c >= 8192u) break;
        const int bh = (int)(c >> 7), s0 = (int)(c & 127u) * 32;
        for (int i = 0; i < 32; ++i) attn_naive_query(F, bh >> 3, bh & 7, s0 + i, ksum); } }
#endif
#endif
}
__device__ __forceinline__ void phase_ssdnorm(Frame& F) {
    unsigned char* const W_ = wsp(F);
    const int gw = F.blk * NWAVES + F.wave, NGW = F.G * NWAVES; bf16* ymix = (bf16*)(W_ + R1_YMIX);
    for (int t = gw; t < T; t += NGW) { v4u* p = (v4u*)(ymix + (size_t)t * 1024) + F.lane; const v4u w = *p;
        float a[8] = {bflo(w.x), bfhi(w.x), bflo(w.y), bfhi(w.y), bflo(w.z), bfhi(w.z), bflo(w.w), bfhi(w.w)};
#if SSD_NAIVE
        float s = 0.f;
#pragma unroll
        for (int q = 0; q < 8; ++q) s += a[q] * a[q];
        s = wave_sum(s);
#else
        const f32x4* sp = (const f32x4*)((const float*)(W_ + SS_SSQ) + (size_t)t * 16); const f32x4 s0 = sp[0], s1 = sp[1], s2 = sp[2], s3 = sp[3];
        const float s = ((s0.x + s0.y) + (s0.z + s0.w)) + ((s1.x + s1.y) + (s1.z + s1.w)) + (((s2.x + s2.y) + (s2.z + s2.w)) + ((s3.x + s3.y) + (s3.z + s3.w)));
#endif
        const float rs = 1.0f / sqrtf(s * (1.0f / DI) + EPS);
        v4u o; o.x = pk2(a[0] * rs, a[1] * rs); o.y = pk2(a[2] * rs, a[3] * rs); o.z = pk2(a[4] * rs, a[5] * rs); o.w = pk2(a[6] * rs, a[7] * rs); *p = o; }
}
__device__ __forceinline__ void phase_router(Frame& F, int l, int cl) {
    unsigned char* const W_ = wsp(F);
    typedef short bf16x8 __attribute__((ext_vector_type(8)));
    LAS unsigned* lcnt = (LAS unsigned*)F.lds;
    if (F.tid < 32) lcnt[F.tid] = 0u;
    __syncthreads();
    const bf16* wrh = (const bf16*)(W_ + WS_WR) + (size_t)l * 64 * 1024; const bf16* wrl = wrh + DEPTH * 64 * 1024;
    const float* b1 = F.in[15] + l * 4; const float* b2 = F.in[17] + l * 32;
    unsigned* route = (unsigned*)(W_ + WS_ROUTE); float* rsb = (float*)(W_ + WS_RS);
    const int lane = F.lane, i16 = lane & 15, kq = lane >> 4;
    const int t = F.blk * 128 + F.wave * 16 + i16;
    const bf16* hrow = (const bf16*)(W_ + WS_HB) + (size_t)t * D + 8 * kq;
    constexpr int WROW = 528, WBUF = 2 * 48 * WROW;
    LAS unsigned char* wl0 = F.lds + 2048;
    v4u stg[6];
#define RT_LOAD(ch) do { _Pragma("unroll") for (int i_ = 0; i_ < 6; ++i_) { const int pc = F.tid + 512 * i_, part = pc / 1536, rr = (pc % 1536) >> 5, cc = pc & 31; \
        stg[i_] = *(const v4u*)((part ? wrl : wrh) + (size_t)rr * 1024 + (ch) * 256 + cc * 8); } } while (0)
#define RT_STORE(buf) do { _Pragma("unroll") for (int i_ = 0; i_ < 6; ++i_) { const int pc = F.tid + 512 * i_, part = pc / 1536, rr = (pc % 1536) >> 5, cc = pc & 31; \
        *(LAS v4u*)(wl0 + (buf) * WBUF + (part * 48 + rr) * WROW + cc * 16) = stg[i_]; } } while (0)
    f32x4 acc[3] = {{0.f, 0.f, 0.f, 0.f}, {0.f, 0.f, 0.f, 0.f}, {0.f, 0.f, 0.f, 0.f}}; float ss = 0.f;
    RT_LOAD(0); RT_STORE(0);
    __syncthreads();
#pragma unroll 1
    for (int ch = 0; ch < 4; ++ch) {
        v4u xw[8];
#pragma unroll
        for (int k8 = 0; k8 < 8; ++k8) xw[k8] = *(const v4u*)(hrow + ch * 256 + 32 * k8);
        if (ch < 3) RT_LOAD(ch + 1);
        const LAS unsigned char* wb = wl0 + (ch & 1) * WBUF + i16 * WROW + 16 * kq;
#pragma unroll
        for (int k8 = 0; k8 < 8; ++k8) {
            { const v4u x = xw[k8]; const float a0 = bflo(x.x), a1 = bfhi(x.x), a2 = bflo(x.y), a3 = bfhi(x.y), a4 = bflo(x.z), a5 = bfhi(x.z), a6 = bflo(x.w), a7 = bfhi(x.w); ss += ((a0 * a0 + a1 * a1) + (a2 * a2 + a3 * a3)) + ((a4 * a4 + a5 * a5) + (a6 * a6 + a7 * a7)); }
            const bf16x8 xhv = __builtin_bit_cast(bf16x8, xw[k8]);
#pragma unroll
            for (int nt = 0; nt < 3; ++nt) { const bf16x8 wh = *(const LAS bf16x8*)(wb + nt * 16 * WROW + 64 * k8), wl = *(const LAS bf16x8*)(wb + (48 + nt * 16) * WROW + 64 * k8);
                acc[nt] = __builtin_amdgcn_mfma_f32_16x16x32_bf16(wh, xhv, acc[nt], 0, 0, 0); acc[nt] = __builtin_amdgcn_mfma_f32_16x16x32_bf16(wl, xhv, acc[nt], 0, 0, 0); }
        }
        if (ch < 3) { RT_STORE((ch + 1) & 1); }
        __syncthreads();
    }
#undef RT_LOAD
#undef RT_STORE
    ss += __shfl_xor(ss, 16); ss += __shfl_xor(ss, 32);
    const float rs = 1.0f / sqrtf(ss * (1.0f / D) + EPS);
    float lg[36];
#pragma unroll
    for (int nt = 0; nt < 3; ++nt)
#pragma unroll
        for (int r = 0; r < 4; ++r) {
#pragma unroll
            for (int q = 0; q < 4; ++q) { const int c = 16 * nt + 4 * q + r; if (c < 36) { const float v = __shfl(acc[nt][r], i16 + 16 * q); lg[c] = v * rs + ((c < 4) ? b1[c & 3] : b2[(c - 4) & 31]); } } }
    const float m1 = fmaxf(fmaxf(lg[0], lg[1]), fmaxf(lg[2], lg[3]));
    const int gi = (lg[0] == m1) ? 0 : (lg[1] == m1) ? 1 : (lg[2] == m1) ? 2 : 3;
    const float se = (__expf(lg[0] - m1) + __expf(lg[1] - m1)) + (__expf(lg[2] - m1) + __expf(lg[3] - m1));
    const float gval = 1.0f / se;
    float f[8];
#pragma unroll
    for (int j = 0; j < 8; ++j) f[j] = (gi == 0) ? lg[4 + j] : (gi == 1) ? lg[12 + j] : (gi == 2) ? lg[20 + j] : lg[28 + j];
    int i0 = 0; float v0 = f[0];
#pragma unroll
    for (int j = 1; j < 8; ++j) if (f[j] > v0) { v0 = f[j]; i0 = j; }
    int i1 = 0; float v1 = -INFINITY;
#pragma unroll
    for (int j = 0; j < 8; ++j) if (j != i0 && f[j] > v1) { v1 = f[j]; i1 = j; }
    const float a1 = __expf(v1 - v0); const float g0 = gval / (1.0f + a1), g1 = gval * a1 / (1.0f + a1);
    if (kq == 0) { const unsigned e0 = (unsigned)(gi * 8 + i0), e1 = (unsigned)(gi * 8 + i1);
        const unsigned p0 = __hip_atomic_fetch_add(lcnt + e0, 1u, __ATOMIC_RELAXED, __HIP_MEMORY_SCOPE_WORKGROUP), p1 = __hip_atomic_fetch_add(lcnt + e1, 1u, __ATOMIC_RELAXED, __HIP_MEMORY_SCOPE_WORKGROUP);
        v4u r0; r0.x = e0; r0.y = e1; r0.z = p0; r0.w = p1; *(v4u*)(route + (size_t)t * 8) = r0;
        v2u r1; r1.x = __builtin_bit_cast(unsigned, g0); r1.y = __builtin_bit_cast(unsigned, g1); *(v2u*)(route + (size_t)t * 8 + 4) = r1;
        rsb[t] = rs; }
    __syncthreads();
    if (F.tid < 32) { const unsigned c = lcnt[F.tid]; const unsigned bb = __hip_atomic_fetch_add(F.ctl + CW_CNT + (cl * 32 + F.tid) * 64, c, RLX_AGENT);
        ((unsigned*)(W_ + WS_BBASE))[F.blk * 32 + F.tid] = bb; }
    __syncthreads();
    if (F.tid == 0) __hip_atomic_fetch_add(F.ctl + CW_RARR + 64 * cl, 1u, RLX_AGENT);
}
__device__ __forceinline__ void phase_gather(Frame& F, int l) {
    unsigned char* const W_ = wsp(F);
    LAS unsigned* base = (LAS unsigned*)F.lds;
    unsigned* tile_e = (unsigned*)(W_ + WS_TILEE);
    if (F.tid == 0) { unsigned sp = 0; while (ald(F.ctl + CW_RARR + 64 * l) < (unsigned)F.G) { __builtin_amdgcn_s_sleep(2); if (++sp > (1u << 22)) { __hip_atomic_store(F.ctl + 1, 0x6A70u, RLX_AGENT); break; } } }
    __syncthreads();
    if (F.tid < 32) base[96 + F.tid] = ald(F.ctl + CW_CNT + (l * 32 + F.tid) * 64);
    LDS_WAIT(); asm volatile("" ::: "memory");
    if (F.tid == 0) { unsigned acc = 0u; for (int e = 0; e < 32; ++e) { const unsigned c = base[96 + e]; base[e] = acc; acc += (c + 255u) & ~255u; } base[32] = acc >> 8; }
    __syncthreads();
    if (F.blk == 0 && F.tid < 32) { const unsigned c = base[96 + F.tid]; const unsigned nt = (c + 255u) >> 8, t0 = base[F.tid] >> 8;
        for (unsigned r = 0; r < nt; ++r) tile_e[t0 + r] = (unsigned)F.tid;
        if (F.tid == 0) tile_e[511] = base[32]; }
    unsigned* route = (unsigned*)(W_ + WS_ROUTE); const unsigned* bbase = (const unsigned*)(W_ + WS_BBASE) + F.blk * 32;
    if (F.tid >= 64 && F.tid < 96) base[64 + (F.tid - 64)] = base[F.tid - 64] + ald(bbase + (F.tid - 64));
    __syncthreads();
    bf16* xg = (bf16*)(W_ + R1_XG); const float* rsb = (const float*)(W_ + WS_RS); const bf16* hb = (const bf16*)(W_ + WS_HB); const float* g2 = F.in[13] + (size_t)l * D;
    f32x4 gv[4];
#pragma unroll
    for (int j = 0; j < 4; ++j) gv[j] = *((const f32x4*)g2 + F.lane + 64 * j);
    const int t0 = F.blk * 128 + F.wave * 16; const int tl = t0 + (F.lane & 15);
    const v4u rw = *(const v4u*)(route + (size_t)tl * 8);
    const unsigned sl0 = base[64 + rw.x] + rw.z, sl1 = base[64 + rw.y] + rw.w; const float rsl = rsb[tl];
    if (F.lane < 16) { v2u sw; sw.x = sl0; sw.y = sl1; *(v2u*)(route + (size_t)tl * 8 + 6) = sw; }
#pragma unroll 4
    for (int ti = 0; ti < 16; ++ti) { const int t = t0 + ti;
        const unsigned s0 = (unsigned)__shfl((int)sl0, ti), s1 = (unsigned)__shfl((int)sl1, ti); const float rs = __shfl(rsl, ti);
        const v2u* hr = (const v2u*)(hb + (size_t)t * D) + F.lane; v2u* d0 = (v2u*)(xg + (size_t)s0 * D) + F.lane; v2u* d1 = (v2u*)(xg + (size_t)s1 * D) + F.lane;
#pragma unroll
        for (int j = 0; j < 4; ++j) { const v2u hv = hr[64 * j]; v2u w; w.x = pk2(bflo(hv.x) * rs * gv[j].x, bfhi(hv.x) * rs * gv[j].y); w.y = pk2(bflo(hv.y) * rs * gv[j].z, bfhi(hv.y) * rs * gv[j].w); d0[64 * j] = w; d1[64 * j] = w; } }
    __syncthreads();
}
#ifndef MK_MULTI
#define MK_MULTI 0
#endif
#ifndef IN_SP2
#define IN_SP2 true
#endif
#ifndef IN_ALIGN
#define IN_ALIGN true
#endif
#ifndef GU_ALIGN
#define GU_ALIGN true
#endif
#ifndef RESID_MFMA
#define RESID_MFMA 1
#endif
#ifndef DN_ALIGN
#define DN_ALIGN false
#endif
constexpr int PPL = 12;
constexpr int NPHASE = 1 + PPL * DEPTH;
struct Args { const float* in[21]; float* out; unsigned char* ws; int ph_lo, ph_hi; };
static_assert(sizeof(Args) == 23 * 8 + 8, "Args has no padding");

#ifndef PH_MASK
#define PH_MASK 0xffffffffu
#endif
#define PHM(j) ((PH_MASK >> (j)) & 1u)
#define IN(k) (lo <= (k) && (k) < hi)
#ifndef BAR_TWICE
#define BAR_TWICE 0
#endif
#define SEAM(k) do { if (IN(k) && IN((k) + 1)) { xcd_barrier(bar); if (BAR_TWICE) xcd_barrier(bar); } } while (0)
constexpr int CW_TAIL = 16384;
constexpr int TLE_OFF = RING_BYTES + 12288;
constexpr int RS1_OFF = RING_BYTES + 8704;
constexpr int QKG_OFF = RING_BYTES + 8192;
constexpr int RS_OFF = RING_BYTES + 4096;
template <class Sched> __device__ __forceinline__ void ssd_row_scales(Frame& F, const Sched& S, const float* ssq) {
    LAS float* rl = (LAS float*)(F.lds + RS_OFF); pg8::Unit u;
    const int ui = F.tid >> 8, r = F.tid & 255;
    if (S.next(ui, u)) { const f32x4* sp = (const f32x4*)(ssq + (size_t)(u.pm * 256 + r) * 16); f32x4 s4 = sp[0]; s4 = s4 + sp[1]; s4 = s4 + sp[2]; s4 = s4 + sp[3];
        rl[ui * 256 + r] = 1.0f / sqrtf(((s4[0] + s4[1]) + (s4[2] + s4[3])) * (1.0f / 512.0f) + EPS); }
    __syncthreads();
}
__device__ __forceinline__ int moe_tile_table(Frame& F, const unsigned* tile_e) {
    LAS unsigned* tl = (LAS unsigned*)(F.lds + TLE_OFF);
    if (F.tid < 320) tl[F.tid] = ald(tile_e + F.tid);
    if (F.tid == 511) tl[511] = ald(tile_e + 511);
    __syncthreads();
    return __builtin_amdgcn_readfirstlane((int)tl[511]);
}
template <int l> __device__ __forceinline__ void layer_program(Frame& F, const XcdBarrier& bar, const int lo, const int hi) {
        const int pb = 1 + PPL * l; unsigned char* W_ = wsp(F);
#if (REP_MASK & 2u)
        if (PHM(1) && IN(pb + 0)) { {
            pg8::Gemm g{(const bf16*)(W_ + WS_HB), (const bf16*)(W_ + WS_WIN) + (size_t)l * NIN * 1024, T, NIN, D}; pg8::StaticOrder S; S.init(T, NIN, F.G, F.blk);
            if (F.tid < 128) ((LAS float*)(F.lds + QKG_OFF))[F.tid] = (F.tid < 64) ? F.in[10][l * 64 + F.tid] : F.in[11][l * 64 + F.tid - 64];
            { LAS float* rl = (LAS float*)(F.lds + RS1_OFF); const float* rs1 = (const float*)(W_ + WS_RS1);
              for (int i = F.tid; i < 6 * 256; i += NTHREADS) { pg8::Unit u; if (S.next(i >> 8, u)) rl[i] = rs1[u.pm * 256 + (i & 255)]; } }
            __syncthreads();
            pg8::EpiInProj E{(bf16*)(W_ + R1_Z), (bf16*)(W_ + R1_XBC), (bf16*)(W_ + R1_Q), (bf16*)(W_ + R1_K), (bf16*)(W_ + R1_V), (float*)(W_ + R1_DT),
                             (float*)(F.ctl + CW_KSUM) + (size_t)l * 65536, (const LAS float*)(F.lds + QKG_OFF), C2, EPS, (const LAS float*)(F.lds + RS1_OFF), 0};
            pg8::gemm_phase<pg8::EpiInProj, pg8::StaticOrder, IN_ALIGN, IN_SP2>(F.lds, g, S, E);
        }        }
#endif
        if (PHM(1) && IN(pb + 0)) { {
            pg8::Gemm g{(const bf16*)(W_ + WS_HB), (const bf16*)(W_ + WS_WIN) + (size_t)l * NIN * 1024, T, NIN, D}; pg8::StaticOrder S; S.init(T, NIN, F.G, F.blk);
            if (F.tid < 128) ((LAS float*)(F.lds + QKG_OFF))[F.tid] = (F.tid < 64) ? F.in[10][l * 64 + F.tid] : F.in[11][l * 64 + F.tid - 64];
            { LAS float* rl = (LAS float*)(F.lds + RS1_OFF); const float* rs1 = (const float*)(W_ + WS_RS1);
              for (int i = F.tid; i < 6 * 256; i += NTHREADS) { pg8::Unit u; if (S.next(i >> 8, u)) rl[i] = rs1[u.pm * 256 + (i & 255)]; } }
            __syncthreads();
            pg8::EpiInProj E{(bf16*)(W_ + R1_Z), (bf16*)(W_ + R1_XBC), (bf16*)(W_ + R1_Q), (bf16*)(W_ + R1_K), (bf16*)(W_ + R1_V), (float*)(W_ + R1_DT),
                             (float*)(F.ctl + CW_KSUM) + (size_t)l * 65536, (const LAS float*)(F.lds + QKG_OFF), C2, EPS, (const LAS float*)(F.lds + RS1_OFF), 0};
            pg8::gemm_phase<pg8::EpiInProj, pg8::StaticOrder, IN_ALIGN, IN_SP2>(F.lds, g, S, E);
        }        } SEAM(pb + 0);
#if SSD_NAIVE
        if (PHM(2) && IN(pb + 1)) { REPS(2) phase_conv(F, l); } SEAM(pb + 1);
        SEAM(pb + 2);
        if (PHM(3) && IN(pb + 3)) { phase_mixer_naive(F, l, bar); } SEAM(pb + 3);
        SEAM(pb + 4);
#else
        if (PHM(2) && IN(pb + 1)) { phase_ssd_prep(F, l); phase_ssd_states(F, l); } SEAM(pb + 1);
        if (PHM(3) && IN(pb + 3)) { phase_mixer_naive(F, l, bar); } SEAM(pb + 3);
#endif
#if SSD_NAIVE
        if (PHM(4) && IN(pb + 5)) { REPS(4) phase_ssdnorm(F); } SEAM(pb + 5);
#endif
#ifndef OUT_ALIGN
#define OUT_ALIGN true
#endif
#ifndef PROBE_MIDK
#define PROBE_MIDK 8
#endif
#ifndef PROBE_ALIGN
#define PROBE_ALIGN true
#endif
#if (REP_MASK & 0x2000u)
        if constexpr (l == 0) {
        if (PHM(5) && IN(pb + 6)) { {
            pg8::Gemm g{(const bf16*)(W_ + R1_YMIX), (const bf16*)(W_ + WS_WOUT) + (size_t)l * 1024 * 1024, T, D, D}; pg8::StaticOrder S; S.init(T, D, F.G, F.blk);
            ssd_row_scales(F, S, (const float*)(W_ + SS_SSQ));
            if constexpr (l == 0) { pg8::EpiResidT<false, PROBE_MIDK> E{F.in[0], (bf16*)(W_ + WS_HB), D, (const LAS float*)(F.lds + RS_OFF), EPS, 0}; pg8::gemm_phase<pg8::EpiResidT<false, PROBE_MIDK>, pg8::StaticOrder, PROBE_ALIGN, true>(F.lds, g, S, E); }
            else { pg8::EpiResidT<true> E{(const bf16*)(W_ + WS_HB), (bf16*)(W_ + WS_HB), D, (const LAS float*)(F.lds + RS_OFF), EPS, 0}; pg8::gemm_phase<pg8::EpiResidT<true>, pg8::StaticOrder, OUT_ALIGN, true>(F.lds, g, S, E); }
        }        }
        }
#endif
        if (PHM(5) && IN(pb + 6)) { {
            pg8::Gemm g{(const bf16*)(W_ + R1_YMIX), (const bf16*)(W_ + WS_WOUT) + (size_t)l * 1024 * 1024, T, D, D}; pg8::StaticOrder S; S.init(T, D, F.G, F.blk);
            ssd_row_scales(F, S, (const float*)(W_ + SS_SSQ));
#if RESID_MFMA
            { pg8::EpiResidX<> E{(const bf16*)(W_ + WS_HB), (const bf16*)(W_ + WS_IDN), (bf16*)(W_ + WS_HB), D, (const LAS float*)(F.lds + RS_OFF), 0}; pg8::gemm_phase<pg8::EpiResidX<>, pg8::StaticOrder, OUT_ALIGN, true>(F.lds, g, S, E); }
#else
            if constexpr (l == 0) { pg8::EpiResidT<false> E{F.in[0], (bf16*)(W_ + WS_HB), D, (const LAS float*)(F.lds + RS_OFF), EPS, 0}; pg8::gemm_phase<pg8::EpiResidT<false>, pg8::StaticOrder, OUT_ALIGN, true>(F.lds, g, S, E); }
            else { pg8::EpiResidT<true> E{(const bf16*)(W_ + WS_HB), (bf16*)(W_ + WS_HB), D, (const LAS float*)(F.lds + RS_OFF), EPS, 0}; pg8::gemm_phase<pg8::EpiResidT<true>, pg8::StaticOrder, OUT_ALIGN, true>(F.lds, g, S, E); }
#endif
        }        } SEAM(pb + 6);
        if (PHM(6) && IN(pb + 7)) {
#if (REP_MASK & 0x40u)
            phase_router(F, l, l + 2);
#endif
            phase_router(F, l, l); phase_gather(F, l); } SEAM(pb + 7);
        if (PHM(8) && IN(pb + 9)) { REPS(8) {
            moe_tile_table(F, (const unsigned*)(W_ + WS_TILEE));
            pg8::Gemm g{(const bf16*)(W_ + R1_XG), (const bf16*)(W_ + WS_WGU) + (size_t)l * 32 * 1024 * 1024, PMAX, 32 * 1024, D};
            pg8::MoeOrder S{(const LAS unsigned*)(F.lds + TLE_OFF), 1024, F.blk}; pg8::EpiSwiGLU E{(bf16*)(W_ + R1_HMID)};
            pg8::gemm_phase<pg8::EpiSwiGLU, pg8::MoeOrder, GU_ALIGN, true>(F.lds, g, S, E);
        }        } SEAM(pb + 9);
        if (PHM(9) && IN(pb + 10)) { REPS(9) {
            const int nrt = moe_tile_table(F, (const unsigned*)(W_ + WS_TILEE));
            const int nunits = 4 * nrt, nT = (nunits - 1024 + 31) >> 5;
            unsigned* tcnt = F.ctl + CW_TAIL + l * 32 * 64;
            { pg8::Gemm g{(const bf16*)(W_ + R1_XG), (const bf16*)(W_ + WS_WGU) + (size_t)l * 32 * 1024 * 1024, PMAX, 32 * 1024, D};
              pg8::MoeTailOrder S{(const LAS unsigned*)(F.lds + TLE_OFF), nunits, F.blk}; pg8::EpiSwiGLUT<true> E{(bf16*)(W_ + R1_HMID)}; pg8::Unit tu;
              if (S.next(0, tu)) {
                  pg8::gemm_phase<pg8::EpiSwiGLUT<true>, pg8::MoeTailOrder, GU_ALIGN, true>(F.lds, g, S, E);
                  if (F.lane == 0) __hip_atomic_fetch_add(tcnt + (tu.pm - 256) * 64, 1u, RLX_AGENT); } }
            pg8::Gemm g{(const bf16*)(W_ + R1_HMID), (const bf16*)(W_ + WS_WD) + (size_t)l * 32 * 1024 * 512, PMAX, 32 * 1024, HID};
            pg8::MoeDownOrder S{(const LAS unsigned*)(F.lds + TLE_OFF), nunits, F.blk, nT, tcnt, F.ctl + 1}; pg8::EpiDown E{(bf16*)(W_ + R1_XG)};
            pg8::gemm_phase<pg8::EpiDown, pg8::MoeDownOrder, DN_ALIGN, true>(F.lds, g, S, E);
        }        } SEAM(pb + 10);
        if (PHM(10) && IN(pb + 11)) {
#if (REP_MASK & 0x400u)
            if constexpr (l == 0) phase_combine<true>(F, l + 1);
#endif
            phase_combine<false>(F, l + 1); } SEAM(pb + 11);
}
__global__ void __launch_bounds__(NTHREADS, 2) hymba_fwd(Args args) {
    extern __shared__ __attribute__((aligned(16))) unsigned char lds[];
    Frame F;
    F.lds = (LAS unsigned char*)lds; F.MISC = (volatile LAS unsigned*)(F.lds + MISC_OFF);
    F.tid = threadIdx.x; F.lane = F.tid & 63; F.wave = __builtin_amdgcn_readfirstlane(F.tid >> 6); F.G = gridDim.x; F.blk = blockIdx.x;
    F.ws = args.ws; F.ctl = (unsigned*)(args.ws + WS_CTL); F.out = args.out;
    F.in = (const float* const*)__builtin_amdgcn_kernarg_segment_ptr();
    for (int u = F.tid; u < (LDS_BYTES - RING_BYTES) / 4; u += NTHREADS) ((LAS unsigned*)(F.lds + RING_BYTES))[u] = 0u;
    __syncthreads();
    const int lo = args.ph_lo, hi = args.ph_hi;
    XcdBarrier bar; bar.bar = F.ctl + CW_BAR; bar.x = 0; bar.st = nullptr;
    if (hi - lo > 1) bar = xcd_barrier_post(F.ctl + CW_BAR, F.MISC + 8);

    if (PHM(0) && IN(0)) { REPS(0) phase_prologue(F); } SEAM(0);

    layer_program<0>(F, bar, lo, hi);
    layer_program<1>(F, bar, lo, hi);
#undef IN
#undef SEAM
}

extern "C" void kernel_launch(void* const* d_in, const int* in_sizes, int n_in, void* d_out, int out_size, void* d_ws, size_t ws_size, hipStream_t stream) {
    static int ready = 0;
    if (ready == 0) {
        if (n_in != 21 || out_size != T * D || ws_size < WS_END) { fprintf(stderr, "kernel_launch: unexpected shapes (n_in %d out %d ws %zu need %zu)\n", n_in, out_size, ws_size, (size_t)WS_END); ready = -1; return; }
        if (hipFuncSetAttribute((const void*)hymba_fwd, hipFuncAttributeMaxDynamicSharedMemorySize, LDS_BYTES) != hipSuccess) { fprintf(stderr, "kernel_launch: hipFuncSetAttribute failed\n"); ready = -1; return; }
        int per_cu = 0;
        if (hipOccupancyMaxActiveBlocksPerMultiprocessor(&per_cu, (const void*)hymba_fwd, NTHREADS, LDS_BYTES) != hipSuccess || per_cu < 1) fprintf(stderr, "kernel_launch: note: occupancy query says %d\n", per_cu);
        (void)hipGetLastError();
        ready = 1;
    }
    if (ready < 0) return;
    (void)hipMemsetAsync((char*)d_ws + WS_CTL, 0, CTL_ZERO_BYTES, stream);
    Args a{};
    for (int i = 0; i < 21; ++i) a.in[i] = (const float*)d_in[i];
    a.out = (float*)d_out; a.ws = (unsigned char*)d_ws;
#if MK_MULTI
    for (int p = 0; p < NPHASE; ++p) { a.ph_lo = p; a.ph_hi = p + 1; hipLaunchKernelGGL(hymba_fwd, dim3(GRID), dim3(NTHREADS), LDS_BYTES, stream, a); }
#else
    a.ph_lo = 0; a.ph_hi = NPHASE; hipLaunchKernelGGL(hymba_fwd, dim3(GRID), dim3(NTHREADS), LDS_BYTES, stream, a);
#endif
}
```
